# Optimizing an MI355X kernel written in HIP

```python
import math, functools
import jax, jax.numpy as jnp
from jax import lax
import numpy as np

D_MODEL = 2048
BATCH = 16
SEQ = 2048
DEPTH = 2

MIX_WIDTH = D_MODEL
GDN_HEAD_DIM = 128
GDN_HEADS = MIX_WIDTH // (2 * GDN_HEAD_DIM)
GDN_W = GDN_HEADS * GDN_HEAD_DIM
RET_HEAD_DIM = 256
RET_HEADS = MIX_WIDTH // (2 * RET_HEAD_DIM)
RET_W = RET_HEADS * RET_HEAD_DIM
EV_IN_SIZES = (3 * GDN_W, GDN_HEADS, GDN_HEADS, GDN_W, RET_W, RET_W, RET_W, RET_W)
EV_IN_WIDTH = 4 * GDN_W + 2 * GDN_HEADS + 4 * RET_W
CHUNK = 64
CONV_WIDTH = 4
ROPE_BASE = 10000.0
LRU_WIDTH = D_MODEL
LRU_BLOCK = 256
LRU_BLOCKS = LRU_WIDTH // LRU_BLOCK
LRU_C = 8.0
D_FF = (11 * D_MODEL) // 4
N_EVEN = (DEPTH + 1) // 2
N_ODD = DEPTH // 2
N_SUB = 3
EPS = 1e-6

kernel_name = 'hybrid_gdn_retention_rglru_macaron_block'


def rms_norm(x, gain, eps=EPS):
    xf = x.astype(jnp.float32)
    y = xf * lax.rsqrt(jnp.mean(xf * xf, axis=-1, keepdims=True) + eps)
    return (y * gain.astype(jnp.float32)).astype(x.dtype)


def l2_normalize(x, eps=EPS):
    return x * lax.rsqrt(jnp.sum(x * x, axis=-1, keepdims=True) + eps)


def causal_depthwise_conv(x, w):
    width, t_len = w.shape[0], x.shape[1]
    xp = jnp.pad(x, ((0, 0), (width - 1, 0), (0, 0)))
    out = xp[:, 0:t_len] * w[0]
    for tap in range(1, width):
        out = out + xp[:, tap:tap + t_len] * w[tap]
    return out


def rotary(x, pos):
    half = x.shape[-1] // 2
    inv_freq = ROPE_BASE ** (-jnp.arange(half, dtype=jnp.float32) / half)
    ang = pos[:, None] * inv_freq[None, :]
    cos, sin = jnp.cos(ang)[None, :, None, :], jnp.sin(ang)[None, :, None, :]
    x1, x2 = x[..., :half], x[..., half:]
    return jnp.concatenate([x1 * cos - x2 * sin, x2 * cos + x1 * sin], axis=-1)


def heads_first(t, n_heads):
    b, t_len, _ = t.shape
    return t.reshape(b, t_len, n_heads, -1).transpose(0, 2, 1, 3)


def to_chunks(t, n_chunks):
    return t.reshape(t.shape[0], t.shape[1], n_chunks, CHUNK, t.shape[-1])


def chunk_gated_delta_rule(q, k, v, log_decay, beta):
    b, h, t_len, dk = q.shape
    dv = v.shape[-1]
    n = t_len // CHUNK
    q, k, v = to_chunks(q * dk ** -0.5, n), to_chunks(k, n), to_chunks(v, n)
    g = jnp.cumsum(log_decay.reshape(b, h, n, CHUNK), axis=-1)
    beta = beta.reshape(b, h, n, CHUNK)[..., None]
    idx = jnp.arange(CHUNK)
    causal = idx[:, None] >= idx[None, :]
    strict = idx[:, None] > idx[None, :]
    decay = jnp.exp(jnp.where(causal, g[..., :, None] - g[..., None, :], -jnp.inf))
    k_beta = k * beta
    a_mat = jnp.where(strict, jnp.einsum('bhnid,bhnjd->bhnij', k_beta, k) * decay, 0.0)
    rhs = jnp.concatenate([v * beta, k_beta * jnp.exp(g)[..., None]], axis=-1)
    sol = lax.linalg.triangular_solve(a_mat, rhs, left_side=True, lower=True, unit_diagonal=True)
    u, w = sol[..., :dv], sol[..., dv:]
    qk = jnp.where(causal, jnp.einsum('bhnid,bhnjd->bhnij', q, k) * decay, 0.0)
    g_last = g[..., -1:]
    q_st = q * jnp.exp(g)[..., None]
    k_st = k * jnp.exp(g_last - g)[..., None]
    chunk_decay = jnp.exp(g_last)[..., None]

    def step(state, inp):
        q_c, k_c, u_c, w_c, qk_c, dec_c = inp
        v_new = u_c - jnp.einsum('bhik,bhkv->bhiv', w_c, state)
        o = jnp.einsum('bhik,bhkv->bhiv', q_c, state) + jnp.einsum('bhij,bhjv->bhiv', qk_c, v_new)
        state = state * dec_c + jnp.einsum('bhjk,bhjv->bhkv', k_c, v_new)
        return state, o

    xs = tuple(jnp.moveaxis(t, 2, 0) for t in (q_st, k_st, u, w, qk, chunk_decay))
    _, o = lax.scan(step, jnp.zeros((b, h, dk, dv), q.dtype), xs)
    return jnp.moveaxis(o, 0, 2).reshape(b, h, t_len, dv)


def chunk_retention(q, k, v):
    b, h, t_len, dk = q.shape
    dv = v.shape[-1]
    n = t_len // CHUNK
    log_gamma = jnp.log1p(-jnp.exp2(-5.0 - jnp.arange(h, dtype=jnp.float32)))
    q, k, v = to_chunks(q, n), to_chunks(k * dk ** -0.5, n), to_chunks(v, n)
    idx = jnp.arange(CHUNK, dtype=jnp.float32)
    causal = idx[:, None] >= idx[None, :]
    intra_decay = jnp.exp(jnp.where(causal, (idx[:, None] - idx[None, :]) * log_gamma[:, None, None], -jnp.inf))
    scores = jnp.einsum('bhnid,bhnjd->bhnij', q, k) * intra_decay[:, None]
    o_intra = jnp.einsum('bhnij,bhnjd->bhnid', scores, v)
    lg4 = log_gamma[:, None, None, None]
    q_in = q * jnp.exp((idx[:, None] + 1.0) * lg4)
    k_st = k * jnp.exp((CHUNK - 1.0 - idx[:, None]) * lg4)
    chunk_decay = jnp.exp(CHUNK * log_gamma)[:, None, None]

    def step(state, inp):
        q_c, k_c, v_c = inp
        o = jnp.einsum('bhid,bhde->bhie', q_c, state)
        state = state * chunk_decay + jnp.einsum('bhjd,bhje->bhde', k_c, v_c)
        return state, o

    xs = tuple(jnp.moveaxis(t, 2, 0) for t in (q_in, k_st, v))
    _, o_inter = lax.scan(step, jnp.zeros((b, h, dk, dv), q.dtype), xs)
    return (o_intra + jnp.moveaxis(o_inter, 0, 2)).reshape(b, h, t_len, dv)


def gdn_retention_mixer(h, w_in, conv_w, a_log, dt_bias, o_norm, ret_norm, w_out):
    b, t_len, _ = h.shape
    f32 = jnp.float32
    cuts = [int(o) for o in np.cumsum(EV_IN_SIZES)[:-1]]
    qkv_a, beta_in, alpha_in, z_a, q_b, k_b, v_b, g_b = jnp.split(h @ w_in, cuts, axis=-1)
    qkv = jax.nn.silu(causal_depthwise_conv(qkv_a, conv_w)).astype(f32)
    q_a, k_a, v_a = [heads_first(t, GDN_HEADS) for t in jnp.split(qkv, 3, axis=-1)]
    q_a, k_a = l2_normalize(q_a), l2_normalize(k_a)
    beta = jax.nn.sigmoid(beta_in.astype(f32)).transpose(0, 2, 1)
    log_decay = (-jnp.exp(a_log.astype(f32)) * jax.nn.softplus(alpha_in.astype(f32) + dt_bias.astype(f32))).transpose(0, 2, 1)
    o_a = chunk_gated_delta_rule(q_a, k_a, v_a, log_decay, beta).transpose(0, 2, 1, 3)
    z = z_a.astype(f32).reshape(b, t_len, GDN_HEADS, GDN_HEAD_DIM)
    o_a = (rms_norm(o_a, o_norm) * jax.nn.silu(z)).reshape(b, t_len, GDN_W)
    pos = jnp.arange(t_len, dtype=f32)
    q_r = rotary(q_b.astype(f32).reshape(b, t_len, RET_HEADS, RET_HEAD_DIM), pos).transpose(0, 2, 1, 3)
    k_r = rotary(k_b.astype(f32).reshape(b, t_len, RET_HEADS, RET_HEAD_DIM), pos).transpose(0, 2, 1, 3)
    v_r = heads_first(v_b.astype(f32), RET_HEADS)
    o_b = chunk_retention(q_r, k_r, v_r).transpose(0, 2, 1, 3)
    gate_b = jax.nn.silu(g_b.astype(f32).reshape(b, t_len, RET_HEADS, RET_HEAD_DIM))
    o_b = (rms_norm(o_b, ret_norm.reshape(RET_HEADS, RET_HEAD_DIM)) * gate_b).reshape(b, t_len, RET_W)
    o = jnp.concatenate([o_a, o_b], axis=-1).astype(h.dtype)
    return o @ w_out


def rglru_mixer(h, w_in, conv_w, conv_b, gate_a_w, gate_a_b, gate_x_w, gate_x_b, lam, w_out):
    b, t_len, _ = h.shape
    f32 = jnp.float32
    y_branch, x_branch = jnp.split(h @ w_in, 2, axis=-1)
    y = jax.nn.gelu(y_branch, approximate=True)
    xc = (causal_depthwise_conv(x_branch, conv_w) + conv_b).astype(f32)
    xb = xc.reshape(b, t_len, LRU_BLOCKS, LRU_BLOCK)
    r = jax.nn.sigmoid(jnp.einsum('btni,nij->btnj', xb, gate_a_w.astype(f32)).reshape(b, t_len, LRU_WIDTH) + gate_a_b.astype(f32))
    i = jax.nn.sigmoid(jnp.einsum('btni,nij->btnj', xb, gate_x_w.astype(f32)).reshape(b, t_len, LRU_WIDTH) + gate_x_b.astype(f32))
    log_a = -LRU_C * r * jax.nn.softplus(-lam.astype(f32))
    a = jnp.exp(log_a)
    inp = jnp.sqrt(-jnp.expm1(2.0 * log_a)) * (i * xc)

    def combine(left, right):
        a_l, b_l = left
        a_r, b_r = right
        return a_l * a_r, a_r * b_l + b_r

    _, hs = lax.associative_scan(combine, (a, inp), axis=1)
    return (hs.astype(h.dtype) * y) @ w_out


def swiglu_ffn(h, w13, w2):
    gate, up = jnp.split(h @ w13, 2, axis=-1)
    return (jax.nn.silu(gate) * up) @ w2


def sandwich(x, fn, mod_s, g_pre, g_post, res_w):
    shift, scale, gate = mod_s[:, 0, None], mod_s[:, 1, None], mod_s[:, 2, None]
    h = rms_norm(x, g_pre) * (1.0 + scale) + shift
    return x + res_w * (1.0 + gate) * rms_norm(fn(h), g_post)


def setup_inputs(seed: int = 0) -> dict:
    key = jax.random.key(seed)
    ks = jax.random.split(key, 24)
    f32 = jnp.float32

    def nrm(k, shape, scale):
        return scale * jax.random.normal(k, shape, f32)

    dt = jnp.exp(jax.random.uniform(ks[11], (N_EVEN, GDN_HEADS), f32, math.log(1e-3), math.log(1e-1)))
    a_pow = jax.random.uniform(ks[22], (N_ODD, LRU_WIDTH), f32, 0.9, 0.999)
    s = a_pow ** (1.0 / LRU_C)
    return {
        'x': nrm(ks[0], (BATCH, SEQ, D_MODEL), 1.0),
        'c': nrm(ks[1], (BATCH, D_MODEL), 1.0),
        'ada_w': nrm(ks[2], (DEPTH, D_MODEL, N_SUB * 3 * D_MODEL), 0.5 * D_MODEL ** -0.5),
        'ada_b': nrm(ks[3], (DEPTH, N_SUB * 3 * D_MODEL), 0.01),
        'norm_pre': 1.0 + nrm(ks[4], (DEPTH, N_SUB, D_MODEL), 0.05),
        'norm_post': 1.0 + nrm(ks[5], (DEPTH, N_SUB, D_MODEL), 0.05),
        'ffn_w13': nrm(ks[6], (DEPTH, 2, D_MODEL, 2 * D_FF), D_MODEL ** -0.5),
        'ffn_w2': nrm(ks[7], (DEPTH, 2, D_FF, D_MODEL), D_FF ** -0.5),
        'ev_w_in': nrm(ks[8], (N_EVEN, D_MODEL, EV_IN_WIDTH), D_MODEL ** -0.5),
        'ev_conv_w': nrm(ks[9], (N_EVEN, CONV_WIDTH, 3 * GDN_W), CONV_WIDTH ** -0.5),
        'ev_a_log': jnp.log(jax.random.uniform(ks[10], (N_EVEN, GDN_HEADS), f32, 1.0, 16.0)),
        'ev_dt_bias': dt + jnp.log(-jnp.expm1(-dt)),
        'ev_o_norm': 1.0 + nrm(ks[12], (N_EVEN, GDN_HEAD_DIM), 0.05),
        'ev_ret_norm': 1.0 + nrm(ks[13], (N_EVEN, RET_W), 0.05),
        'ev_w_out': nrm(ks[14], (N_EVEN, MIX_WIDTH, D_MODEL), MIX_WIDTH ** -0.5),
        'od_w_in': nrm(ks[15], (N_ODD, D_MODEL, 2 * LRU_WIDTH), D_MODEL ** -0.5),
        'od_conv_w': nrm(ks[16], (N_ODD, CONV_WIDTH, LRU_WIDTH), CONV_WIDTH ** -0.5),
        'od_conv_b': nrm(ks[17], (N_ODD, LRU_WIDTH), 0.01),
        'od_gate_a_w': nrm(ks[18], (N_ODD, LRU_BLOCKS, LRU_BLOCK, LRU_BLOCK), LRU_BLOCK ** -0.5),
        'od_gate_a_b': nrm(ks[19], (N_ODD, LRU_WIDTH), 0.01),
        'od_gate_x_w': nrm(ks[20], (N_ODD, LRU_BLOCKS, LRU_BLOCK, LRU_BLOCK), LRU_BLOCK ** -0.5),
        'od_gate_x_b': nrm(ks[21], (N_ODD, LRU_WIDTH), 0.01),
        'od_lambda': jnp.log(s) - jnp.log1p(-s),
        'od_w_out': nrm(ks[23], (N_ODD, LRU_WIDTH, D_MODEL), LRU_WIDTH ** -0.5),
    }


def reference(x, c, ada_w, ada_b, norm_pre, norm_post, ffn_w13, ffn_w2,
              ev_w_in, ev_conv_w, ev_a_log, ev_dt_bias, ev_o_norm, ev_ret_norm, ev_w_out,
              od_w_in, od_conv_w, od_conv_b, od_gate_a_w, od_gate_a_b, od_gate_x_w, od_gate_x_b,
              od_lambda, od_w_out):
    b = x.shape[0]
    for layer in range(DEPTH):
        mod = (jax.nn.silu(c) @ ada_w[layer] + ada_b[layer]).reshape(b, N_SUB, 3, D_MODEL)
        ffn_pre = functools.partial(swiglu_ffn, w13=ffn_w13[layer, 0], w2=ffn_w2[layer, 0])
        ffn_post = functools.partial(swiglu_ffn, w13=ffn_w13[layer, 1], w2=ffn_w2[layer, 1])
        if layer % 2 == 0:
            e = layer // 2
            mixer = functools.partial(gdn_retention_mixer, w_in=ev_w_in[e], conv_w=ev_conv_w[e],
                                      a_log=ev_a_log[e], dt_bias=ev_dt_bias[e], o_norm=ev_o_norm[e],
                                      ret_norm=ev_ret_norm[e], w_out=ev_w_out[e])
        else:
            o = layer // 2
            mixer = functools.partial(rglru_mixer, w_in=od_w_in[o], conv_w=od_conv_w[o], conv_b=od_conv_b[o],
                                      gate_a_w=od_gate_a_w[o], gate_a_b=od_gate_a_b[o],
                                      gate_x_w=od_gate_x_w[o], gate_x_b=od_gate_x_b[o],
                                      lam=od_lambda[o], w_out=od_w_out[o])
        x = sandwich(x, ffn_pre, mod[:, 0], norm_pre[layer, 0], norm_post[layer, 0], 0.5)
        x = sandwich(x, mixer, mod[:, 1], norm_pre[layer, 1], norm_post[layer, 1], 1.0)
        x = sandwich(x, ffn_post, mod[:, 2], norm_pre[layer, 2], norm_post[layer, 2], 0.5)
    return x
```

```cpp
#include <hip/hip_runtime.h>
#include <cstdio>
#include <cstdint>
#include <cmath>
namespace pg8 {
#define PG8_LAS __attribute__((address_space(3)))
typedef unsigned short bf16_t;
typedef short bf16x8 __attribute__((ext_vector_type(8)));
typedef float f32x4 __attribute__((ext_vector_type(4)));
typedef unsigned u32x4 __attribute__((ext_vector_type(4)));
constexpr int BM = 256, BK = 64, HALF = 128, HTB = HALF * BK * 2  , STAGE_BYTES = 8 * HTB, NXCD = 8, WGM = 8;

__host__ __device__ __forceinline__ int lds_byte(int r, int c) { const int st = (r >> 4) * 2 + (c >> 5), rr = r & 15, cc = c & 31, ob = rr * 64 + cc * 2; return st * 1024 + (ob ^ (((ob >> 9) & 1) << 5)); }
__host__ __device__ __forceinline__ void stage_rc(int b, int& R, int& C) { const int st = b / 1024, sb = b % 1024, swz = sb ^ (((sb >> 9) & 1) << 5); R = (st >> 1) * 16 + swz / 64; C = (st & 1) * 32 + (swz % 64) / 2; }
__host__ __device__ __forceinline__ int perm32(int rho) { const int n = rho >> 4, i = rho & 15; return 8 * (i >> 2) + 4 * n + (i & 3); }

struct Unit { int pm, pn; };
struct Gemm { const bf16_t* A; const bf16_t* Bt; int M, N, K, lda, ablk; };

struct StaticOrder {
    int nM, nN, nwg, G, c;
    __host__ __device__ void init(int M, int N, int G_, int c_) { nM = M / BM; nN = N / BM; nwg = nM * nN; G = G_; c = c_; }
    __host__ __device__ bool next(int i, Unit& u) const {
        const long L = (long)i * G + c; if (L >= nwg) return false;
        int wgid = (int)L; { const int q = nwg / NXCD, r = nwg % NXCD, xcd = wgid % NXCD, off = wgid / NXCD; wgid = (xcd < r ? xcd * (q + 1) : r * (q + 1) + (xcd - r) * q) + off; }
        const int nig = WGM * nN, gid = wgid / nig, fm = gid * WGM, gsz = (nM - fm) < WGM ? (nM - fm) : WGM;
        u.pm = fm + ((wgid % nig) % gsz); u.pn = (wgid % nig) / gsz; return true;
    }
    __device__ __forceinline__ void a_ready(const Unit&) const {}
    __device__ __forceinline__ void done(const Unit&) const {}
};

__device__ __forceinline__ unsigned cvt_pk_bf16(float lo, float hi) { unsigned r; asm volatile("v_cvt_pk_bf16_f32 %0, %1, %2" : "=v"(r) : "v"(lo), "v"(hi)); return r; }
__device__ __forceinline__ float fast_sigmoid(float x) { return __builtin_amdgcn_rcpf(1.0f + __expf(-x)); }
__device__ __forceinline__ float bfl(unsigned w) { return __uint_as_float(w << 16); }
__device__ __forceinline__ float bfh(unsigned w) { return __uint_as_float(w & 0xffff0000u); }

struct EpiBf16 {
    static constexpr bool PERM = true, AFTER_DRAIN = false;
    bf16_t* O; int ldc;
    __device__ __forceinline__ void operator()(const f32x4 (&acc)[2][2][4][2], const Unit& u, int wr, int wc, int fr, int fq) const {
        const int row0 = u.pm * BM + wr * 64 + fr, col0 = u.pn * BM + wc * 32 + 8 * fq;
#pragma unroll
        for (int ai = 0; ai < 2; ++ai)
#pragma unroll
            for (int m = 0; m < 4; ++m) { bf16_t* rowp = O + (size_t)(row0 + ai * HALF + m * 16) * ldc + col0;
#pragma unroll
                for (int bj = 0; bj < 2; ++bj) { const f32x4 v0 = acc[ai][bj][m][0], v1 = acc[ai][bj][m][1];
                    u32x4 w; w.x = cvt_pk_bf16(v0[0], v0[1]); w.y = cvt_pk_bf16(v0[2], v0[3]); w.z = cvt_pk_bf16(v1[0], v1[1]); w.w = cvt_pk_bf16(v1[2], v1[3]);
                    *(u32x4*)(rowp + bj * HALF) = w; } }
    }
};
struct EpiSwiGLU {
    static constexpr bool PERM = true, AFTER_DRAIN = false;
    bf16_t* O; int ldc;
    __device__ __forceinline__ void operator()(const f32x4 (&acc)[2][2][4][2], const Unit& u, int wr, int wc, int fr, int fq) const {
        const int row0 = u.pm * BM + wr * 64 + fr, col0 = u.pn * HALF + wc * 32 + 8 * fq;
#pragma unroll
        for (int ai = 0; ai < 2; ++ai)
#pragma unroll
            for (int m = 0; m < 4; ++m) { bf16_t* rowp = O + (size_t)(row0 + ai * HALF + m * 16) * ldc + col0;
                float r[8];
#pragma unroll
                for (int n = 0; n < 2; ++n)
#pragma unroll
                    for (int e = 0; e < 4; ++e) { const float g = acc[ai][0][m][n][e], up = acc[ai][1][m][n][e]; r[n * 4 + e] = g * fast_sigmoid(g) * up; }
                u32x4 w; w.x = cvt_pk_bf16(r[0], r[1]); w.y = cvt_pk_bf16(r[2], r[3]); w.z = cvt_pk_bf16(r[4], r[5]); w.w = cvt_pk_bf16(r[6], r[7]);
                *(u32x4*)rowp = w; }
    }
};
struct EpiGates {
    static constexpr bool PERM = true, AFTER_DRAIN = false;
    float* ADEC; bf16_t* INP; const bf16_t* XC; const float* ba; const float* bx; const float* sp8;
    __device__ __forceinline__ void operator()(const f32x4 (&acc)[2][2][4][2], const Unit& u, int wr, int wc, int fr, int fq) const {
        const int row0 = u.pm * BM + wr * 64 + fr, c0 = (u.pn >> 1) * 256 + (u.pn & 1) * HALF + wc * 32 + 8 * fq;
#pragma unroll
        for (int ai = 0; ai < 2; ++ai)
#pragma unroll
            for (int m = 0; m < 4; ++m) { const size_t off = (size_t)(row0 + ai * HALF + m * 16) * 2048 + c0;
                const u32x4 xw = *(const u32x4*)(XC + off);
                f32x4 bav[2], bxv[2], spv[2];
#pragma unroll
                for (int n = 0; n < 2; ++n) { bav[n] = *(const f32x4*)(ba + c0 + 4 * n); bxv[n] = *(const f32x4*)(bx + c0 + 4 * n); spv[n] = *(const f32x4*)(sp8 + c0 + 4 * n); }
                const float xc[8] = {bfl(xw.x), bfh(xw.x), bfl(xw.y), bfh(xw.y), bfl(xw.z), bfh(xw.z), bfl(xw.w), bfh(xw.w)};
                float av[8], iv[8];
#pragma unroll
                for (int n = 0; n < 2; ++n)
#pragma unroll
                    for (int e = 0; e < 4; ++e) { const float r = fast_sigmoid(acc[ai][0][m][n][e] + bav[n][e]), ig = fast_sigmoid(acc[ai][1][m][n][e] + bxv[n][e]);
                        const float a = __expf(spv[n][e] * r); av[n * 4 + e] = a; iv[n * 4 + e] = sqrtf(fmaxf(1.0f - a * a, 0.0f)) * ig * xc[n * 4 + e]; }
                *(f32x4*)(ADEC + off) = (f32x4){av[0], av[1], av[2], av[3]}; *(f32x4*)(ADEC + off + 4) = (f32x4){av[4], av[5], av[6], av[7]};
                u32x4 w; w.x = cvt_pk_bf16(iv[0], iv[1]); w.y = cvt_pk_bf16(iv[2], iv[3]); w.z = cvt_pk_bf16(iv[4], iv[5]); w.w = cvt_pk_bf16(iv[6], iv[7]);
                *(u32x4*)(INP + off) = w;
                asm volatile("" ::: "memory"); }
    }
};

template <class Epi, class Sched, bool ALIGN_EPI = false, bool SP2 = false>
__device__ __forceinline__ void gemm_phase(PG8_LAS unsigned char* lds, const Gemm g, const Sched& S, const Epi& E) {
    int tid_ = threadIdx.x; asm volatile("" : "+v"(tid_));
    const int tid = tid_, wid = __builtin_amdgcn_readfirstlane(tid >> 6), lane = tid & 63, wr = wid >> 2, wc = wid & 3, fr = lane & 15, fq = lane >> 4;
    const int K = g.K, nt = K / BK;
    unsigned voffA[2], voffB[2];
#pragma unroll
    for (int i = 0; i < 2; ++i) { int R, C; stage_rc(tid * 16 + i * 8192, R, C); const int Rb = Epi::PERM ? ((R & ~31) + perm32(R & 31)) : R;
        voffA[i] = (unsigned)(R * g.lda + C) * 2u; voffB[i] = (unsigned)(Rb * K + C) * 2u; }
    const size_t kstep = (size_t)(BK * 2);
    const size_t hstep = (size_t)HALF * K * 2, hstepA = (size_t)HALF * g.lda * 2;
    const size_t tstep = 2 * hstep, tstepA = 2 * hstepA;
    const unsigned ldsw = (unsigned)wid * 1024u;
    const int aoff = lds_byte(wr * 64 + fr, fq * 8), boff = lds_byte(wc * 32 + fr, fq * 8);
#define PG8_SA(b, h) (((b) * 2 + (h)) * HTB)
#define PG8_SB(b, h) ((4 + (b) * 2 + (h)) * HTB)
#define PG8_STAGE(bufoff, gbase, voff) do { _Pragma("unroll") for (int _i = 0; _i < 2; ++_i) \
        __builtin_amdgcn_global_load_lds((const unsigned*)((const char*)(gbase) + (voff)[_i]), (PG8_LAS unsigned*)(lds + (bufoff) + ldsw + _i * 8192), 16, 0, 0); } while (0)
#define PG8_LDA(dst, b, h) do { _Pragma("unroll") for (int m = 0; m < 4; ++m) _Pragma("unroll") for (int k = 0; k < 2; ++k) dst[m][k] = *(const PG8_LAS bf16x8*)(lds + PG8_SA(b, h) + aoff + m * 2048 + k * 1024); } while (0)
#define PG8_LDB(dst, b, h) do { _Pragma("unroll") for (int n = 0; n < 2; ++n) _Pragma("unroll") for (int k = 0; k < 2; ++k) dst[n][k] = *(const PG8_LAS bf16x8*)(lds + PG8_SB(b, h) + boff + n * 2048 + k * 1024); } while (0)
#define PG8_MMA(ai, bj, At, Bt) do { __builtin_amdgcn_s_setprio(1); _Pragma("unroll") for (int m = 0; m < 4; ++m) _Pragma("unroll") for (int n = 0; n < 2; ++n) _Pragma("unroll") for (int k = 0; k < 2; ++k) \
        acc[ai][bj][m][n] = __builtin_amdgcn_mfma_f32_16x16x32_bf16(Bt[n][k], At[m][k], acc[ai][bj][m][n], 0, 0, 0); __builtin_amdgcn_s_setprio(0); } while (0)
#define PG8_WAIT_V(n) asm volatile("s_waitcnt vmcnt(" #n ")" ::: "memory")
#define PG8_WAIT_L(n) asm volatile("s_waitcnt lgkmcnt(" #n ")" ::: "memory")
#define PG8_BAR __builtin_amdgcn_s_barrier()
#define PG8_SCHED __builtin_amdgcn_sched_barrier(0)
    Unit cur, nxt; int ui = 0;
    if (!S.next(0, cur)) return;
    f32x4 acc[2][2][4][2];
#pragma unroll
    for (int a = 0; a < 2; ++a)
#pragma unroll
        for (int b = 0; b < 2; ++b)
#pragma unroll
            for (int m = 0; m < 4; ++m)
#pragma unroll
                for (int n = 0; n < 2; ++n) acc[a][b][m][n] = (f32x4){0.f, 0.f, 0.f, 0.f};
    bf16x8 At[4][2], B0[2][2], B1[2][2];
    const char* cA = (const char*)g.A + (size_t)cur.pm * tstepA + (g.ablk ? (size_t)(cur.pn / g.ablk) * K * 2 : (size_t)0); const char* cB = (const char*)g.Bt + (size_t)cur.pn * tstep;
    S.a_ready(cur);
    if constexpr (SP2) {
        PG8_STAGE(PG8_SB(0, 0), cB, voffB); PG8_STAGE(PG8_SB(0, 1), cB + hstep, voffB); PG8_STAGE(PG8_SA(0, 0), cA, voffA); PG8_STAGE(PG8_SA(0, 1), cA + hstepA, voffA);
        if (wr == 1) PG8_BAR;
        PG8_WAIT_V(2); PG8_BAR;
        PG8_STAGE(PG8_SB(1, 0), cB + kstep, voffB); PG8_STAGE(PG8_SA(1, 0), cA + kstep, voffA); PG8_STAGE(PG8_SB(1, 1), cB + hstep + kstep, voffB);
        PG8_WAIT_V(6); PG8_BAR;
    } else {
        PG8_STAGE(PG8_SB(0, 0), cB, voffB); PG8_STAGE(PG8_SA(0, 0), cA, voffA); PG8_STAGE(PG8_SB(0, 1), cB + hstep, voffB); PG8_STAGE(PG8_SA(0, 1), cA + hstepA, voffA);
        if (wr == 1) PG8_BAR;
        PG8_WAIT_V(4); PG8_BAR;
        PG8_STAGE(PG8_SB(1, 0), cB + kstep, voffB); PG8_STAGE(PG8_SA(1, 0), cA + kstep, voffA); PG8_STAGE(PG8_SB(1, 1), cB + hstep + kstep, voffB);
        PG8_WAIT_V(6); PG8_BAR;
    }
    for (;;) {
        const bool has_next = S.next(ui + 1, nxt);
        const char* nA = has_next ? (const char*)g.A + (size_t)nxt.pm * tstepA + (g.ablk ? (size_t)(nxt.pn / g.ablk) * K * 2 : (size_t)0) : cA; const char* nB = has_next ? (const char*)g.Bt + (size_t)nxt.pn * tstep : cB;
        for (int t = 0; t < nt; t += 2) {
            const bool last = (t == nt - 2);
            const char* a1 = cA + (size_t)(t + 1) * kstep;
            const char* a2 = last ? nA : cA + (size_t)(t + 2) * kstep; const char* b2 = last ? nB : cB + (size_t)(t + 2) * kstep;
            const char* a3 = a2 + kstep; const char* b3 = b2 + kstep;
            if (last && has_next) S.a_ready(nxt);
            if constexpr (SP2) {
            PG8_LDB(B0, 0, 0); PG8_LDB(B1, 0, 1); PG8_SCHED; PG8_LDA(At, 0, 0); PG8_STAGE(PG8_SA(1, 1), a1 + hstepA, voffA);
            PG8_WAIT_V(8); PG8_WAIT_L(0); PG8_BAR; PG8_MMA(0, 0, At, B0); PG8_MMA(0, 1, At, B1); PG8_BAR; PG8_SCHED;
            PG8_LDA(At, 0, 1); PG8_STAGE(PG8_SB(0, 0), b2, voffB); PG8_STAGE(PG8_SB(0, 1), b2 + hstep, voffB); PG8_STAGE(PG8_SA(0, 0), a2, voffA);
            PG8_WAIT_V(8); PG8_WAIT_L(0); PG8_BAR; PG8_MMA(1, 0, At, B0); PG8_MMA(1, 1, At, B1); PG8_BAR; PG8_SCHED;
            PG8_LDB(B0, 1, 0); PG8_LDB(B1, 1, 1); PG8_SCHED; PG8_LDA(At, 1, 0); PG8_STAGE(PG8_SA(0, 1), a2 + hstepA, voffA);
            PG8_WAIT_V(8); PG8_WAIT_L(0); PG8_BAR; PG8_MMA(0, 0, At, B0); PG8_MMA(0, 1, At, B1); PG8_BAR; PG8_SCHED;
            PG8_LDA(At, 1, 1); PG8_STAGE(PG8_SB(1, 0), b3, voffB); PG8_STAGE(PG8_SB(1, 1), b3 + hstep, voffB); PG8_STAGE(PG8_SA(1, 0), a3, voffA);
            PG8_WAIT_V(8); PG8_WAIT_L(0); PG8_BAR; PG8_MMA(1, 0, At, B0); PG8_MMA(1, 1, At, B1); PG8_BAR; PG8_SCHED;
            } else {
            PG8_LDB(B0, 0, 0); PG8_SCHED; PG8_LDA(At, 0, 0); PG8_STAGE(PG8_SA(1, 1), a1 + hstepA, voffA);
            PG8_WAIT_L(8); PG8_BAR; PG8_WAIT_L(0); PG8_MMA(0, 0, At, B0); PG8_BAR; PG8_SCHED;
            PG8_LDB(B1, 0, 1); PG8_STAGE(PG8_SB(0, 0), b2, voffB);
            PG8_BAR; PG8_WAIT_L(0); PG8_MMA(0, 1, At, B1); PG8_BAR;
            PG8_LDA(At, 0, 1); PG8_STAGE(PG8_SA(0, 0), a2, voffA);
            PG8_BAR; PG8_WAIT_L(0); PG8_MMA(1, 0, At, B0); PG8_BAR; PG8_SCHED;
            PG8_STAGE(PG8_SB(0, 1), b2 + hstep, voffB);
            PG8_WAIT_V(6); PG8_BAR; PG8_MMA(1, 1, At, B1); PG8_BAR;
            PG8_LDB(B0, 1, 0); PG8_SCHED; PG8_LDA(At, 1, 0); PG8_STAGE(PG8_SA(0, 1), a2 + hstepA, voffA);
            PG8_WAIT_L(8); PG8_BAR; PG8_WAIT_L(0); PG8_MMA(0, 0, At, B0); PG8_BAR; PG8_SCHED;
            PG8_LDB(B1, 1, 1); PG8_STAGE(PG8_SB(1, 0), b3, voffB);
            PG8_BAR; PG8_WAIT_L(0); PG8_MMA(0, 1, At, B1); PG8_BAR;
            PG8_LDA(At, 1, 1); PG8_STAGE(PG8_SA(1, 0), a3, voffA);
            PG8_BAR; PG8_WAIT_L(0); PG8_MMA(1, 0, At, B0); PG8_BAR; PG8_SCHED;
            PG8_STAGE(PG8_SB(1, 1), b3 + hstep, voffB);
            PG8_WAIT_V(6); PG8_BAR; PG8_MMA(1, 1, At, B1); PG8_BAR;
            }
        }
        if constexpr (ALIGN_EPI) { if (wr == 0) PG8_BAR; }
        if constexpr (!Epi::AFTER_DRAIN) { E(acc, cur, wr, wc, fr, fq); S.done(cur); }
        if (!has_next) break;
#pragma unroll
        for (int a = 0; a < 2; ++a)
#pragma unroll
            for (int b = 0; b < 2; ++b)
#pragma unroll
                for (int m = 0; m < 4; ++m)
#pragma unroll
                    for (int n = 0; n < 2; ++n) acc[a][b][m][n] = (f32x4){0.f, 0.f, 0.f, 0.f};
        cur = nxt; cA = nA; cB = nB; ++ui;
        if constexpr (ALIGN_EPI) { if (wr == 1) PG8_BAR; }
    }
    PG8_WAIT_V(0);
    if constexpr (!ALIGN_EPI) { if (wr == 0) PG8_BAR; }
    PG8_BAR;
    if constexpr (Epi::AFTER_DRAIN) { E.fused(acc, cur, wr, wc, fr, fq, lds, wid, lane); S.done(cur); }
#undef PG8_SA
#undef PG8_SB
#undef PG8_STAGE
#undef PG8_LDA
#undef PG8_LDB
#undef PG8_MMA
#undef PG8_WAIT_V
#undef PG8_WAIT_L
#undef PG8_BAR
#undef PG8_SCHED
}
}

constexpr int NWAVES = 8;
constexpr int NB = 16, T = 2048, D = 2048, M = NB * T, DFF = 5632, NADA = 18432, EVW = 8208;
constexpr float EPS = 1e-6f;
#ifndef MK_PER_PHASE
#define MK_PER_PHASE 0
#endif
constexpr int NPHASE = 26;

constexpr size_t MiB = 1u << 20;
constexpr size_t WS_CTL = 0, CTL_ZERO_BYTES = 1 * MiB;
constexpr size_t WS_MODV = 1 * MiB;
constexpr size_t WS_ROPE = 4 * MiB;
constexpr size_t WS_BG = 6 * MiB;
constexpr size_t WS_WBA = 8 * MiB;
constexpr size_t WS_SP8 = 8 * MiB + 256 * 1024;
constexpr size_t WS_W13 = 16 * MiB;
constexpr size_t W13_BYTES = (size_t)2 * DFF * D * 2;
constexpr size_t WS_W2 = WS_W13 + 4 * W13_BYTES;
constexpr size_t W2_BYTES = (size_t)D * DFF * 2;
constexpr size_t WS_WEVIN = WS_W2 + 4 * W2_BYTES;
constexpr size_t WS_WEVOUT = WS_WEVIN + (size_t)8192 * D * 2;
constexpr size_t WS_WODIN = WS_WEVOUT + (size_t)D * D * 2;
constexpr size_t WS_WGATE = WS_WODIN + (size_t)4096 * D * 2;
constexpr size_t WS_WODOUT = WS_WGATE + (size_t)4096 * 256 * 2;
constexpr size_t WS_H = WS_WODOUT + (size_t)D * D * 2;
constexpr size_t WS_Y = WS_H + (size_t)M * D * 2;
constexpr size_t WS_BIG = WS_Y + (size_t)M * D * 2;
constexpr size_t WS_ADEC = WS_BIG + 256 * MiB;
constexpr size_t WS_EXT = WS_BIG + 512 * MiB;
constexpr size_t WS_END = WS_EXT + 192 * MiB;
static_assert(WS_W13 % (1u << 20) == 0 && WS_H == 346 * MiB && WS_END == 1306 * MiB, "d_ws map");
constexpr int CW_BAR = 4096;

constexpr int RING_BYTES = 131072;
constexpr int WAVE_LDS = 17920;
constexpr int ADA_ACC_OFF = 131072;
constexpr int LDSCTL_OFF = 143360, MISC_OFF = LDSCTL_OFF + 320;
constexpr int LDS_BYTES = 147456;
static_assert(MISC_OFF + 128 <= LDS_BYTES && 8 * WAVE_LDS <= LDSCTL_OFF, "LDS map");

#define GAS __attribute__((address_space(1)))
#define LAS __attribute__((address_space(3)))
typedef unsigned short bf16;
typedef unsigned v4u __attribute__((ext_vector_type(4)));
typedef unsigned v2u __attribute__((ext_vector_type(2)));
typedef float f32x4 __attribute__((ext_vector_type(4)));
typedef GAS unsigned gu32;
#define RLX_AGENT __ATOMIC_RELAXED, __HIP_MEMORY_SCOPE_AGENT
#define LDS_WAIT() asm volatile("s_waitcnt lgkmcnt(0)" ::: "memory")
#define VM_WAIT() asm volatile("s_waitcnt vmcnt(0)" ::: "memory")
using pg8::cvt_pk_bf16; using pg8::bfl; using pg8::bfh; using pg8::fast_sigmoid;

#define XB_TMO      128
#define XB_XCNT(j)  (256  + 64 * (j))
#define XB_XSUB(j)  (1280 + 64 * (j))
#define XB_XGEN(j)  (2304 + 64 * (j))
#define XB_TOP      3328
#define XB_TOPGEN   3392
#define XCD_BAR_WORDS 3456
#define XB_SPIN_CAP (1u << 18)

__device__ __forceinline__ unsigned xb_ld(unsigned* p)              { return __hip_atomic_load(p, __ATOMIC_RELAXED, __HIP_MEMORY_SCOPE_AGENT); }
__device__ __forceinline__ unsigned xb_add(unsigned* p, unsigned v) { return __hip_atomic_fetch_add(p, v, __ATOMIC_RELAXED, __HIP_MEMORY_SCOPE_AGENT); }
__device__ __forceinline__ unsigned xb_xcc_id() { return (unsigned)__builtin_amdgcn_s_getreg((3 << 11) | 20) & 0xFu; }
#define XB_SPIN(cond, bar) do { unsigned _sp = 0; while (cond) { __builtin_amdgcn_s_sleep(1); \
    if ((++_sp & 255u) == 0u) { if (xb_ld(&(bar)[XB_TMO])) break; if (_sp > XB_SPIN_CAP) { atomicAdd(&(bar)[XB_TMO], 1u); break; } } } } while (0)

struct XcdBarrier {
    unsigned* bar; unsigned x;
    volatile LAS unsigned* st;
};

__device__ __forceinline__ XcdBarrier xcd_barrier_post(unsigned* bar, volatile LAS unsigned* st) {
    XcdBarrier b; b.bar = bar; b.x = xb_xcc_id(); b.st = st;
    if (threadIdx.x == 0) (void)xb_add(&bar[XB_XCNT(b.x)], 1u);
    return b;
}
__device__ __forceinline__ void xcd_barrier_complete(unsigned* bar, unsigned x, unsigned& nloc, unsigned& nx) {
    const unsigned G = gridDim.x * gridDim.y * gridDim.z;
    unsigned sum, cnt, mine, sp = 0u;
    for (;;) {
        sum = 0u; cnt = 0u; mine = 0u;
#pragma unroll
        for (unsigned j = 0; j < 16; ++j) { const unsigned c = xb_ld(&bar[XB_XCNT(j)]); sum += c; cnt += (c > 0u) ? 1u : 0u; mine = (j == x) ? c : mine; }
        if (sum == G) break;
        __builtin_amdgcn_s_sleep(1);
        if ((++sp & 255u) == 0u) { if (xb_ld(&bar[XB_TMO])) break; if (sp > XB_SPIN_CAP) { atomicAdd(&bar[XB_TMO], 1u); break; } }
    }
    nloc = mine > 0u ? mine : 1u; nx = cnt > 0u ? cnt : 1u;
}

__device__ __forceinline__ void xcd_barrier(const XcdBarrier& b) {
    asm volatile("s_waitcnt vmcnt(0)" ::: "memory");
    __syncthreads();
    if (threadIdx.x == 0) {
        unsigned* bar = b.bar;
        __builtin_amdgcn_s_waitcnt(0);
        unsigned nloc = b.st[0], nx = b.st[1];
        if (nloc == 0u) { xcd_barrier_complete(bar, b.x, nloc, nx); b.st[0] = nloc; b.st[1] = nx; }
        const unsigned old = xb_add(&bar[XB_XSUB(b.x)], 1u);
        const unsigned gen = old / nloc;
        if (old + 1u == (gen + 1u) * nloc) {
            __builtin_amdgcn_fence(__ATOMIC_RELEASE, "agent");
            asm volatile("s_waitcnt vmcnt(0)" ::: "memory");
            const unsigned og = xb_add(&bar[XB_TOP], 1u);
            const unsigned tg = og / nx;
            if (og + 1u == (tg + 1u) * nx) xb_add(&bar[XB_TOPGEN], 1u);
            else XB_SPIN(xb_ld(&bar[XB_TOPGEN]) == tg, bar);
            __builtin_amdgcn_fence(__ATOMIC_ACQUIRE, "agent");
            xb_add(&bar[XB_XGEN(b.x)], 1u);
            asm volatile("s_waitcnt vmcnt(0)" ::: "memory");
        } else {
            XB_SPIN(xb_ld(&bar[XB_XGEN(b.x)]) == gen, bar);
            __builtin_amdgcn_fence(__ATOMIC_ACQUIRE, "agent");
            asm volatile("s_waitcnt vmcnt(0)" ::: "memory");
        }
    }
    __syncthreads();
}

struct Args { const float* in[24]; float* out; unsigned char* ws; int ph_lo, ph_hi; };
struct Frame {
    LAS unsigned char* lds; volatile LAS unsigned* MISC; gu32* ctl;
    int tid, lane, wave, vcu, G;
};
__device__ __forceinline__ float wave_sum(float v) {
#pragma unroll
    for (int o = 1; o < 64; o <<= 1) v += __shfl_xor(v, o);
    return v;
}
__device__ __forceinline__ float silu_f(float x) { return x * fast_sigmoid(x); }
__device__ __forceinline__ void unpack8(const v4u w, float (&f)[8]) { f[0] = bfl(w.x); f[1] = bfh(w.x); f[2] = bfl(w.y); f[3] = bfh(w.y); f[4] = bfl(w.z); f[5] = bfh(w.z); f[6] = bfl(w.w); f[7] = bfh(w.w); }
__device__ __forceinline__ v4u pack8(const float (&f)[8]) { v4u w; w.x = cvt_pk_bf16(f[0], f[1]); w.y = cvt_pk_bf16(f[2], f[3]); w.z = cvt_pk_bf16(f[4], f[5]); w.w = cvt_pk_bf16(f[6], f[7]); return w; }

__device__ __forceinline__ void transpose_item(const float* W, int ldw, int k0, int n0, bf16* WT, int ldt, int drow0, LAS float* scr, int lane) {
#pragma unroll 8
    for (int i = 0; i < 32; ++i) { const int kk = 2 * i + (lane >> 5); scr[kk * 33 + (lane & 31)] = W[(size_t)(k0 + kk) * ldw + n0 + (lane & 31)]; }
    LDS_WAIT(); asm volatile("" ::: "memory");
    const int c = lane & 7;
#pragma unroll
    for (int j = 0; j < 4; ++j) { const int n = (lane >> 3) + 8 * j; const LAS float* s = scr + (8 * c) * 33 + n;
        v4u o; o.x = cvt_pk_bf16(s[0 * 33], s[1 * 33]); o.y = cvt_pk_bf16(s[2 * 33], s[3 * 33]); o.z = cvt_pk_bf16(s[4 * 33], s[5 * 33]); o.w = cvt_pk_bf16(s[6 * 33], s[7 * 33]);
        *(GAS v4u*)(WT + (size_t)(drow0 + n) * ldt + k0 + 8 * c) = o; }
    LDS_WAIT(); asm volatile("" ::: "memory");
}
__device__ __forceinline__ void p0_prologue(Frame& F, const Args& a) {
    unsigned char* ws = a.ws;
    {
        LAS float* sc = (LAS float*)F.lds;
        LAS float* accl = (LAS float*)(F.lds + ADA_ACC_OFF);
        const float* c = a.in[1];
        for (int idx = F.tid; idx < NB * D; idx += NWAVES * 64) { const int b = idx >> 11, k = idx & 2047; const float v = c[idx]; sc[k * 16 + b] = v / (1.0f + __expf(-v)); }
        __syncthreads();
        float* modv = (float*)(ws + WS_MODV);
        for (int u = blockIdx.x; u < 2 * (NADA / 64); u += F.G) {
            const int layer = u / (NADA / 64), n0 = (u % (NADA / 64)) * 64;
            for (int e = F.tid; e < 1024; e += NWAVES * 64) accl[e] = 0.f;
            __syncthreads();
            const float* W = a.in[2] + (size_t)layer * D * NADA + n0 + F.lane;
            float acc[16];
#pragma unroll
            for (int b = 0; b < 16; ++b) acc[b] = 0.f;
            const int kbeg = F.wave * 256;
#pragma unroll 4
            for (int kk = 0; kk < 256; ++kk) { const int k = kbeg + kk; const float w = W[(size_t)k * NADA];
#pragma unroll
                for (int i = 0; i < 4; ++i) { const f32x4 s4 = *(const LAS f32x4*)(sc + k * 16 + 4 * i);
                    acc[4 * i + 0] += w * s4[0]; acc[4 * i + 1] += w * s4[1]; acc[4 * i + 2] += w * s4[2]; acc[4 * i + 3] += w * s4[3]; } }
            for (int w = 0; w < NWAVES; ++w) {
                if (F.wave == w) {
#pragma unroll
                    for (int b = 0; b < 16; ++b) accl[b * 64 + F.lane] += acc[b];
                }
                __syncthreads();
            }
            for (int e = F.tid; e < 1024; e += NWAVES * 64) { const int b = e >> 6, col = e & 63, n = n0 + col;
                const float v = accl[e] + a.in[3][layer * NADA + n];
                const int s = n / (3 * D), j = (n / D) % 3, d = n % D, q = layer * 3 + s;
                float o = v;
                if (j == 1) o = a.in[4][(size_t)q * D + d] * (1.0f + v);
                if (j == 2) o = (s == 1 ? 1.0f : 0.5f) * a.in[5][(size_t)q * D + d] * (1.0f + v);
                modv[((size_t)(q * 3 + j) * 16 + b) * D + d] = o; }
            __syncthreads();
        }
    }
    const int gw = F.vcu * NWAVES + F.wave, NGW = F.G * NWAVES;
    {
        LAS float* scr = (LAS float*)(F.lds + F.wave * 16384);
        constexpr int I13 = 32 * 352, I2 = 88 * 64, IEV = 32 * 256, IEO = 32 * 64, IOI = 32 * 128, IG = 16 * 32, IOO = 32 * 64;
        constexpr int NITEMS = 4 * I13 + 4 * I2 + IEV + IEO + IOI + IG + IOO;
        for (int it = gw; it < NITEMS; it += NGW) {
            int r = it;
            if (r < 4 * I13) { const int mat = r / I13; r -= mat * I13; const int kb = r / 352, nb = r % 352, n0 = 32 * nb;
                const int dr = n0 < DFF ? (n0 >> 7) * 256 + (n0 & 127) : ((n0 - DFF) >> 7) * 256 + 128 + ((n0 - DFF) & 127);
                transpose_item(a.in[6] + (size_t)mat * D * 2 * DFF, 2 * DFF, 64 * kb, n0, (bf16*)(ws + WS_W13 + mat * W13_BYTES), D, dr, scr, F.lane); continue; }
            r -= 4 * I13;
            if (r < 4 * I2) { const int mat = r / I2; r -= mat * I2; const int kb = r / 64, nb = r % 64;
                transpose_item(a.in[7] + (size_t)mat * DFF * D, D, 64 * kb, 32 * nb, (bf16*)(ws + WS_W2 + mat * W2_BYTES), DFF, 32 * nb, scr, F.lane); continue; }
            r -= 4 * I2;
            if (r < IEV) { const int kb = r / 256, nb = r % 256, d0 = 32 * nb, n0 = d0 + (d0 >= 3072 ? 16 : 0);
                transpose_item(a.in[8], EVW, 64 * kb, n0, (bf16*)(ws + WS_WEVIN), D, d0, scr, F.lane); continue; }
            r -= IEV;
            if (r < IEO) { const int kb = r / 64, nb = r % 64;
                transpose_item(a.in[14], D, 64 * kb, 32 * nb, (bf16*)(ws + WS_WEVOUT), D, 32 * nb, scr, F.lane); continue; }
            r -= IEO;
            if (r < IOI) { const int kb = r / 128, nb = r % 128;
                transpose_item(a.in[15], 2 * D, 64 * kb, 32 * nb, (bf16*)(ws + WS_WODIN), D, 32 * nb, scr, F.lane); continue; }
            r -= IOI;
            if (r < IG) { const int mat = r / 32; r -= mat * 32; const int gsel = mat >> 3, blk = mat & 7, kb = r / 8, nb = r % 8, j0 = 32 * nb;
                const int dr = (blk * 2 + (j0 >> 7)) * 256 + gsel * 128 + (j0 & 127);
                transpose_item((gsel ? a.in[20] : a.in[18]) + (size_t)blk * 65536, 256, 64 * kb, j0, (bf16*)(ws + WS_WGATE), 256, dr, scr, F.lane); continue; }
            r -= IG;
            { const int kb = r / 64, nb = r % 64;
                transpose_item(a.in[23], D, 64 * kb, 32 * nb, (bf16*)(ws + WS_WODOUT), D, 32 * nb, scr, F.lane); }
        }
    }
    const int gt = (F.vcu * NWAVES + F.wave) * 64 + F.lane, NGT = F.G * NWAVES * 64;
    { float* wba = (float*)(ws + WS_WBA);
      for (int i = gt; i < 16 * D; i += NGT) { const int o = i >> 11, k = i & 2047; wba[i] = a.in[8][(size_t)k * EVW + 3072 + o]; } }
    { float* sp8 = (float*)(ws + WS_SP8);
      for (int i = gt; i < D; i += NGT) sp8[i] = -8.0f * log1pf(expf(-a.in[22][i])); }
    { float* rc = (float*)(ws + WS_ROPE); float* rs = rc + T * 128;
      for (int i = gt; i < T * 128; i += NGT) { const int t = i >> 7, f = i & 127;
          const double ang = (double)t * pow(10000.0, -(double)f / 128.0); rc[i] = (float)cos(ang); rs[i] = (float)sin(ang); } }
}

template <bool DO_BA>
__device__ __forceinline__ void norm_pass(Frame& F, const Args& a, const int q) {
    unsigned char* ws = a.ws;
    const bool has_prev = q > 0, has_next = q < 6;
    const float* xold = (q <= 1) ? a.in[0] : a.out;
    float* xnew = a.out;
    const bf16* Y = (const bf16*)(ws + WS_Y); bf16* H = (bf16*)(ws + WS_H);
    const float* modv = (const float*)(ws + WS_MODV);
    LAS float* wl = (LAS float*)F.lds;
    if (DO_BA) {
        const float* wba = (const float*)(ws + WS_WBA);
        for (int i = F.tid; i < 16 * D; i += NWAVES * 64) { const int o = i >> 11, col = i & 2047, j = col >> 9, l = (col >> 3) & 63, hf = (col >> 2) & 1, e = col & 3;
            wl[o * 2048 + j * 512 + hf * 256 + l * 4 + e] = wba[i]; }
        __syncthreads();
    }
    const int gw = F.vcu * NWAVES + F.wave, l = F.lane;
    for (int r = 0; r < 16; ++r) {
        const int m = gw * 16 + r, b = m >> 11;
        const size_t ro = (size_t)m * D + 8 * l;
        float x[4][8];
#pragma unroll
        for (int j = 0; j < 4; ++j) { const f32x4 x0 = *(const f32x4*)(xold + ro + 512 * j), x1 = *(const f32x4*)(xold + ro + 512 * j + 4);
            x[j][0] = x0[0]; x[j][1] = x0[1]; x[j][2] = x0[2]; x[j][3] = x0[3]; x[j][4] = x1[0]; x[j][5] = x1[1]; x[j][6] = x1[2]; x[j][7] = x1[3]; }
        if (has_prev) {
            float y[4][8]; float ss = 0.f;
#pragma unroll
            for (int j = 0; j < 4; ++j) { const v4u yw = *(const v4u*)(Y + ro + 512 * j); unpack8(yw, y[j]);
#pragma unroll
                for (int e = 0; e < 8; ++e) ss += y[j][e] * y[j][e]; }
            const float ry = 1.0f / sqrtf(wave_sum(ss) * (1.0f / D) + EPS);
            const float* al = modv + ((size_t)((q - 1) * 3 + 2) * 16 + b) * D + 8 * l;
#pragma unroll
            for (int j = 0; j < 4; ++j) { const f32x4 a0 = *(const f32x4*)(al + 512 * j), a1 = *(const f32x4*)(al + 512 * j + 4);
#pragma unroll
                for (int e = 0; e < 4; ++e) { x[j][e] += a0[e] * (y[j][e] * ry); x[j][4 + e] += a1[e] * (y[j][4 + e] * ry); }
                *(f32x4*)(xnew + ro + 512 * j) = (f32x4){x[j][0], x[j][1], x[j][2], x[j][3]}; *(f32x4*)(xnew + ro + 512 * j + 4) = (f32x4){x[j][4], x[j][5], x[j][6], x[j][7]}; }
        }
        if (has_next) {
            float ss = 0.f;
#pragma unroll
            for (int j = 0; j < 4; ++j)
#pragma unroll
                for (int e = 0; e < 8; ++e) ss += x[j][e] * x[j][e];
            const float rx = 1.0f / sqrtf(wave_sum(ss) * (1.0f / D) + EPS);
            const float* Bv = modv + ((size_t)(q * 3 + 1) * 16 + b) * D + 8 * l;
            const float* Cv = modv + ((size_t)(q * 3 + 0) * 16 + b) * D + 8 * l;
#pragma unroll
            for (int j = 0; j < 4; ++j) { const f32x4 b0 = *(const f32x4*)(Bv + 512 * j), b1 = *(const f32x4*)(Bv + 512 * j + 4), c0 = *(const f32x4*)(Cv + 512 * j), c1 = *(const f32x4*)(Cv + 512 * j + 4);
#pragma unroll
                for (int e = 0; e < 4; ++e) { x[j][e] = x[j][e] * rx * b0[e] + c0[e]; x[j][4 + e] = x[j][4 + e] * rx * b1[e] + c1[e]; }
                *(v4u*)(H + ro + 512 * j) = pack8(x[j]); }
            if (DO_BA) {
                float mine = 0.f;
#pragma unroll
                for (int o = 0; o < 16; ++o) { float p = 0.f;
#pragma unroll
                    for (int j = 0; j < 4; ++j) { const f32x4 w0 = *(const LAS f32x4*)(wl + o * 2048 + j * 512 + l * 4), w1 = *(const LAS f32x4*)(wl + o * 2048 + j * 512 + 256 + l * 4);
                        p += x[j][0] * w0[0] + x[j][1] * w0[1] + x[j][2] * w0[2] + x[j][3] * w0[3] + x[j][4] * w1[0] + x[j][5] * w1[1] + x[j][6] * w1[2] + x[j][7] * w1[3]; }
                    p = wave_sum(p); mine = (l == o) ? p : mine; }
                if (l < 16) { float v;
                    if (l < 8) v = 1.0f / (1.0f + expf(-mine));
                    else { const float z = mine + a.in[11][l - 8]; const float sp = z > 20.f ? z : log1pf(expf(z)); v = -expf(a.in[10][l - 8]) * sp; }
                    ((float*)(ws + WS_BG))[(size_t)m * 16 + l] = v; }
            }
        }
    }
}

__device__ __forceinline__ void ev_prep(Frame& F, const Args& a) {
    unsigned char* ws = a.ws;
    bf16* P = (bf16*)(ws + WS_BIG); bf16* QKV = (bf16*)(ws + WS_EXT);
    const float* cw = a.in[9];
    const float* rc = (const float*)(ws + WS_ROPE); const float* rs = rc + T * 128;
    const int gw = F.vcu * NWAVES + F.wave, l = F.lane;
    for (int r = 0; r < 16; ++r) {
        const int m = gw * 16 + r, t = m & (T - 1);
#pragma unroll
        for (int g = 0; g < 6; ++g) {
            const int c0 = 512 * g + 8 * l;
            float acc[8];
#pragma unroll
            for (int e = 0; e < 8; ++e) acc[e] = 0.f;
#pragma unroll
            for (int tap = 0; tap < 4; ++tap) {
                if (t - 3 + tap >= 0) {
                    const v4u pw = *(const v4u*)(P + (size_t)(m - 3 + tap) * 8192 + c0); float pv[8]; unpack8(pw, pv);
                    const f32x4 w0 = *(const f32x4*)(cw + tap * 3072 + c0), w1 = *(const f32x4*)(cw + tap * 3072 + c0 + 4);
#pragma unroll
                    for (int e = 0; e < 4; ++e) { acc[e] += w0[e] * pv[e]; acc[4 + e] += w1[e] * pv[4 + e]; }
                }
            }
#pragma unroll
            for (int e = 0; e < 8; ++e) acc[e] = silu_f(acc[e]);
            if (g < 4) {
                float ss = 0.f;
#pragma unroll
                for (int e = 0; e < 8; ++e) ss += acc[e] * acc[e];
                ss += __shfl_xor(ss, 1); ss += __shfl_xor(ss, 2); ss += __shfl_xor(ss, 4); ss += __shfl_xor(ss, 8);
                float rn = 1.0f / sqrtf(ss + EPS);
                if (g < 2) rn *= 0.08838834764831845f;
#pragma unroll
                for (int e = 0; e < 8; ++e) acc[e] *= rn;
            }
            *(v4u*)(QKV + (size_t)m * 3072 + c0) = pack8(acc);
        }
        {
            const int hh = l >> 4, i0 = (l & 15) * 8;
            const f32x4 cs0 = *(const f32x4*)(rc + t * 128 + i0), cs1 = *(const f32x4*)(rc + t * 128 + i0 + 4);
            const f32x4 sn0 = *(const f32x4*)(rs + t * 128 + i0), sn1 = *(const f32x4*)(rs + t * 128 + i0 + 4);
            const float cs[8] = {cs0[0], cs0[1], cs0[2], cs0[3], cs1[0], cs1[1], cs1[2], cs1[3]};
            const float sn[8] = {sn0[0], sn0[1], sn0[2], sn0[3], sn1[0], sn1[1], sn1[2], sn1[3]};
#pragma unroll
            for (int w = 0; w < 2; ++w) {
                bf16* base = P + (size_t)m * 8192 + 4096 + 1024 * w + 256 * hh + i0;
                const float scl = w ? 0.0625f : 1.0f;
                float x1[8], x2[8], o1[8], o2[8];
                unpack8(*(const v4u*)base, x1); unpack8(*(const v4u*)(base + 128), x2);
#pragma unroll
                for (int e = 0; e < 8; ++e) { o1[e] = (x1[e] * cs[e] - x2[e] * sn[e]) * scl; o2[e] = (x2[e] * cs[e] + x1[e] * sn[e]) * scl; }
                *(v4u*)base = pack8(o1); *(v4u*)(base + 128) = pack8(o2);
            }
        }
    }
}

__device__ __forceinline__ void ev_recur(Frame& F, const Args& a) {
    unsigned char* ws = a.ws;
    const bf16* P = (const bf16*)(ws + WS_BIG); const bf16* QKV = (const bf16*)(ws + WS_EXT); const float* BG = (const float*)(ws + WS_BG);
    bf16* O = (bf16*)(ws + WS_Y);
    const int l = F.lane, col = l >> 2, kq = l & 3;
    LAS unsigned char* reg = F.lds + F.wave * WAVE_LDS;
    LAS float* vl = (LAS float*)(reg + 16384); LAS float* bgl = (LAS float*)(reg + 16384 + 1024);
    if (F.wave < 4) {
        const int uw = blockIdx.x * 4 + F.wave, bh = uw >> 3, vc = uw & 7, b = bh >> 3, h = bh & 7;
        float S[32];
#pragma unroll
        for (int i = 0; i < 32; ++i) S[i] = 0.f;
        v4u pf[8]; v4u pfv; float pfb;
#define GDN_ISSUE(t0) do { const size_t m0 = (size_t)b * T + (t0); \
        _Pragma("unroll") for (int i = 0; i < 8; ++i) { const int idx = l + 64 * i, tok = idx >> 5, wi = idx & 31; \
            pf[i] = *(const v4u*)(QKV + (m0 + tok) * 3072 + (wi >> 4) * 1024 + 128 * h + 8 * (wi & 15)); } \
        pfv = *(const v4u*)(QKV + (m0 + ((l & 31) >> 1)) * 3072 + 2048 + 128 * h + 16 * vc + 8 * (l & 1)); \
        pfb = BG[(m0 + ((l & 31) >> 1)) * 16 + (l & 1) * 8 + h]; } while (0)
        GDN_ISSUE(0);
        for (int t0 = 0; t0 < T; t0 += 16) {
#pragma unroll
            for (int i = 0; i < 8; ++i) { const int idx = l + 64 * i, tok = idx >> 5, wi = idx & 31; float f[8]; unpack8(pf[i], f);
                LAS float* dst = (LAS float*)(reg + tok * 1024 + (wi >> 4) * 512 + (wi & 15) * 32);
                *(LAS f32x4*)dst = (f32x4){f[0], f[1], f[2], f[3]}; *(LAS f32x4*)(dst + 4) = (f32x4){f[4], f[5], f[6], f[7]}; }
            if (l < 32) { float f[8]; unpack8(pfv, f); LAS float* dst = vl + (l >> 1) * 16 + 8 * (l & 1);
                *(LAS f32x4*)dst = (f32x4){f[0], f[1], f[2], f[3]}; *(LAS f32x4*)(dst + 4) = (f32x4){f[4], f[5], f[6], f[7]};
                bgl[(l >> 1) * 2 + (l & 1)] = pfb; }
            LDS_WAIT();
            if (t0 + 16 < T) GDN_ISSUE(t0 + 16);
            for (int tok = 0; tok < 16; ++tok) {
                const LAS float* qp = (const LAS float*)(reg + tok * 1024 + kq * 128);
                const LAS float* kp = (const LAS float*)(reg + tok * 1024 + 512 + kq * 128);
                const float v = vl[tok * 16 + col], beta = bgl[tok * 2], eg = __expf(bgl[tok * 2 + 1]);
                float kk[32]; float ks = 0.f;
#pragma unroll
                for (int i = 0; i < 8; ++i) { const f32x4 k4 = *(const LAS f32x4*)(kp + 4 * i); kk[4 * i] = k4[0]; kk[4 * i + 1] = k4[1]; kk[4 * i + 2] = k4[2]; kk[4 * i + 3] = k4[3]; }
#pragma unroll
                for (int i = 0; i < 32; ++i) ks += kk[i] * S[i];
                ks += __shfl_xor(ks, 1); ks += __shfl_xor(ks, 2);
                const float cc = beta * (v - eg * ks);
                float o = 0.f;
#pragma unroll
                for (int i = 0; i < 8; ++i) { const f32x4 q4 = *(const LAS f32x4*)(qp + 4 * i);
#pragma unroll
                    for (int e = 0; e < 4; ++e) { const float s = fmaf(kk[4 * i + e], cc, eg * S[4 * i + e]); S[4 * i + e] = s; o += q4[e] * s; } }
                o += __shfl_xor(o, 1); o += __shfl_xor(o, 2);
                if (kq == 0) O[((size_t)b * T + t0 + tok) * D + 128 * h + 16 * vc + col] = (bf16)(cvt_pk_bf16(o, 0.f) & 0xffffu);
            }
        }
#undef GDN_ISSUE
    } else {
        const int uw = blockIdx.x * 4 + (F.wave - 4), bh = uw >> 4, vc = uw & 15, b = bh >> 2, h = bh & 3;
        const float gamma = 1.0f - exp2f(-5.0f - (float)h);
        float S[64];
#pragma unroll
        for (int i = 0; i < 64; ++i) S[i] = 0.f;
        v4u pf[8]; v4u pfv;
#define RET_ISSUE(t0) do { const size_t m0 = (size_t)b * T + (t0); \
        _Pragma("unroll") for (int i = 0; i < 8; ++i) pf[i] = *(const v4u*)(P + (m0 + i) * 8192 + 4096 + (l >> 5) * 1024 + 256 * h + 8 * (l & 31)); \
        pfv = *(const v4u*)(P + (m0 + ((l & 15) >> 1)) * 8192 + 6144 + 256 * h + 16 * vc + 8 * (l & 1)); } while (0)
        RET_ISSUE(0);
        for (int t0 = 0; t0 < T; t0 += 8) {
#pragma unroll
            for (int i = 0; i < 8; ++i) { float f[8]; unpack8(pf[i], f);
                LAS float* dst = (LAS float*)(reg + i * 2048 + (l >> 5) * 1024 + (l & 31) * 32);
                *(LAS f32x4*)dst = (f32x4){f[0], f[1], f[2], f[3]}; *(LAS f32x4*)(dst + 4) = (f32x4){f[4], f[5], f[6], f[7]}; }
            if (l < 16) { float f[8]; unpack8(pfv, f); LAS float* dst = vl + (l >> 1) * 16 + 8 * (l & 1);
                *(LAS f32x4*)dst = (f32x4){f[0], f[1], f[2], f[3]}; *(LAS f32x4*)(dst + 4) = (f32x4){f[4], f[5], f[6], f[7]}; }
            LDS_WAIT();
            if (t0 + 8 < T) RET_ISSUE(t0 + 8);
            for (int tok = 0; tok < 8; ++tok) {
                const LAS float* qp = (const LAS float*)(reg + tok * 2048 + kq * 256);
                const LAS float* kp = (const LAS float*)(reg + tok * 2048 + 1024 + kq * 256);
                const float v = vl[tok * 16 + col];
                float o = 0.f;
#pragma unroll
                for (int i = 0; i < 16; ++i) { const f32x4 k4 = *(const LAS f32x4*)(kp + 4 * i), q4 = *(const LAS f32x4*)(qp + 4 * i);
#pragma unroll
                    for (int e = 0; e < 4; ++e) { const float s = fmaf(k4[e], v, gamma * S[4 * i + e]); S[4 * i + e] = s; o += q4[e] * s; } }
                o += __shfl_xor(o, 1); o += __shfl_xor(o, 2);
                if (kq == 0) O[((size_t)b * T + t0 + tok) * D + 1024 + 256 * h + 16 * vc + col] = (bf16)(cvt_pk_bf16(o, 0.f) & 0xffffu);
            }
        }
#undef RET_ISSUE
    }
}

__device__ __forceinline__ void ev_post(Frame& F, const Args& a) {
    unsigned char* ws = a.ws;
    const bf16* P = (const bf16*)(ws + WS_BIG); const bf16* O = (const bf16*)(ws + WS_Y); bf16* OM = (bf16*)(ws + WS_H);
    const int gw = F.vcu * NWAVES + F.wave, l = F.lane;
    for (int r = 0; r < 16; ++r) {
        const int m = gw * 16 + r;
#pragma unroll
        for (int j = 0; j < 4; ++j) {
            const int c0 = 512 * j + 8 * l;
            float o[8], z[8]; unpack8(*(const v4u*)(O + (size_t)m * D + c0), o);
            float ss = 0.f;
#pragma unroll
            for (int e = 0; e < 8; ++e) ss += o[e] * o[e];
            ss += __shfl_xor(ss, 1); ss += __shfl_xor(ss, 2); ss += __shfl_xor(ss, 4); ss += __shfl_xor(ss, 8);
            float rn; const float* gn;
            if (j < 2) { rn = 1.0f / sqrtf(ss * (1.0f / 128.0f) + EPS); gn = a.in[12] + (c0 & 127); unpack8(*(const v4u*)(P + (size_t)m * 8192 + 3072 + c0), z); }
            else { ss += __shfl_xor(ss, 16); rn = 1.0f / sqrtf(ss * (1.0f / 256.0f) + EPS); gn = a.in[13] + (c0 - 1024); unpack8(*(const v4u*)(P + (size_t)m * 8192 + 7168 + (c0 - 1024)), z); }
            const f32x4 g0 = *(const f32x4*)gn, g1 = *(const f32x4*)(gn + 4);
            const float gg[8] = {g0[0], g0[1], g0[2], g0[3], g1[0], g1[1], g1[2], g1[3]};
#pragma unroll
            for (int e = 0; e < 8; ++e) o[e] = o[e] * rn * gg[e] * silu_f(z[e]);
            *(v4u*)(OM + (size_t)m * D + c0) = pack8(o);
        }
    }
}

__device__ __forceinline__ void od_conv(Frame& F, const Args& a) {
    unsigned char* ws = a.ws;
    const bf16* P1 = (const bf16*)(ws + WS_BIG); bf16* XC = (bf16*)(ws + WS_H);
    const float* cw = a.in[16]; const float* cb = a.in[17];
    const int gw = F.vcu * NWAVES + F.wave, l = F.lane;
    for (int r = 0; r < 16; ++r) {
        const int m = gw * 16 + r, t = m & (T - 1);
#pragma unroll
        for (int j = 0; j < 4; ++j) {
            const int c0 = 512 * j + 8 * l;
            const f32x4 b0 = *(const f32x4*)(cb + c0), b1 = *(const f32x4*)(cb + c0 + 4);
            float acc[8] = {b0[0], b0[1], b0[2], b0[3], b1[0], b1[1], b1[2], b1[3]};
#pragma unroll
            for (int tap = 0; tap < 4; ++tap) {
                if (t - 3 + tap >= 0) {
                    float pv[8]; unpack8(*(const v4u*)(P1 + (size_t)(m - 3 + tap) * 4096 + 2048 + c0), pv);
                    const f32x4 w0 = *(const f32x4*)(cw + tap * 2048 + c0), w1 = *(const f32x4*)(cw + tap * 2048 + c0 + 4);
#pragma unroll
                    for (int e = 0; e < 4; ++e) { acc[e] += w0[e] * pv[e]; acc[4 + e] += w1[e] * pv[4 + e]; }
                }
            }
            *(v4u*)(XC + (size_t)m * D + c0) = pack8(acc);
        }
    }
}
__device__ __forceinline__ float gelu_tanh(float y) {
    const float u = 0.7978845608028654f * (y + 0.044715f * y * y * y);
    const float th = 1.0f - 2.0f * __builtin_amdgcn_rcpf(__expf(2.0f * u) + 1.0f);
    return 0.5f * y * (1.0f + th);
}
__device__ __forceinline__ void od_scan(Frame& F, const Args& a) {
    unsigned char* ws = a.ws;
    const bf16* P1 = (const bf16*)(ws + WS_BIG); const float* ADEC = (const float*)(ws + WS_ADEC); const bf16* INP = (const bf16*)(ws + WS_EXT); bf16* HSY = (bf16*)(ws + WS_H);
    if (F.tid < 128) {
        const int gt = blockIdx.x * 128 + F.tid, b = gt >> 11, c = gt & 2047;
        float h = 0.f;
        for (int t0 = 0; t0 < T; t0 += 8) {
            float av[8], iv[8], yv[8];
#pragma unroll
            for (int i = 0; i < 8; ++i) { const size_t m = (size_t)b * T + t0 + i; av[i] = ADEC[m * D + c]; iv[i] = bfl((unsigned)INP[m * D + c]); yv[i] = bfl((unsigned)P1[m * 4096 + c]); }
#pragma unroll
            for (int i = 0; i < 8; ++i) { const size_t m = (size_t)b * T + t0 + i; h = fmaf(av[i], h, iv[i]);
                HSY[m * D + c] = (bf16)(cvt_pk_bf16(h * gelu_tanh(yv[i]), 0.f) & 0xffffu); }
        }
    }
}

__device__ __forceinline__ bool fresh(Frame& F) { int t = threadIdx.x; asm volatile("" : "+v"(t)); F.tid = t; F.lane = t & 63; return true; }
__global__ void __launch_bounds__(NWAVES * 64, 2) mk_fwd(Args args) {
    extern __shared__ __attribute__((aligned(16))) unsigned char lds[];
    Frame F;
    F.lds = (LAS unsigned char*)lds;
    F.MISC = (volatile LAS unsigned*)(F.lds + MISC_OFF);
    F.tid = threadIdx.x; F.lane = F.tid & 63; F.wave = __builtin_amdgcn_readfirstlane(F.tid >> 6);
    F.G = gridDim.x; { const int bx = blockIdx.x; F.vcu = (F.G % 8 == 0) ? (bx % 8) * (F.G / 8) + bx / 8 : bx; }
    unsigned char* ws = args.ws;
    F.ctl = (gu32*)(ws + WS_CTL);
    for (int u = F.tid; u < (LDS_BYTES - LDSCTL_OFF) / 4; u += NWAVES * 64) ((LAS unsigned*)(F.lds + LDSCTL_OFF))[u] = 0u;
    __syncthreads();
    XcdBarrier bar; bar.bar = (unsigned*)(F.ctl + CW_BAR); bar.x = 0; bar.st = nullptr;
    if (!MK_PER_PHASE) bar = xcd_barrier_post((unsigned*)(F.ctl + CW_BAR), F.MISC + 8);
    const int lo = args.ph_lo, hi = args.ph_hi;
#define IN(k) (lo <= (k) && (k) < hi && fresh(F))
#define SEAM(k) do { if (IN(k) && IN((k) + 1)) xcd_barrier(bar); } while (0)
    const pg8::bf16_t* Hb = (const pg8::bf16_t*)(ws + WS_H);
    pg8::bf16_t* Yb = (pg8::bf16_t*)(ws + WS_Y);
    pg8::bf16_t* BIGb = (pg8::bf16_t*)(ws + WS_BIG);
#define FFN_PHASES(k, q, wi) \
    if (IN(k)) { norm_pass<false>(F, args, (q)); } SEAM(k); \
    if (IN((k) + 1)) { pg8::Gemm g{Hb, (const pg8::bf16_t*)(ws + WS_W13 + (size_t)(wi) * W13_BYTES), M, 2 * DFF, D, D, 0}; pg8::StaticOrder S; S.init(M, 2 * DFF, F.G, (int)blockIdx.x); \
        pg8::EpiSwiGLU E{BIGb, DFF}; pg8::gemm_phase<pg8::EpiSwiGLU, pg8::StaticOrder, true, true>(F.lds, g, S, E); } SEAM((k) + 1); \
    if (IN((k) + 2)) { pg8::Gemm g{BIGb, (const pg8::bf16_t*)(ws + WS_W2 + (size_t)(wi) * W2_BYTES), M, D, DFF, DFF, 0}; pg8::StaticOrder S; S.init(M, D, F.G, (int)blockIdx.x); \
        pg8::EpiBf16 E{Yb, D}; pg8::gemm_phase<pg8::EpiBf16, pg8::StaticOrder, true, true>(F.lds, g, S, E); } SEAM((k) + 2);

    if (IN(0)) { p0_prologue(F, args); } SEAM(0);
    FFN_PHASES(1, 0, 0)
    if (IN(4)) { norm_pass<true>(F, args, 1); } SEAM(4);
    if (IN(5)) { pg8::Gemm g{Hb, (const pg8::bf16_t*)(ws + WS_WEVIN), M, 8192, D, D, 0}; pg8::StaticOrder S; S.init(M, 8192, F.G, (int)blockIdx.x);
        pg8::EpiBf16 E{BIGb, 8192}; pg8::gemm_phase<pg8::EpiBf16, pg8::StaticOrder, true, true>(F.lds, g, S, E); } SEAM(5);
    if (IN(6)) { ev_prep(F, args); } SEAM(6);
    if (IN(7)) { ev_recur(F, args); } SEAM(7);
    if (IN(8)) { ev_post(F, args); } SEAM(8);
    if (IN(9)) { pg8::Gemm g{Hb, (const pg8::bf16_t*)(ws + WS_WEVOUT), M, D, D, D, 0}; pg8::StaticOrder S; S.init(M, D, F.G, (int)blockIdx.x);
        pg8::EpiBf16 E{Yb, D}; pg8::gemm_phase<pg8::EpiBf16, pg8::StaticOrder, true, true>(F.lds, g, S, E); } SEAM(9);
    FFN_PHASES(10, 2, 1)
    FFN_PHASES(13, 3, 2)
    if (IN(16)) { norm_pass<false>(F, args, 4); } SEAM(16);
    if (IN(17)) { pg8::Gemm g{Hb, (const pg8::bf16_t*)(ws + WS_WODIN), M, 4096, D, D, 0}; pg8::StaticOrder S; S.init(M, 4096, F.G, (int)blockIdx.x);
        pg8::EpiBf16 E{BIGb, 4096}; pg8::gemm_phase<pg8::EpiBf16, pg8::StaticOrder, true, true>(F.lds, g, S, E); } SEAM(17);
    if (IN(18)) { od_conv(F, args); } SEAM(18);
    if (IN(19)) { pg8::Gemm g{Hb, (const pg8::bf16_t*)(ws + WS_WGATE), M, 4096, 256, D, 2}; pg8::StaticOrder S; S.init(M, 4096, F.G, (int)blockIdx.x);
        pg8::EpiGates E{(float*)(ws + WS_ADEC), (pg8::bf16_t*)(ws + WS_EXT), Hb, args.in[19], args.in[21], (const float*)(ws + WS_SP8)};
        pg8::gemm_phase<pg8::EpiGates, pg8::StaticOrder, true, true>(F.lds, g, S, E); } SEAM(19);
    if (IN(20)) { od_scan(F, args); } SEAM(20);
    if (IN(21)) { pg8::Gemm g{Hb, (const pg8::bf16_t*)(ws + WS_WODOUT), M, D, D, D, 0}; pg8::StaticOrder S; S.init(M, D, F.G, (int)blockIdx.x);
        pg8::EpiBf16 E{Yb, D}; pg8::gemm_phase<pg8::EpiBf16, pg8::StaticOrder, true, true>(F.lds, g, S, E); } SEAM(21);
    FFN_PHASES(22, 5, 3)
    if (IN(25)) { norm_pass<false>(F, args, 6); }
#undef IN
#undef SEAM
#undef FFN_PHASES
}

extern "C" void kernel_launch(void* const* d_in, const int* in_sizes, int n_in, void* d_out, int out_size, void* d_ws, size_t ws_size, hipStream_t stream) {
    static int grid = 0;
    if (grid == 0) {
        if (n_in != 24 || in_sizes[0] != M * D || out_size != M * D || ws_size < WS_END) {
            fprintf(stderr, "kernel_launch: unexpected problem (n_in %d, in0 %d, out %d, ws %zu < %zu); nothing launched\n", n_in, n_in > 0 ? in_sizes[0] : -1, out_size, ws_size, (size_t)WS_END); grid = -1; return; }
        int dev = 0, cus = 0, per_cu = 0;
        if (hipGetDevice(&dev) != hipSuccess || hipDeviceGetAttribute(&cus, hipDeviceAttributeMultiprocessorCount, dev) != hipSuccess) { grid = -1; return; }
        if (hipFuncSetAttribute((const void*)mk_fwd, hipFuncAttributeMaxDynamicSharedMemorySize, LDS_BYTES) != hipSuccess) { fprintf(stderr, "kernel_launch: hipFuncSetAttribute failed\n"); grid = -1; return; }
        if (hipOccupancyMaxActiveBlocksPerMultiprocessor(&per_cu, (const void*)mk_fwd, NWAVES * 64, LDS_BYTES) != hipSuccess || per_cu < 1)
            fprintf(stderr, "kernel_launch: note: occupancy query reports %d workgroups per CU\n", per_cu);
        (void)hipGetLastError();
        grid = cus;
        if (grid != 256) fprintf(stderr, "kernel_launch: note: %d CUs (built for 256)\n", grid);
    }
    if (grid < 0) return;
    if (hipMemsetAsync((char*)d_ws + WS_CTL, 0, CTL_ZERO_BYTES, stream) != hipSuccess) return;
    Args a{};
    for (int i = 0; i < 24; ++i) a.in[i] = (const float*)d_in[i];
    a.out = (float*)d_out; a.ws = (unsigned char*)d_ws;
#if MK_PER_PHASE
    for (int k = 0; k < NPHASE; ++k) { a.ph_lo = k; a.ph_hi = k + 1; hipLaunchKernelGGL(mk_fwd, dim3(grid), dim3(NWAVES * 64), LDS_BYTES, stream, a); }
#else
    a.ph_lo = 0; a.ph_hi = NPHASE; hipLaunchKernelGGL(mk_fwd, dim3(grid), dim3(NWAVES * 64), LDS_BYTES, stream, a);
#endif
}
```

```cpp
#include <hip/hip_runtime.h>
#include <cstdio>
#include <cstdint>
#include <cmath>
namespace pg8 {
#define PG8_LAS __attribute__((address_space(3)))
typedef unsigned short bf16_t;
typedef short bf16x8 __attribute__((ext_vector_type(8)));
typedef float f32x4 __attribute__((ext_vector_type(4)));
typedef unsigned u32x4 __attribute__((ext_vector_type(4)));
constexpr int BM = 256, BK = 64, HALF = 128, HTB = HALF * BK * 2  , STAGE_BYTES = 8 * HTB, NXCD = 8, WGM = 8;

__host__ __device__ __forceinline__ int lds_byte(int r, int c) { const int st = (r >> 4) * 2 + (c >> 5), rr = r & 15, cc = c & 31, ob = rr * 64 + cc * 2; return st * 1024 + (ob ^ (((ob >> 9) & 1) << 5)); }
__host__ __device__ __forceinline__ void stage_rc(int b, int& R, int& C) { const int st = b / 1024, sb = b % 1024, swz = sb ^ (((sb >> 9) & 1) << 5); R = (st >> 1) * 16 + swz / 64; C = (st & 1) * 32 + (swz % 64) / 2; }
__host__ __device__ __forceinline__ int perm32(int rho) { const int n = rho >> 4, i = rho & 15; return 8 * (i >> 2) + 4 * n + (i & 3); }

struct Unit { int pm, pn; };
struct Gemm { const bf16_t* A; const bf16_t* Bt; int M, N, K, lda, ablk; };

struct StaticOrder {
    int nM, nN, nwg, G, c;
    __host__ __device__ void init(int M, int N, int G_, int c_) { nM = M / BM; nN = N / BM; nwg = nM * nN; G = G_; c = c_; }
    __host__ __device__ bool next(int i, Unit& u) const {
        const long L = (long)i * G + c; if (L >= nwg) return false;
        int wgid = (int)L; { const int q = nwg / NXCD, r = nwg % NXCD, xcd = wgid % NXCD, off = wgid / NXCD; wgid = (xcd < r ? xcd * (q + 1) : r * (q + 1) + (xcd - r) * q) + off; }
        const int nig = WGM * nN, gid = wgid / nig, fm = gid * WGM, gsz = (nM - fm) < WGM ? (nM - fm) : WGM;
        u.pm = fm + ((wgid % nig) % gsz); u.pn = (wgid % nig) / gsz; return true;
    }
    __device__ __forceinline__ void a_ready(const Unit&) const {}
    __device__ __forceinline__ void done(const Unit&) const {}
};

__device__ __forceinline__ unsigned cvt_pk_bf16(float lo, float hi) { unsigned r; asm volatile("v_cvt_pk_bf16_f32 %0, %1, %2" : "=v"(r) : "v"(lo), "v"(hi)); return r; }
__device__ __forceinline__ float fast_sigmoid(float x) { return __builtin_amdgcn_rcpf(1.0f + __expf(-x)); }
__device__ __forceinline__ float bfl(unsigned w) { return __uint_as_float(w << 16); }
__device__ __forceinline__ float bfh(unsigned w) { return __uint_as_float(w & 0xffff0000u); }

struct EpiBf16 {
    static constexpr bool PERM = true, AFTER_DRAIN = false;
    bf16_t* O; int ldc;
    __device__ __forceinline__ void operator()(const f32x4 (&acc)[2][2][4][2], const Unit& u, int wr, int wc, int fr, int fq) const {
        const int row0 = u.pm * BM + wr * 64 + fr, col0 = u.pn * BM + wc * 32 + 8 * fq;
#pragma unroll
        for (int ai = 0; ai < 2; ++ai)
#pragma unroll
            for (int m = 0; m < 4; ++m) { bf16_t* rowp = O + (size_t)(row0 + ai * HALF + m * 16) * ldc + col0;
#pragma unroll
                for (int bj = 0; bj < 2; ++bj) { const f32x4 v0 = acc[ai][bj][m][0], v1 = acc[ai][bj][m][1];
                    u32x4 w; w.x = cvt_pk_bf16(v0[0], v0[1]); w.y = cvt_pk_bf16(v0[2], v0[3]); w.z = cvt_pk_bf16(v1[0], v1[1]); w.w = cvt_pk_bf16(v1[2], v1[3]);
                    *(u32x4*)(rowp + bj * HALF) = w; } }
    }
};
struct EpiSwiGLU {
    static constexpr bool PERM = true, AFTER_DRAIN = false;
    bf16_t* O; int ldc;
    __device__ __forceinline__ void operator()(const f32x4 (&acc)[2][2][4][2], const Unit& u, int wr, int wc, int fr, int fq) const {
        const int row0 = u.pm * BM + wr * 64 + fr, col0 = u.pn * HALF + wc * 32 + 8 * fq;
#pragma unroll
        for (int ai = 0; ai < 2; ++ai)
#pragma unroll
            for (int m = 0; m < 4; ++m) { bf16_t* rowp = O + (size_t)(row0 + ai * HALF + m * 16) * ldc + col0;
                float r[8];
#pragma unroll
                for (int n = 0; n < 2; ++n)
#pragma unroll
                    for (int e = 0; e < 4; ++e) { const float g = acc[ai][0][m][n][e], up = acc[ai][1][m][n][e]; r[n * 4 + e] = g * fast_sigmoid(g) * up; }
                u32x4 w; w.x = cvt_pk_bf16(r[0], r[1]); w.y = cvt_pk_bf16(r[2], r[3]); w.z = cvt_pk_bf16(r[4], r[5]); w.w = cvt_pk_bf16(r[6], r[7]);
                *(u32x4*)rowp = w; }
    }
};
struct EpiGates {
    static constexpr bool PERM = true, AFTER_DRAIN = false;
    float* ADEC; bf16_t* INP; const bf16_t* XC; const float* ba; const float* bx; const float* sp8;
    __device__ __forceinline__ void operator()(const f32x4 (&acc)[2][2][4][2], const Unit& u, int wr, int wc, int fr, int fq) const {
        const int row0 = u.pm * BM + wr * 64 + fr, c0 = (u.pn >> 1) * 256 + (u.pn & 1) * HALF + wc * 32 + 8 * fq;
#pragma unroll
        for (int ai = 0; ai < 2; ++ai)
#pragma unroll
            for (int m = 0; m < 4; ++m) { const size_t off = (size_t)(row0 + ai * HALF + m * 16) * 2048 + c0;
                const u32x4 xw = *(const u32x4*)(XC + off);
                f32x4 bav[2], bxv[2], spv[2];
#pragma unroll
                for (int n = 0; n < 2; ++n) { bav[n] = *(const f32x4*)(ba + c0 + 4 * n); bxv[n] = *(const f32x4*)(bx + c0 + 4 * n); spv[n] = *(const f32x4*)(sp8 + c0 + 4 * n); }
                const float xc[8] = {bfl(xw.x), bfh(xw.x), bfl(xw.y), bfh(xw.y), bfl(xw.z), bfh(xw.z), bfl(xw.w), bfh(xw.w)};
                float av[8], iv[8];
#pragma unroll
                for (int n = 0; n < 2; ++n)
#pragma unroll
                    for (int e = 0; e < 4; ++e) { const float r = fast_sigmoid(acc[ai][0][m][n][e] + bav[n][e]), ig = fast_sigmoid(acc[ai][1][m][n][e] + bxv[n][e]);
                        const float a = __expf(spv[n][e] * r); av[n * 4 + e] = a; iv[n * 4 + e] = sqrtf(fmaxf(1.0f - a * a, 0.0f)) * ig * xc[n * 4 + e]; }
                *(f32x4*)(ADEC + off) = (f32x4){av[0], av[1], av[2], av[3]}; *(f32x4*)(ADEC + off + 4) = (f32x4){av[4], av[5], av[6], av[7]};
                u32x4 w; w.x = cvt_pk_bf16(iv[0], iv[1]); w.y = cvt_pk_bf16(iv[2], iv[3]); w.z = cvt_pk_bf16(iv[4], iv[5]); w.w = cvt_pk_bf16(iv[6], iv[7]);
                *(u32x4*)(INP + off) = w;
                asm volatile("" ::: "memory"); }
    }
};

template <class Epi, class Sched, bool ALIGN_EPI = false, bool SP2 = false>
__device__ __forceinline__ void gemm_phase(PG8_LAS unsigned char* lds, const Gemm g, const Sched& S, const Epi& E) {
    int tid_ = threadIdx.x; asm volatile("" : "+v"(tid_));
    const int tid = tid_, wid = __builtin_amdgcn_readfirstlane(tid >> 6), lane = tid & 63, wr = wid >> 2, wc = wid & 3, fr = lane & 15, fq = lane >> 4;
    const int K = g.K, nt = K / BK;
    unsigned voffA[2], voffB[2];
#pragma unroll
    for (int i = 0; i < 2; ++i) { int R, C; stage_rc(tid * 16 + i * 8192, R, C); const int Rb = Epi::PERM ? ((R & ~31) + perm32(R & 31)) : R;
        voffA[i] = (unsigned)(R * g.lda + C) * 2u; voffB[i] = (unsigned)(Rb * K + C) * 2u; }
    const size_t kstep = (size_t)(BK * 2);
    const size_t hstep = (size_t)HALF * K * 2, hstepA = (size_t)HALF * g.lda * 2;
    const size_t tstep = 2 * hstep, tstepA = 2 * hstepA;
    const unsigned ldsw = (unsigned)wid * 1024u;
    const int aoff = lds_byte(wr * 64 + fr, fq * 8), boff = lds_byte(wc * 32 + fr, fq * 8);
#define PG8_SA(b, h) (((b) * 2 + (h)) * HTB)
#define PG8_SB(b, h) ((4 + (b) * 2 + (h)) * HTB)
#define PG8_STAGE(bufoff, gbase, voff) do { _Pragma("unroll") for (int _i = 0; _i < 2; ++_i) \
        __builtin_amdgcn_global_load_lds((const unsigned*)((const char*)(gbase) + (voff)[_i]), (PG8_LAS unsigned*)(lds + (bufoff) + ldsw + _i * 8192), 16, 0, 0); } while (0)
#define PG8_LDA(dst, b, h) do { _Pragma("unroll") for (int m = 0; m < 4; ++m) _Pragma("unroll") for (int k = 0; k < 2; ++k) dst[m][k] = *(const PG8_LAS bf16x8*)(lds + PG8_SA(b, h) + aoff + m * 2048 + k * 1024); } while (0)
#define PG8_LDB(dst, b, h) do { _Pragma("unroll") for (int n = 0; n < 2; ++n) _Pragma("unroll") for (int k = 0; k < 2; ++k) dst[n][k] = *(const PG8_LAS bf16x8*)(lds + PG8_SB(b, h) + boff + n * 2048 + k * 1024); } while (0)
#define PG8_MMA(ai, bj, At, Bt) do { __builtin_amdgcn_s_setprio(1); _Pragma("unroll") for (int m = 0; m < 4; ++m) _Pragma("unroll") for (int n = 0; n < 2; ++n) _Pragma("unroll") for (int k = 0; k < 2; ++k) \
        acc[ai][bj][m][n] = __builtin_amdgcn_mfma_f32_16x16x32_bf16(Bt[n][k], At[m][k], acc[ai][bj][m][n], 0, 0, 0); __builtin_amdgcn_s_setprio(0); } while (0)
#define PG8_WAIT_V(n) asm volatile("s_waitcnt vmcnt(" #n ")" ::: "memory")
#define PG8_WAIT_L(n) asm volatile("s_waitcnt lgkmcnt(" #n ")" ::: "memory")
#define PG8_BAR __builtin_amdgcn_s_barrier()
#define PG8_SCHED __builtin_amdgcn_sched_barrier(0)
    Unit cur, nxt; int ui = 0;
    if (!S.next(0, cur)) return;
    f32x4 acc[2][2][4][2];
#pragma unroll
    for (int a = 0; a < 2; ++a)
#pragma unroll
        for (int b = 0; b < 2; ++b)
#pragma unroll
            for (int m = 0; m < 4; ++m)
#pragma unroll
                for (int n = 0; n < 2; ++n) acc[a][b][m][n] = (f32x4){0.f, 0.f, 0.f, 0.f};
    bf16x8 At[4][2], B0[2][2], B1[2][2];
    const char* cA = (const char*)g.A + (size_t)cur.pm * tstepA + (g.ablk ? (size_t)(cur.pn / g.ablk) * K * 2 : (size_t)0); const char* cB = (const char*)g.Bt + (size_t)cur.pn * tstep;
    S.a_ready(cur);
    if constexpr (SP2) {
        PG8_STAGE(PG8_SB(0, 0), cB, voffB); PG8_STAGE(PG8_SB(0, 1), cB + hstep, voffB); PG8_STAGE(PG8_SA(0, 0), cA, voffA); PG8_STAGE(PG8_SA(0, 1), cA + hstepA, voffA);
        if (wr == 1) PG8_BAR;
        PG8_WAIT_V(2); PG8_BAR;
        PG8_STAGE(PG8_SB(1, 0), cB + kstep, voffB); PG8_STAGE(PG8_SA(1, 0), cA + kstep, voffA); PG8_STAGE(PG8_SB(1, 1), cB + hstep + kstep, voffB);
        PG8_WAIT_V(6); PG8_BAR;
    } else {
        PG8_STAGE(PG8_SB(0, 0), cB, voffB); PG8_STAGE(PG8_SA(0, 0), cA, voffA); PG8_STAGE(PG8_SB(0, 1), cB + hstep, voffB); PG8_STAGE(PG8_SA(0, 1), cA + hstepA, voffA);
        if (wr == 1) PG8_BAR;
        PG8_WAIT_V(4); PG8_BAR;
        PG8_STAGE(PG8_SB(1, 0), cB + kstep, voffB); PG8_STAGE(PG8_SA(1, 0), cA + kstep, voffA); PG8_STAGE(PG8_SB(1, 1), cB + hstep + kstep, voffB);
        PG8_WAIT_V(6); PG8_BAR;
    }
    for (;;) {
        const bool has_next = S.next(ui + 1, nxt);
        const char* nA = has_next ? (const char*)g.A + (size_t)nxt.pm * tstepA + (g.ablk ? (size_t)(nxt.pn / g.ablk) * K * 2 : (size_t)0) : cA; const char* nB = has_next ? (const char*)g.Bt + (size_t)nxt.pn * tstep : cB;
        for (int t = 0; t < nt; t += 2) {
            const bool last = (t == nt - 2);
            const char* a1 = cA + (size_t)(t + 1) * kstep;
            const char* a2 = last ? nA : cA + (size_t)(t + 2) * kstep; const char* b2 = last ? nB : cB + (size_t)(t + 2) * kstep;
            const char* a3 = a2 + kstep; const char* b3 = b2 + kstep;
            if (last && has_next) S.a_ready(nxt);
            if constexpr (SP2) {
            PG8_LDB(B0, 0, 0); PG8_LDB(B1, 0, 1); PG8_SCHED; PG8_LDA(At, 0, 0); PG8_STAGE(PG8_SA(1, 1), a1 + hstepA, voffA);
            PG8_WAIT_V(8); PG8_WAIT_L(0); PG8_BAR; PG8_MMA(0, 0, At, B0); PG8_MMA(0, 1, At, B1); PG8_BAR; PG8_SCHED;
            PG8_LDA(At, 0, 1); PG8_STAGE(PG8_SB(0, 0), b2, voffB); PG8_STAGE(PG8_SB(0, 1), b2 + hstep, voffB); PG8_STAGE(PG8_SA(0, 0), a2, voffA);
            PG8_WAIT_V(8); PG8_WAIT_L(0); PG8_BAR; PG8_MMA(1, 0, At, B0); PG8_MMA(1, 1, At, B1); PG8_BAR; PG8_SCHED;
            PG8_LDB(B0, 1, 0); PG8_LDB(B1, 1, 1); PG8_SCHED; PG8_LDA(At, 1, 0); PG8_STAGE(PG8_SA(0, 1), a2 + hstepA, voffA);
            PG8_WAIT_V(8); PG8_WAIT_L(0); PG8_BAR; PG8_MMA(0, 0, At, B0); PG8_MMA(0, 1, At, B1); PG8_BAR; PG8_SCHED;
            PG8_LDA(At, 1, 1); PG8_STAGE(PG8_SB(1, 0), b3, voffB); PG8_STAGE(PG8_SB(1, 1), b3 + hstep, voffB); PG8_STAGE(PG8_SA(1, 0), a3, voffA);
            PG8_WAIT_V(8); PG8_WAIT_L(0); PG8_BAR; PG8_MMA(1, 0, At, B0); PG8_MMA(1, 1, At, B1); PG8_BAR; PG8_SCHED;
            } else {
            PG8_LDB(B0, 0, 0); PG8_SCHED; PG8_LDA(At, 0, 0); PG8_STAGE(PG8_SA(1, 1), a1 + hstepA, voffA);
            PG8_WAIT_L(8); PG8_BAR; PG8_WAIT_L(0); PG8_MMA(0, 0, At, B0); PG8_BAR; PG8_SCHED;
            PG8_LDB(B1, 0, 1); PG8_STAGE(PG8_SB(0, 0), b2, voffB);
            PG8_BAR; PG8_WAIT_L(0); PG8_MMA(0, 1, At, B1); PG8_BAR;
            PG8_LDA(At, 0, 1); PG8_STAGE(PG8_SA(0, 0), a2, voffA);
            PG8_BAR; PG8_WAIT_L(0); PG8_MMA(1, 0, At, B0); PG8_BAR; PG8_SCHED;
            PG8_STAGE(PG8_SB(0, 1), b2 + hstep, voffB);
            PG8_WAIT_V(6); PG8_BAR; PG8_MMA(1, 1, At, B1); PG8_BAR;
            PG8_LDB(B0, 1, 0); PG8_SCHED; PG8_LDA(At, 1, 0); PG8_STAGE(PG8_SA(0, 1), a2 + hstepA, voffA);
            PG8_WAIT_L(8); PG8_BAR; PG8_WAIT_L(0); PG8_MMA(0, 0, At, B0); PG8_BAR; PG8_SCHED;
            PG8_LDB(B1, 1, 1); PG8_STAGE(PG8_SB(1, 0), b3, voffB);
            PG8_BAR; PG8_WAIT_L(0); PG8_MMA(0, 1, At, B1); PG8_BAR;
            PG8_LDA(At, 1, 1); PG8_STAGE(PG8_SA(1, 0), a3, voffA);
            PG8_BAR; PG8_WAIT_L(0); PG8_MMA(1, 0, At, B0); PG8_BAR; PG8_SCHED;
            PG8_STAGE(PG8_SB(1, 1), b3 + hstep, voffB);
            PG8_WAIT_V(6); PG8_BAR; PG8_MMA(1, 1, At, B1); PG8_BAR;
            }
        }
        if constexpr (ALIGN_EPI) { if (wr == 0) PG8_BAR; }
        if constexpr (!Epi::AFTER_DRAIN) { E(acc, cur, wr, wc, fr, fq); S.done(cur); }
        if (!has_next) break;
#pragma unroll
        for (int a = 0; a < 2; ++a)
#pragma unroll
            for (int b = 0; b < 2; ++b)
#pragma unroll
                for (int m = 0; m < 4; ++m)
#pragma unroll
                    for (int n = 0; n < 2; ++n) acc[a][b][m][n] = (f32x4){0.f, 0.f, 0.f, 0.f};
        cur = nxt; cA = nA; cB = nB; ++ui;
        if constexpr (ALIGN_EPI) { if (wr == 1) PG8_BAR; }
    }
    PG8_WAIT_V(0);
    if constexpr (!ALIGN_EPI) { if (wr == 0) PG8_BAR; }
    PG8_BAR;
    if constexpr (Epi::AFTER_DRAIN) { E.fused(acc, cur, wr, wc, fr, fq, lds, wid, lane); S.done(cur); }
#undef PG8_SA
#undef PG8_SB
#undef PG8_STAGE
#undef PG8_LDA
#undef PG8_LDB
#undef PG8_MMA
#undef PG8_WAIT_V
#undef PG8_WAIT_L
#undef PG8_BAR
#undef PG8_SCHED
}
}

constexpr int NWAVES = 8;
constexpr int NB = 16, T = 2048, D = 2048, M = NB * T, DFF = 5632, NADA = 18432, EVW = 8208;
constexpr float EPS = 1e-6f;
#ifndef MK_PER_PHASE
#define MK_PER_PHASE 0
#endif
constexpr int NPHASE = 26;
#ifndef PROBE_GEMM_X2
#define PROBE_GEMM_X2 0
#endif
#ifndef PROBE_P0_X2
#define PROBE_P0_X2 0
#endif
#ifndef PROBE_REC_X2
#define PROBE_REC_X2 0
#endif

constexpr size_t MiB = 1u << 20;
constexpr size_t WS_CTL = 0, CTL_ZERO_BYTES = 1 * MiB;
constexpr size_t WS_MODV = 1 * MiB;
constexpr size_t WS_ROPE = 4 * MiB;
constexpr size_t WS_BG = 6 * MiB;
constexpr size_t WS_WBA = 8 * MiB;
constexpr size_t WS_SP8 = 8 * MiB + 256 * 1024;
constexpr size_t WS_W13 = 16 * MiB;
constexpr size_t W13_BYTES = (size_t)2 * DFF * D * 2;
constexpr size_t WS_W2 = WS_W13 + 4 * W13_BYTES;
constexpr size_t W2_BYTES = (size_t)D * DFF * 2;
constexpr size_t WS_WEVIN = WS_W2 + 4 * W2_BYTES;
constexpr size_t WS_WEVOUT = WS_WEVIN + (size_t)8192 * D * 2;
constexpr size_t WS_WODIN = WS_WEVOUT + (size_t)D * D * 2;
constexpr size_t WS_WGATE = WS_WODIN + (size_t)4096 * D * 2;
constexpr size_t WS_WODOUT = WS_WGATE + (size_t)4096 * 256 * 2;
constexpr size_t WS_H = WS_WODOUT + (size_t)D * D * 2;
constexpr size_t WS_Y = WS_H + (size_t)M * D * 2;
constexpr size_t WS_BIG = WS_Y + (size_t)M * D * 2;
constexpr size_t WS_ADEC = WS_BIG + 256 * MiB;
constexpr size_t WS_EXT = WS_BIG + 512 * MiB;
constexpr size_t WS_END = WS_EXT + 192 * MiB;
static_assert(WS_W13 % (1u << 20) == 0 && WS_H == 346 * MiB && WS_END == 1306 * MiB, "d_ws map");
constexpr int CW_BAR = 4096;

constexpr int RING_BYTES = 131072;
constexpr int WAVE_LDS = 19712;
constexpr int ADA_ACC_OFF = 131072;
constexpr int LDSCTL_OFF = 157696, MISC_OFF = LDSCTL_OFF + 320;
constexpr int LDS_BYTES = 158720;
static_assert(MISC_OFF + 128 <= LDS_BYTES && 8 * WAVE_LDS <= LDSCTL_OFF, "LDS map");

#define GAS __attribute__((address_space(1)))
#define LAS __attribute__((address_space(3)))
typedef unsigned short bf16;
typedef unsigned v4u __attribute__((ext_vector_type(4)));
typedef unsigned v2u __attribute__((ext_vector_type(2)));
typedef float f32x4 __attribute__((ext_vector_type(4)));
typedef GAS unsigned gu32;
#define RLX_AGENT __ATOMIC_RELAXED, __HIP_MEMORY_SCOPE_AGENT
#define LDS_WAIT() asm volatile("s_waitcnt lgkmcnt(0)" ::: "memory")
#define VM_WAIT() asm volatile("s_waitcnt vmcnt(0)" ::: "memory")
using pg8::cvt_pk_bf16; using pg8::bfl; using pg8::bfh; using pg8::fast_sigmoid;

#define XB_TMO      128
#define XB_XCNT(j)  (256  + 64 * (j))
#define XB_XSUB(j)  (1280 + 64 * (j))
#define XB_XGEN(j)  (2304 + 64 * (j))
#define XB_TOP      3328
#define XB_TOPGEN   3392
#define XCD_BAR_WORDS 3456
#define XB_SPIN_CAP (1u << 18)

__device__ __forceinline__ unsigned xb_ld(unsigned* p)              { return __hip_atomic_load(p, __ATOMIC_RELAXED, __HIP_MEMORY_SCOPE_AGENT); }
__device__ __forceinline__ unsigned xb_add(unsigned* p, unsigned v) { return __hip_atomic_fetch_add(p, v, __ATOMIC_RELAXED, __HIP_MEMORY_SCOPE_AGENT); }
__device__ __forceinline__ unsigned xb_xcc_id() { return (unsigned)__builtin_amdgcn_s_getreg((3 << 11) | 20) & 0xFu; }
#define XB_SPIN(cond, bar) do { unsigned _sp = 0; while (cond) { __builtin_amdgcn_s_sleep(1); \
    if ((++_sp & 255u) == 0u) { if (xb_ld(&(bar)[XB_TMO])) break; if (_sp > XB_SPIN_CAP) { atomicAdd(&(bar)[XB_TMO], 1u); break; } } } } while (0)

struct XcdBarrier {
    unsigned* bar; unsigned x;
    volatile LAS unsigned* st;
};

__device__ __forceinline__ XcdBarrier xcd_barrier_post(unsigned* bar, volatile LAS unsigned* st) {
    XcdBarrier b; b.bar = bar; b.x = xb_xcc_id(); b.st = st;
    if (threadIdx.x == 0) (void)xb_add(&bar[XB_XCNT(b.x)], 1u);
    return b;
}
__device__ __forceinline__ void xcd_barrier_complete(unsigned* bar, unsigned x, unsigned& nloc, unsigned& nx) {
    const unsigned G = gridDim.x * gridDim.y * gridDim.z;
    unsigned sum, cnt, mine, sp = 0u;
    for (;;) {
        sum = 0u; cnt = 0u; mine = 0u;
#pragma unroll
        for (unsigned j = 0; j < 16; ++j) { const unsigned c = xb_ld(&bar[XB_XCNT(j)]); sum += c; cnt += (c > 0u) ? 1u : 0u; mine = (j == x) ? c : mine; }
        if (sum == G) break;
        __builtin_amdgcn_s_sleep(1);
        if ((++sp & 255u) == 0u) { if (xb_ld(&bar[XB_TMO])) break; if (sp > XB_SPIN_CAP) { atomicAdd(&bar[XB_TMO], 1u); break; } }
    }
    nloc = mine > 0u ? mine : 1u; nx = cnt > 0u ? cnt : 1u;
}

__device__ __forceinline__ void xcd_barrier(const XcdBarrier& b) {
    asm volatile("s_waitcnt vmcnt(0)" ::: "memory");
    __syncthreads();
    if (threadIdx.x == 0) {
        unsigned* bar = b.bar;
        __builtin_amdgcn_s_waitcnt(0);
        unsigned nloc = b.st[0], nx = b.st[1];
        if (nloc == 0u) { xcd_barrier_complete(bar, b.x, nloc, nx); b.st[0] = nloc; b.st[1] = nx; }
        const unsigned old = xb_add(&bar[XB_XSUB(b.x)], 1u);
        const unsigned gen = old / nloc;
        if (old + 1u == (gen + 1u) * nloc) {
            __builtin_amdgcn_fence(__ATOMIC_RELEASE, "agent");
            asm volatile("s_waitcnt vmcnt(0)" ::: "memory");
            const unsigned og = xb_add(&bar[XB_TOP], 1u);
            const unsigned tg = og / nx;
            if (og + 1u == (tg + 1u) * nx) xb_add(&bar[XB_TOPGEN], 1u);
            else XB_SPIN(xb_ld(&bar[XB_TOPGEN]) == tg, bar);
            __builtin_amdgcn_fence(__ATOMIC_ACQUIRE, "agent");
            xb_add(&bar[XB_XGEN(b.x)], 1u);
            asm volatile("s_waitcnt vmcnt(0)" ::: "memory");
        } else {
            XB_SPIN(xb_ld(&bar[XB_XGEN(b.x)]) == gen, bar);
            __builtin_amdgcn_fence(__ATOMIC_ACQUIRE, "agent");
            asm volatile("s_waitcnt vmcnt(0)" ::: "memory");
        }
    }
    __syncthreads();
}

struct Args { const float* in[24]; float* out; unsigned char* ws; int ph_lo, ph_hi; };
struct Frame {
    LAS unsigned char* lds; volatile LAS unsigned* MISC; gu32* ctl;
    int tid, lane, wave, vcu, G;
};
__device__ __forceinline__ float wave_sum(float v) {
#pragma unroll
    for (int o = 1; o < 64; o <<= 1) v += __shfl_xor(v, o);
    return v;
}
__device__ __forceinline__ float silu_f(float x) { return x * fast_sigmoid(x); }
__device__ __forceinline__ void unpack8(const v4u w, float (&f)[8]) { f[0] = bfl(w.x); f[1] = bfh(w.x); f[2] = bfl(w.y); f[3] = bfh(w.y); f[4] = bfl(w.z); f[5] = bfh(w.z); f[6] = bfl(w.w); f[7] = bfh(w.w); }
__device__ __forceinline__ v4u pack8(const float (&f)[8]) { v4u w; w.x = cvt_pk_bf16(f[0], f[1]); w.y = cvt_pk_bf16(f[2], f[3]); w.z = cvt_pk_bf16(f[4], f[5]); w.w = cvt_pk_bf16(f[6], f[7]); return w; }

__device__ __forceinline__ void transpose_item(const float* W, int ldw, int k0, int n0, bf16* WT, int ldt, int drow0, LAS float* scr, int lane) {
#pragma unroll 8
    for (int i = 0; i < 32; ++i) { const int kk = 2 * i + (lane >> 5); scr[kk * 33 + (lane & 31)] = W[(size_t)(k0 + kk) * ldw + n0 + (lane & 31)]; }
    LDS_WAIT(); asm volatile("" ::: "memory");
    const int c = lane & 7;
#pragma unroll
    for (int j = 0; j < 4; ++j) { const int n = (lane >> 3) + 8 * j; const LAS float* s = scr + (8 * c) * 33 + n;
        v4u o; o.x = cvt_pk_bf16(s[0 * 33], s[1 * 33]); o.y = cvt_pk_bf16(s[2 * 33], s[3 * 33]); o.z = cvt_pk_bf16(s[4 * 33], s[5 * 33]); o.w = cvt_pk_bf16(s[6 * 33], s[7 * 33]);
        *(GAS v4u*)(WT + (size_t)(drow0 + n) * ldt + k0 + 8 * c) = o; }
    LDS_WAIT(); asm volatile("" ::: "memory");
}
__device__ __forceinline__ void p0_prologue(Frame& F, const Args& a) {
    unsigned char* ws = a.ws;
    {
        LAS float* sc = (LAS float*)F.lds;
        LAS float* accl = (LAS float*)(F.lds + ADA_ACC_OFF);
        const float* c = a.in[1];
        for (int idx = F.tid; idx < NB * D; idx += NWAVES * 64) { const int b = idx >> 11, k = idx & 2047; const float v = c[idx]; sc[k * 16 + b] = v / (1.0f + __expf(-v)); }
        __syncthreads();
        float* modv = (float*)(ws + WS_MODV);
        for (int u = blockIdx.x; u < 2 * (NADA / 64); u += F.G) {
            const int layer = u / (NADA / 64), n0 = (u % (NADA / 64)) * 64;
            for (int e = F.tid; e < 1024; e += NWAVES * 64) accl[e] = 0.f;
            __syncthreads();
            const float* W = a.in[2] + (size_t)layer * D * NADA + n0 + F.lane;
            float acc[16];
#pragma unroll
            for (int b = 0; b < 16; ++b) acc[b] = 0.f;
            const int kbeg = F.wave * 256;
#pragma unroll 4
            for (int kk = 0; kk < 256; ++kk) { const int k = kbeg + kk; const float w = W[(size_t)k * NADA];
#pragma unroll
                for (int i = 0; i < 4; ++i) { const f32x4 s4 = *(const LAS f32x4*)(sc + k * 16 + 4 * i);
                    acc[4 * i + 0] += w * s4[0]; acc[4 * i + 1] += w * s4[1]; acc[4 * i + 2] += w * s4[2]; acc[4 * i + 3] += w * s4[3]; } }
            for (int w = 0; w < NWAVES; ++w) {
                if (F.wave == w) {
#pragma unroll
                    for (int b = 0; b < 16; ++b) accl[b * 64 + F.lane] += acc[b];
                }
                __syncthreads();
            }
            for (int e = F.tid; e < 1024; e += NWAVES * 64) { const int b = e >> 6, col = e & 63, n = n0 + col;
                const float v = accl[e] + a.in[3][layer * NADA + n];
                const int s = n / (3 * D), j = (n / D) % 3, d = n % D, q = layer * 3 + s;
                float o = v;
                if (j == 1) o = a.in[4][(size_t)q * D + d] * (1.0f + v);
                if (j == 2) o = (s == 1 ? 1.0f : 0.5f) * a.in[5][(size_t)q * D + d] * (1.0f + v);
                modv[((size_t)(q * 3 + j) * 16 + b) * D + d] = o; }
            __syncthreads();
        }
    }
    const int gw = F.vcu * NWAVES + F.wave, NGW = F.G * NWAVES;
    {
        LAS float* scr = (LAS float*)(F.lds + F.wave * 16384);
        constexpr int I13 = 32 * 352, I2 = 88 * 64, IEV = 32 * 256, IEO = 32 * 64, IOI = 32 * 128, IG = 16 * 32, IOO = 32 * 64;
        constexpr int NITEMS = 4 * I13 + 4 * I2 + IEV + IEO + IOI + IG + IOO;
        for (int it = gw; it < NITEMS; it += NGW) {
            int r = it;
            if (r < 4 * I13) { const int mat = r / I13; r -= mat * I13; const int kb = r / 352, nb = r % 352, n0 = 32 * nb;
                const int dr = n0 < DFF ? (n0 >> 7) * 256 + (n0 & 127) : ((n0 - DFF) >> 7) * 256 + 128 + ((n0 - DFF) & 127);
                transpose_item(a.in[6] + (size_t)mat * D * 2 * DFF, 2 * DFF, 64 * kb, n0, (bf16*)(ws + WS_W13 + mat * W13_BYTES), D, dr, scr, F.lane); continue; }
            r -= 4 * I13;
            if (r < 4 * I2) { const int mat = r / I2; r -= mat * I2; const int kb = r / 64, nb = r % 64;
                transpose_item(a.in[7] + (size_t)mat * DFF * D, D, 64 * kb, 32 * nb, (bf16*)(ws + WS_W2 + mat * W2_BYTES), DFF, 32 * nb, scr, F.lane); continue; }
            r -= 4 * I2;
            if (r < IEV) { const int kb = r / 256, nb = r % 256, d0 = 32 * nb, n0 = d0 + (d0 >= 3072 ? 16 : 0);
                transpose_item(a.in[8], EVW, 64 * kb, n0, (bf16*)(ws + WS_WEVIN), D, d0, scr, F.lane); continue; }
            r -= IEV;
            if (r < IEO) { const int kb = r / 64, nb = r % 64;
                transpose_item(a.in[14], D, 64 * kb, 32 * nb, (bf16*)(ws + WS_WEVOUT), D, 32 * nb, scr, F.lane); continue; }
            r -= IEO;
            if (r < IOI) { const int kb = r / 128, nb = r % 128;
                transpose_item(a.in[15], 2 * D, 64 * kb, 32 * nb, (bf16*)(ws + WS_WODIN), D, 32 * nb, scr, F.lane); continue; }
            r -= IOI;
            if (r < IG) { const int mat = r / 32; r -= mat * 32; const int gsel = mat >> 3, blk = mat & 7, kb = r / 8, nb = r % 8, j0 = 32 * nb;
                const int dr = (blk * 2 + (j0 >> 7)) * 256 + gsel * 128 + (j0 & 127);
                transpose_item((gsel ? a.in[20] : a.in[18]) + (size_t)blk * 65536, 256, 64 * kb, j0, (bf16*)(ws + WS_WGATE), 256, dr, scr, F.lane); continue; }
            r -= IG;
            { const int kb = r / 64, nb = r % 64;
                transpose_item(a.in[23], D, 64 * kb, 32 * nb, (bf16*)(ws + WS_WODOUT), D, 32 * nb, scr, F.lane); }
        }
    }
    const int gt = (F.vcu * NWAVES + F.wave) * 64 + F.lane, NGT = F.G * NWAVES * 64;
    { float* wba = (float*)(ws + WS_WBA);
      for (int i = gt; i < 16 * D; i += NGT) { const int o = i >> 11, k = i & 2047; wba[i] = a.in[8][(size_t)k * EVW + 3072 + o]; } }
    { float* sp8 = (float*)(ws + WS_SP8);
      for (int i = gt; i < D; i += NGT) sp8[i] = -8.0f * log1pf(expf(-a.in[22][i])); }
    { float* rc = (float*)(ws + WS_ROPE); float* rs = rc + T * 128;
      for (int i = gt; i < T * 128; i += NGT) { const int t = i >> 7, f = i & 127;
          const double ang = (double)t * pow(10000.0, -(double)f / 128.0); rc[i] = (float)cos(ang); rs[i] = (float)sin(ang); } }
}

template <bool DO_BA>
__device__ __forceinline__ void norm_pass(Frame& F, const Args& a, const int q) {
    unsigned char* ws = a.ws;
    const bool has_prev = q > 0, has_next = q < 6;
    const float* xold = (q <= 1) ? a.in[0] : a.out;
    float* xnew = a.out;
    const bf16* Y = (const bf16*)(ws + WS_Y); bf16* H = (bf16*)(ws + WS_H);
    const float* modv = (const float*)(ws + WS_MODV);
    LAS float* wl = (LAS float*)F.lds;
    if (DO_BA) {
        const float* wba = (const float*)(ws + WS_WBA);
        for (int i = F.tid; i < 16 * D; i += NWAVES * 64) { const int o = i >> 11, col = i & 2047, j = col >> 9, l = (col >> 3) & 63, hf = (col >> 2) & 1, e = col & 3;
            wl[o * 2048 + j * 512 + hf * 256 + l * 4 + e] = wba[i]; }
        __syncthreads();
    }
    const int gw = F.vcu * NWAVES + F.wave, l = F.lane;
    for (int r = 0; r < 16; ++r) {
        const int m = gw * 16 + r, b = m >> 11;
        const size_t ro = (size_t)m * D + 8 * l;
        float x[4][8];
#pragma unroll
        for (int j = 0; j < 4; ++j) { const f32x4 x0 = *(const f32x4*)(xold + ro + 512 * j), x1 = *(const f32x4*)(xold + ro + 512 * j + 4);
            x[j][0] = x0[0]; x[j][1] = x0[1]; x[j][2] = x0[2]; x[j][3] = x0[3]; x[j][4] = x1[0]; x[j][5] = x1[1]; x[j][6] = x1[2]; x[j][7] = x1[3]; }
        if (has_prev) {
            float y[4][8]; float ss = 0.f;
#pragma unroll
            for (int j = 0; j < 4; ++j) { const v4u yw = *(const v4u*)(Y + ro + 512 * j); unpack8(yw, y[j]);
#pragma unroll
                for (int e = 0; e < 8; ++e) ss += y[j][e] * y[j][e]; }
            const float ry = 1.0f / sqrtf(wave_sum(ss) * (1.0f / D) + EPS);
            const float* al = modv + ((size_t)((q - 1) * 3 + 2) * 16 + b) * D + 8 * l;
#pragma unroll
            for (int j = 0; j < 4; ++j) { const f32x4 a0 = *(const f32x4*)(al + 512 * j), a1 = *(const f32x4*)(al + 512 * j + 4);
#pragma unroll
                for (int e = 0; e < 4; ++e) { x[j][e] += a0[e] * (y[j][e] * ry); x[j][4 + e] += a1[e] * (y[j][4 + e] * ry); }
                *(f32x4*)(xnew + ro + 512 * j) = (f32x4){x[j][0], x[j][1], x[j][2], x[j][3]}; *(f32x4*)(xnew + ro + 512 * j + 4) = (f32x4){x[j][4], x[j][5], x[j][6], x[j][7]}; }
        }
        if (has_next) {
            float ss = 0.f;
#pragma unroll
            for (int j = 0; j < 4; ++j)
#pragma unroll
                for (int e = 0; e < 8; ++e) ss += x[j][e] * x[j][e];
            const float rx = 1.0f / sqrtf(wave_sum(ss) * (1.0f / D) + EPS);
            const float* Bv = modv + ((size_t)(q * 3 + 1) * 16 + b) * D + 8 * l;
            const float* Cv = modv + ((size_t)(q * 3 + 0) * 16 + b) * D + 8 * l;
#pragma unroll
            for (int j = 0; j < 4; ++j) { const f32x4 b0 = *(const f32x4*)(Bv + 512 * j), b1 = *(const f32x4*)(Bv + 512 * j + 4), c0 = *(const f32x4*)(Cv + 512 * j), c1 = *(const f32x4*)(Cv + 512 * j + 4);
#pragma unroll
                for (int e = 0; e < 4; ++e) { x[j][e] = x[j][e] * rx * b0[e] + c0[e]; x[j][4 + e] = x[j][4 + e] * rx * b1[e] + c1[e]; }
                *(v4u*)(H + ro + 512 * j) = pack8(x[j]); }
            if (DO_BA) {
                float mine = 0.f;
#pragma unroll
                for (int o = 0; o < 16; ++o) { float p = 0.f;
#pragma unroll
                    for (int j = 0; j < 4; ++j) { const f32x4 w0 = *(const LAS f32x4*)(wl + o * 2048 + j * 512 + l * 4), w1 = *(const LAS f32x4*)(wl + o * 2048 + j * 512 + 256 + l * 4);
                        p += x[j][0] * w0[0] + x[j][1] * w0[1] + x[j][2] * w0[2] + x[j][3] * w0[3] + x[j][4] * w1[0] + x[j][5] * w1[1] + x[j][6] * w1[2] + x[j][7] * w1[3]; }
                    p = wave_sum(p); mine = (l == o) ? p : mine; }
                if (l < 16) { float v;
                    if (l < 8) v = 1.0f / (1.0f + expf(-mine));
                    else { const float z = mine + a.in[11][l - 8]; const float sp = z > 20.f ? z : log1pf(expf(z)); v = -expf(a.in[10][l - 8]) * sp; }
                    ((float*)(ws + WS_BG))[(size_t)m * 16 + l] = v; }
            }
        }
    }
}

__device__ __forceinline__ void ev_prep(Frame& F, const Args& a) {
    unsigned char* ws = a.ws;
    bf16* P = (bf16*)(ws + WS_BIG); bf16* QKV = (bf16*)(ws + WS_EXT);
    const float* cw = a.in[9];
    const float* rc = (const float*)(ws + WS_ROPE); const float* rs = rc + T * 128;
    const int gw = F.vcu * NWAVES + F.wave, l = F.lane;
    for (int r = 0; r < 16; ++r) {
        const int m = gw * 16 + r, t = m & (T - 1);
#pragma unroll
        for (int g = 0; g < 6; ++g) {
            const int c0 = 512 * g + 8 * l;
            float acc[8];
#pragma unroll
            for (int e = 0; e < 8; ++e) acc[e] = 0.f;
#pragma unroll
            for (int tap = 0; tap < 4; ++tap) {
                if (t - 3 + tap >= 0) {
                    const v4u pw = *(const v4u*)(P + (size_t)(m - 3 + tap) * 8192 + c0); float pv[8]; unpack8(pw, pv);
                    const f32x4 w0 = *(const f32x4*)(cw + tap * 3072 + c0), w1 = *(const f32x4*)(cw + tap * 3072 + c0 + 4);
#pragma unroll
                    for (int e = 0; e < 4; ++e) { acc[e] += w0[e] * pv[e]; acc[4 + e] += w1[e] * pv[4 + e]; }
                }
            }
#pragma unroll
            for (int e = 0; e < 8; ++e) acc[e] = silu_f(acc[e]);
            if (g < 4) {
                float ss = 0.f;
#pragma unroll
                for (int e = 0; e < 8; ++e) ss += acc[e] * acc[e];
                ss += __shfl_xor(ss, 1); ss += __shfl_xor(ss, 2); ss += __shfl_xor(ss, 4); ss += __shfl_xor(ss, 8);
                float rn = 1.0f / sqrtf(ss + EPS);
                if (g < 2) rn *= 0.08838834764831845f;
#pragma unroll
                for (int e = 0; e < 8; ++e) acc[e] *= rn;
            }
            *(v4u*)(QKV + (size_t)m * 3072 + c0) = pack8(acc);
        }
        {
            const int hh = l >> 4, i0 = (l & 15) * 8;
            const f32x4 cs0 = *(const f32x4*)(rc + t * 128 + i0), cs1 = *(const f32x4*)(rc + t * 128 + i0 + 4);
            const f32x4 sn0 = *(const f32x4*)(rs + t * 128 + i0), sn1 = *(const f32x4*)(rs + t * 128 + i0 + 4);
            const float cs[8] = {cs0[0], cs0[1], cs0[2], cs0[3], cs1[0], cs1[1], cs1[2], cs1[3]};
            const float sn[8] = {sn0[0], sn0[1], sn0[2], sn0[3], sn1[0], sn1[1], sn1[2], sn1[3]};
#pragma unroll
            for (int w = 0; w < 2; ++w) {
                bf16* base = P + (size_t)m * 8192 + 4096 + 1024 * w + 256 * hh + i0;
                const float scl = w ? 0.0625f : 1.0f;
                float x1[8], x2[8], o1[8], o2[8];
                unpack8(*(const v4u*)base, x1); unpack8(*(const v4u*)(base + 128), x2);
#pragma unroll
                for (int e = 0; e < 8; ++e) { o1[e] = (x1[e] * cs[e] - x2[e] * sn[e]) * scl; o2[e] = (x2[e] * cs[e] + x1[e] * sn[e]) * scl; }
                *(v4u*)base = pack8(o1); *(v4u*)(base + 128) = pack8(o2);
            }
        }
    }
}

__device__ __forceinline__ float quad_sum(float v) {
    v += __builtin_bit_cast(float, __builtin_amdgcn_mov_dpp(__builtin_bit_cast(int, v), 0xB1, 0xF, 0xF, true));
    v += __builtin_bit_cast(float, __builtin_amdgcn_mov_dpp(__builtin_bit_cast(int, v), 0x4E, 0xF, 0xF, true));
    return v;
}
__device__ __forceinline__ void ev_recur(Frame& F, const Args& a) {
    unsigned char* ws = a.ws;
    const bf16* P = (const bf16*)(ws + WS_BIG); const bf16* QKV = (const bf16*)(ws + WS_EXT); const float* BG = (const float*)(ws + WS_BG);
    bf16* O = (bf16*)(ws + WS_Y);
    const int l = F.lane, col = l >> 2, kq = l & 3;
    LAS unsigned char* reg = F.lds + F.wave * WAVE_LDS;
    LAS float* vl = (LAS float*)(reg + 18432); LAS float* bgl = (LAS float*)(reg + 18432 + 1024);
    if (F.wave < 4) {
        const int uw = blockIdx.x * 4 + F.wave, bh = uw >> 3, vc = uw & 7, b = bh >> 3, h = bh & 7;
        float S[32];
#pragma unroll
        for (int i = 0; i < 32; ++i) S[i] = 0.f;
        v4u pf[8]; v4u pfv; float pfb;
#define GDN_ISSUE(t0) do { const size_t m0 = (size_t)b * T + (t0); \
        _Pragma("unroll") for (int i = 0; i < 8; ++i) { const int idx = l + 64 * i, tok = idx >> 5, wi = idx & 31; \
            pf[i] = *(const v4u*)(QKV + (m0 + tok) * 3072 + (wi >> 4) * 1024 + 128 * h + 8 * (wi & 15)); } \
        pfv = *(const v4u*)(QKV + (m0 + ((l & 31) >> 1)) * 3072 + 2048 + 128 * h + 16 * vc + 8 * (l & 1)); \
        pfb = BG[(m0 + ((l & 31) >> 1)) * 16 + (l & 1) * 8 + h]; } while (0)
        GDN_ISSUE(0);
        for (int t0 = 0; t0 < T; t0 += 16) {
#pragma unroll
            for (int i = 0; i < 8; ++i) { const int idx = l + 64 * i, tok = idx >> 5, wi = idx & 31; float f[8]; unpack8(pf[i], f);
                LAS float* dst = (LAS float*)(reg + tok * 1152 + (wi >> 4) * 576 + ((wi & 15) >> 2) * 144 + (wi & 3) * 32);
                *(LAS f32x4*)dst = (f32x4){f[0], f[1], f[2], f[3]}; *(LAS f32x4*)(dst + 4) = (f32x4){f[4], f[5], f[6], f[7]}; }
            if (l < 32) { float f[8]; unpack8(pfv, f); LAS float* dst = vl + (l >> 1) * 16 + 8 * (l & 1);
                *(LAS f32x4*)dst = (f32x4){f[0], f[1], f[2], f[3]}; *(LAS f32x4*)(dst + 4) = (f32x4){f[4], f[5], f[6], f[7]};
                bgl[(l >> 1) * 2 + (l & 1)] = pfb; }
            LDS_WAIT();
            if (t0 + 16 < T) GDN_ISSUE(t0 + 16);
            for (int tok = 0; tok < 16; ++tok) {
                const LAS float* qp = (const LAS float*)(reg + tok * 1152 + kq * 144);
                const LAS float* kp = (const LAS float*)(reg + tok * 1152 + 576 + kq * 144);
                const float v = vl[tok * 16 + col], beta = bgl[tok * 2], eg = __expf(bgl[tok * 2 + 1]);
                float kk[32]; float ksp[4] = {0.f, 0.f, 0.f, 0.f};
#pragma unroll
                for (int i = 0; i < 8; ++i) { const f32x4 k4 = *(const LAS f32x4*)(kp + 4 * i); kk[4 * i] = k4[0]; kk[4 * i + 1] = k4[1]; kk[4 * i + 2] = k4[2]; kk[4 * i + 3] = k4[3]; }
#pragma unroll
                for (int i = 0; i < 32; ++i) ksp[i & 3] = fmaf(kk[i], S[i], ksp[i & 3]);
                float ks = (ksp[0] + ksp[1]) + (ksp[2] + ksp[3]);
                ks = quad_sum(ks);
                const float cc = beta * (v - eg * ks);
                float op[4] = {0.f, 0.f, 0.f, 0.f};
#pragma unroll
                for (int i = 0; i < 8; ++i) { const f32x4 q4 = *(const LAS f32x4*)(qp + 4 * i);
#pragma unroll
                    for (int e = 0; e < 4; ++e) { const float s = fmaf(kk[4 * i + e], cc, eg * S[4 * i + e]); S[4 * i + e] = s; op[e] = fmaf(q4[e], s, op[e]); } }
                float o = (op[0] + op[1]) + (op[2] + op[3]);
                o = quad_sum(o);
                if (kq == 0) O[((size_t)b * T + t0 + tok) * D + 128 * h + 16 * vc + col] = (bf16)(cvt_pk_bf16(o, 0.f) & 0xffffu);
            }
        }
#undef GDN_ISSUE
    } else {
        const int uw = blockIdx.x * 4 + (F.wave - 4), bh = uw >> 4, vc = uw & 15, b = bh >> 2, h = bh & 3;
        const float gamma = 1.0f - exp2f(-5.0f - (float)h);
        float S[64];
#pragma unroll
        for (int i = 0; i < 64; ++i) S[i] = 0.f;
        v4u pf[8]; v4u pfv;
#define RET_ISSUE(t0) do { const size_t m0 = (size_t)b * T + (t0); \
        _Pragma("unroll") for (int i = 0; i < 8; ++i) pf[i] = *(const v4u*)(P + (m0 + i) * 8192 + 4096 + (l >> 5) * 1024 + 256 * h + 8 * (l & 31)); \
        pfv = *(const v4u*)(P + (m0 + ((l & 15) >> 1)) * 8192 + 6144 + 256 * h + 16 * vc + 8 * (l & 1)); } while (0)
        RET_ISSUE(0);
        for (int t0 = 0; t0 < T; t0 += 8) {
#pragma unroll
            for (int i = 0; i < 8; ++i) { float f[8]; unpack8(pf[i], f);
                LAS float* dst = (LAS float*)(reg + i * 2176 + (l >> 5) * 1088 + ((l & 31) >> 3) * 272 + (l & 7) * 32);
                *(LAS f32x4*)dst = (f32x4){f[0], f[1], f[2], f[3]}; *(LAS f32x4*)(dst + 4) = (f32x4){f[4], f[5], f[6], f[7]}; }
            if (l < 16) { float f[8]; unpack8(pfv, f); LAS float* dst = vl + (l >> 1) * 16 + 8 * (l & 1);
                *(LAS f32x4*)dst = (f32x4){f[0], f[1], f[2], f[3]}; *(LAS f32x4*)(dst + 4) = (f32x4){f[4], f[5], f[6], f[7]}; }
            LDS_WAIT();
            if (t0 + 8 < T) RET_ISSUE(t0 + 8);
            for (int tok = 0; tok < 8; ++tok) {
                const LAS float* qp = (const LAS float*)(reg + tok * 2176 + kq * 272);
                const LAS float* kp = (const LAS float*)(reg + tok * 2176 + 1088 + kq * 272);
                const float v = vl[tok * 16 + col];
                float op[4] = {0.f, 0.f, 0.f, 0.f};
#pragma unroll
                for (int i = 0; i < 16; ++i) { const f32x4 k4 = *(const LAS f32x4*)(kp + 4 * i), q4 = *(const LAS f32x4*)(qp + 4 * i);
#pragma unroll
                    for (int e = 0; e < 4; ++e) { const float s = fmaf(k4[e], v, gamma * S[4 * i + e]); S[4 * i + e] = s; op[e] = fmaf(q4[e], s, op[e]); } }
                float o = (op[0] + op[1]) + (op[2] + op[3]);
                o = quad_sum(o);
                if (kq == 0) O[((size_t)b * T + t0 + tok) * D + 1024 + 256 * h + 16 * vc + col] = (bf16)(cvt_pk_bf16(o, 0.f) & 0xffffu);
            }
        }
#undef RET_ISSUE
    }
}

__device__ __forceinline__ void ev_post(Frame& F, const Args& a) {
    unsigned char* ws = a.ws;
    const bf16* P = (const bf16*)(ws + WS_BIG); const bf16* O = (const bf16*)(ws + WS_Y); bf16* OM = (bf16*)(ws + WS_H);
    const int gw = F.vcu * NWAVES + F.wave, l = F.lane;
    for (int r = 0; r < 16; ++r) {
        const int m = gw * 16 + r;
#pragma unroll
        for (int j = 0; j < 4; ++j) {
            const int c0 = 512 * j + 8 * l;
            float o[8], z[8]; unpack8(*(const v4u*)(O + (size_t)m * D + c0), o);
            float ss = 0.f;
#pragma unroll
            for (int e = 0; e < 8; ++e) ss += o[e] * o[e];
            ss += __shfl_xor(ss, 1); ss += __shfl_xor(ss, 2); ss += __shfl_xor(ss, 4); ss += __shfl_xor(ss, 8);
            float rn; const float* gn;
            if (j < 2) { rn = 1.0f / sqrtf(ss * (1.0f / 128.0f) + EPS); gn = a.in[12] + (c0 & 127); unpack8(*(const v4u*)(P + (size_t)m * 8192 + 3072 + c0), z); }
            else { ss += __shfl_xor(ss, 16); rn = 1.0f / sqrtf(ss * (1.0f / 256.0f) + EPS); gn = a.in[13] + (c0 - 1024); unpack8(*(const v4u*)(P + (size_t)m * 8192 + 7168 + (c0 - 1024)), z); }
            const f32x4 g0 = *(const f32x4*)gn, g1 = *(const f32x4*)(gn + 4);
            const float gg[8] = {g0[0], g0[1], g0[2], g0[3], g1[0], g1[1], g1[2], g1[3]};
#pragma unroll
            for (int e = 0; e < 8; ++e) o[e] = o[e] * rn * gg[e] * silu_f(z[e]);
            *(v4u*)(OM + (size_t)m * D + c0) = pack8(o);
        }
    }
}

__device__ __forceinline__ void od_conv(Frame& F, const Args& a) {
    unsigned char* ws = a.ws;
    const bf16* P1 = (const bf16*)(ws + WS_BIG); bf16* XC = (bf16*)(ws + WS_H);
    const float* cw = a.in[16]; const float* cb = a.in[17];
    const int gw = F.vcu * NWAVES + F.wave, l = F.lane;
    for (int r = 0; r < 16; ++r) {
        const int m = gw * 16 + r, t = m & (T - 1);
#pragma unroll
        for (int j = 0; j < 4; ++j) {
            const int c0 = 512 * j + 8 * l;
            const f32x4 b0 = *(const f32x4*)(cb + c0), b1 = *(const f32x4*)(cb + c0 + 4);
            float acc[8] = {b0[0], b0[1], b0[2], b0[3], b1[0], b1[1], b1[2], b1[3]};
#pragma unroll
            for (int tap = 0; tap < 4; ++tap) {
                if (t - 3 + tap >= 0) {
                    float pv[8]; unpack8(*(const v4u*)(P1 + (size_t)(m - 3 + tap) * 4096 + 2048 + c0), pv);
                    const f32x4 w0 = *(const f32x4*)(cw + tap * 2048 + c0), w1 = *(const f32x4*)(cw + tap * 2048 + c0 + 4);
#pragma unroll
                    for (int e = 0; e < 4; ++e) { acc[e] += w0[e] * pv[e]; acc[4 + e] += w1[e] * pv[4 + e]; }
                }
            }
            *(v4u*)(XC + (size_t)m * D + c0) = pack8(acc);
        }
    }
}
__device__ __forceinline__ float gelu_tanh(float y) {
    const float u = 0.7978845608028654f * (y + 0.044715f * y * y * y);
    const float th = 1.0f - 2.0f * __builtin_amdgcn_rcpf(__expf(2.0f * u) + 1.0f);
    return 0.5f * y * (1.0f + th);
}
__device__ __forceinline__ void od_scan(Frame& F, const Args& a) {
    unsigned char* ws = a.ws;
    const bf16* P1 = (const bf16*)(ws + WS_BIG); const float* ADEC = (const float*)(ws + WS_ADEC); const bf16* INP = (const bf16*)(ws + WS_EXT); bf16* HSY = (bf16*)(ws + WS_H);
    typedef float f32x2 __attribute__((ext_vector_type(2)));
    LAS f32x4* seg = (LAS f32x4*)F.lds;
    const int b = blockIdx.x >> 4, c = (blockIdx.x & 15) * 128 + 2 * F.lane;
    const size_t m0 = (size_t)b * T + (size_t)F.wave * 256;
    float A0 = 1.f, A1 = 1.f, h0 = 0.f, h1 = 0.f;
    for (int t0 = 0; t0 < 256; t0 += 16) {
        f32x2 av[16]; unsigned iv[16];
#pragma unroll
        for (int i = 0; i < 16; ++i) { const size_t m = m0 + t0 + i; av[i] = *(const f32x2*)(ADEC + m * D + c); iv[i] = *(const unsigned*)(INP + m * D + c); }
#pragma unroll
        for (int i = 0; i < 16; ++i) { h0 = fmaf(av[i][0], h0, bfl(iv[i])); h1 = fmaf(av[i][1], h1, bfh(iv[i])); A0 *= av[i][0]; A1 *= av[i][1]; }
    }
    seg[F.wave * 64 + F.lane] = (f32x4){A0, h0, A1, h1};
    __syncthreads();
    h0 = 0.f; h1 = 0.f;
    for (int s = 0; s < F.wave; ++s) { const f32x4 g = seg[s * 64 + F.lane]; h0 = fmaf(g[0], h0, g[1]); h1 = fmaf(g[2], h1, g[3]); }
    for (int t0 = 0; t0 < 256; t0 += 16) {
        f32x2 av[16]; unsigned iv[16], yv[16];
#pragma unroll
        for (int i = 0; i < 16; ++i) { const size_t m = m0 + t0 + i; av[i] = *(const f32x2*)(ADEC + m * D + c); iv[i] = *(const unsigned*)(INP + m * D + c); yv[i] = *(const unsigned*)(P1 + m * 4096 + c); }
#pragma unroll
        for (int i = 0; i < 16; ++i) { const size_t m = m0 + t0 + i; h0 = fmaf(av[i][0], h0, bfl(iv[i])); h1 = fmaf(av[i][1], h1, bfh(iv[i]));
            *(unsigned*)(HSY + m * D + c) = cvt_pk_bf16(h0 * gelu_tanh(bfl(yv[i])), h1 * gelu_tanh(bfh(yv[i]))); }
    }
    __syncthreads();
}

__device__ __forceinline__ bool fresh(Frame& F) { int t = threadIdx.x; asm volatile("" : "+v"(t)); F.tid = t; F.lane = t & 63; return true; }
__global__ void __launch_bounds__(NWAVES * 64, 2) mk_fwd(Args args) {
    extern __shared__ __attribute__((aligned(16))) unsigned char lds[];
    Frame F;
    F.lds = (LAS unsigned char*)lds;
    F.MISC = (volatile LAS unsigned*)(F.lds + MISC_OFF);
    F.tid = threadIdx.x; F.lane = F.tid & 63; F.wave = __builtin_amdgcn_readfirstlane(F.tid >> 6);
    F.G = gridDim.x; { const int bx = blockIdx.x; F.vcu = (F.G % 8 == 0) ? (bx % 8) * (F.G / 8) + bx / 8 : bx; }
    unsigned char* ws = args.ws;
    F.ctl = (gu32*)(ws + WS_CTL);
    for (int u = F.tid; u < (LDS_BYTES - LDSCTL_OFF) / 4; u += NWAVES * 64) ((LAS unsigned*)(F.lds + LDSCTL_OFF))[u] = 0u;
    __syncthreads();
    XcdBarrier bar; bar.bar = (unsigned*)(F.ctl + CW_BAR); bar.x = 0; bar.st = nullptr;
    if (!MK_PER_PHASE) bar = xcd_barrier_post((unsigned*)(F.ctl + CW_BAR), F.MISC + 8);
    const int lo = args.ph_lo, hi = args.ph_hi;
#define IN(k) (lo <= (k) && (k) < hi && fresh(F))
#define GEMM_RUN(...) do { pg8::gemm_phase<__VA_ARGS__>(F.lds, g, S, E); if (PROBE_GEMM_X2) { __syncthreads(); pg8::gemm_phase<__VA_ARGS__>(F.lds, g, S, E); } } while (0)
#define SEAM(k) do { if (IN(k) && IN((k) + 1)) xcd_barrier(bar); } while (0)
    const pg8::bf16_t* Hb = (const pg8::bf16_t*)(ws + WS_H);
    pg8::bf16_t* Yb = (pg8::bf16_t*)(ws + WS_Y);
    pg8::bf16_t* BIGb = (pg8::bf16_t*)(ws + WS_BIG);
#define FFN_PHASES(k, q, wi) \
    if (IN(k)) { norm_pass<false>(F, args, (q)); } SEAM(k); \
    if (IN((k) + 1)) { pg8::Gemm g{Hb, (const pg8::bf16_t*)(ws + WS_W13 + (size_t)(wi) * W13_BYTES), M, 2 * DFF, D, D, 0}; pg8::StaticOrder S; S.init(M, 2 * DFF, F.G, (int)blockIdx.x); \
        pg8::EpiSwiGLU E{BIGb, DFF}; GEMM_RUN(pg8::EpiSwiGLU, pg8::StaticOrder, true, true); } SEAM((k) + 1); \
    if (IN((k) + 2)) { pg8::Gemm g{BIGb, (const pg8::bf16_t*)(ws + WS_W2 + (size_t)(wi) * W2_BYTES), M, D, DFF, DFF, 0}; pg8::StaticOrder S; S.init(M, D, F.G, (int)blockIdx.x); \
        pg8::EpiBf16 E{Yb, D}; GEMM_RUN(pg8::EpiBf16, pg8::StaticOrder, true, true); } SEAM((k) + 2);

    if (IN(0)) { p0_prologue(F, args); if (PROBE_P0_X2) { __syncthreads(); p0_prologue(F, args); } } SEAM(0);
    FFN_PHASES(1, 0, 0)
    if (IN(4)) { norm_pass<true>(F, args, 1); } SEAM(4);
    if (IN(5)) { pg8::Gemm g{Hb, (const pg8::bf16_t*)(ws + WS_WEVIN), M, 8192, D, D, 0}; pg8::StaticOrder S; S.init(M, 8192, F.G, (int)blockIdx.x);
        pg8::EpiBf16 E{BIGb, 8192}; GEMM_RUN(pg8::EpiBf16, pg8::StaticOrder, true, true); } SEAM(5);
    if (IN(6)) { ev_prep(F, args); } SEAM(6);
    if (IN(7)) { ev_recur(F, args); if (PROBE_REC_X2) { __syncthreads(); ev_recur(F, args); } } SEAM(7);
    if (IN(8)) { ev_post(F, args); } SEAM(8);
    if (IN(9)) { pg8::Gemm g{Hb, (const pg8::bf16_t*)(ws + WS_WEVOUT), M, D, D, D, 0}; pg8::StaticOrder S; S.init(M, D, F.G, (int)blockIdx.x);
        pg8::EpiBf16 E{Yb, D}; GEMM_RUN(pg8::EpiBf16, pg8::StaticOrder, true, true); } SEAM(9);
    FFN_PHASES(10, 2, 1)
    FFN_PHASES(13, 3, 2)
    if (IN(16)) { norm_pass<false>(F, args, 4); } SEAM(16);
    if (IN(17)) { pg8::Gemm g{Hb, (const pg8::bf16_t*)(ws + WS_WODIN), M, 4096, D, D, 0}; pg8::StaticOrder S; S.init(M, 4096, F.G, (int)blockIdx.x);
        pg8::EpiBf16 E{BIGb, 4096}; GEMM_RUN(pg8::EpiBf16, pg8::StaticOrder, true, true); } SEAM(17);
    if (IN(18)) { od_conv(F, args); } SEAM(18);
    if (IN(19)) { pg8::Gemm g{Hb, (const pg8::bf16_t*)(ws + WS_WGATE), M, 4096, 256, D, 2}; pg8::StaticOrder S; S.init(M, 4096, F.G, (int)blockIdx.x);
        pg8::EpiGates E{(float*)(ws + WS_ADEC), (pg8::bf16_t*)(ws + WS_EXT), Hb, args.in[19], args.in[21], (const float*)(ws + WS_SP8)};
        GEMM_RUN(pg8::EpiGates, pg8::StaticOrder, true, true); } SEAM(19);
    if (IN(20)) { od_scan(F, args); if (PROBE_REC_X2) { __syncthreads(); od_scan(F, args); } } SEAM(20);
    if (IN(21)) { pg8::Gemm g{Hb, (const pg8::bf16_t*)(ws + WS_WODOUT), M, D, D, D, 0}; pg8::StaticOrder S; S.init(M, D, F.G, (int)blockIdx.x);
        pg8::EpiBf16 E{Yb, D}; GEMM_RUN(pg8::EpiBf16, pg8::StaticOrder, true, true); } SEAM(21);
    FFN_PHASES(22, 5, 3)
    if (IN(25)) { norm_pass<false>(F, args, 6); }
#undef IN
#undef SEAM
#undef FFN_PHASES
}

extern "C" void kernel_launch(void* const* d_in, const int* in_sizes, int n_in, void* d_out, int out_size, void* d_ws, size_t ws_size, hipStream_t stream) {
    static int grid = 0;
    if (grid == 0) {
        if (n_in != 24 || in_sizes[0] != M * D || out_size != M * D || ws_size < WS_END) {
            fprintf(stderr, "kernel_launch: unexpected problem (n_in %d, in0 %d, out %d, ws %zu < %zu); nothing launched\n", n_in, n_in > 0 ? in_sizes[0] : -1, out_size, ws_size, (size_t)WS_END); grid = -1; return; }
        int dev = 0, cus = 0, per_cu = 0;
        if (hipGetDevice(&dev) != hipSuccess || hipDeviceGetAttribute(&cus, hipDeviceAttributeMultiprocessorCount, dev) != hipSuccess) { grid = -1; return; }
        if (hipFuncSetAttribute((const void*)mk_fwd, hipFuncAttributeMaxDynamicSharedMemorySize, LDS_BYTES) != hipSuccess) { fprintf(stderr, "kernel_launch: hipFuncSetAttribute failed\n"); grid = -1; return; }
        if (hipOccupancyMaxActiveBlocksPerMultiprocessor(&per_cu, (const void*)mk_fwd, NWAVES * 64, LDS_BYTES) != hipSuccess || per_cu < 1)
            fprintf(stderr, "kernel_launch: note: occupancy query reports %d workgroups per CU\n", per_cu);
        (void)hipGetLastError();
        grid = cus;
        if (grid != 256) fprintf(stderr, "kernel_launch: note: %d CUs (built for 256)\n", grid);
    }
    if (grid < 0) return;
    if (hipMemsetAsync((char*)d_ws + WS_CTL, 0, CTL_ZERO_BYTES, stream) != hipSuccess) return;
    Args a{};
    for (int i = 0; i < 24; ++i) a.in[i] = (const float*)d_in[i];
    a.out = (float*)d_out; a.ws = (unsigned char*)d_ws;
#if MK_PER_PHASE
    for (int k = 0; k < NPHASE; ++k) { a.ph_lo = k; a.ph_hi = k + 1; hipLaunchKernelGGL(mk_fwd, dim3(grid), dim3(NWAVES * 64), LDS_BYTES, stream, a); }
#else
    a.ph_lo = 0; a.ph_hi = NPHASE; hipLaunchKernelGGL(mk_fwd, dim3(grid), dim3(NWAVES * 64), LDS_BYTES, stream, a);
#endif
}
```

```cpp
#include <hip/hip_runtime.h>
#include <cstdio>
#include <cstdint>
#include <cmath>
namespace pg8 {
#define PG8_LAS __attribute__((address_space(3)))
typedef unsigned short bf16_t;
typedef short bf16x8 __attribute__((ext_vector_type(8)));
typedef float f32x4 __attribute__((ext_vector_type(4)));
typedef unsigned u32x4 __attribute__((ext_vector_type(4)));
constexpr int BM = 256, BK = 64, HALF = 128, HTB = HALF * BK * 2  , STAGE_BYTES = 8 * HTB, NXCD = 8, WGM = 8;

__host__ __device__ __forceinline__ int lds_byte(int r, int c) { const int st = (r >> 4) * 2 + (c >> 5), rr = r & 15, cc = c & 31, ob = rr * 64 + cc * 2; return st * 1024 + (ob ^ (((ob >> 9) & 1) << 5)); }
__host__ __device__ __forceinline__ void stage_rc(int b, int& R, int& C) { const int st = b / 1024, sb = b % 1024, swz = sb ^ (((sb >> 9) & 1) << 5); R = (st >> 1) * 16 + swz / 64; C = (st & 1) * 32 + (swz % 64) / 2; }
__host__ __device__ __forceinline__ int perm32(int rho) { const int n = rho >> 4, i = rho & 15; return 8 * (i >> 2) + 4 * n + (i & 3); }

struct Unit { int pm, pn; };
struct Gemm { const bf16_t* A; const bf16_t* Bt; int M, N, K, lda, ablk; };

struct StaticOrder {
    int nM, nN, nwg, G, c;
    __host__ __device__ void init(int M, int N, int G_, int c_) { nM = M / BM; nN = N / BM; nwg = nM * nN; G = G_; c = c_; }
    __host__ __device__ bool next(int i, Unit& u) const {
        const long L = (long)i * G + c; if (L >= nwg) return false;
        int wgid = (int)L; { const int q = nwg / NXCD, r = nwg % NXCD, xcd = wgid % NXCD, off = wgid / NXCD; wgid = (xcd < r ? xcd * (q + 1) : r * (q + 1) + (xcd - r) * q) + off; }
        const int nig = WGM * nN, gid = wgid / nig, fm = gid * WGM, gsz = (nM - fm) < WGM ? (nM - fm) : WGM;
        u.pm = fm + ((wgid % nig) % gsz); u.pn = (wgid % nig) / gsz; return true;
    }
    __device__ __forceinline__ void a_ready(const Unit&) const {}
    __device__ __forceinline__ void done(const Unit&) const {}
};

__device__ __forceinline__ unsigned cvt_pk_bf16(float lo, float hi) { unsigned r; asm volatile("v_cvt_pk_bf16_f32 %0, %1, %2" : "=v"(r) : "v"(lo), "v"(hi)); return r; }
__device__ __forceinline__ float fast_sigmoid(float x) { return __builtin_amdgcn_rcpf(1.0f + __expf(-x)); }
__device__ __forceinline__ float bfl(unsigned w) { return __uint_as_float(w << 16); }
__device__ __forceinline__ float bfh(unsigned w) { return __uint_as_float(w & 0xffff0000u); }

struct EpiBf16 {
    static constexpr bool PERM = true, AFTER_DRAIN = false;
    bf16_t* O; int ldc;
    __device__ __forceinline__ void operator()(const f32x4 (&acc)[2][2][4][2], const Unit& u, int wr, int wc, int fr, int fq) const {
        const int row0 = u.pm * BM + wr * 64 + fr, col0 = u.pn * BM + wc * 32 + 8 * fq;
#pragma unroll
        for (int ai = 0; ai < 2; ++ai)
#pragma unroll
            for (int m = 0; m < 4; ++m) { bf16_t* rowp = O + (size_t)(row0 + ai * HALF + m * 16) * ldc + col0;
#pragma unroll
                for (int bj = 0; bj < 2; ++bj) { const f32x4 v0 = acc[ai][bj][m][0], v1 = acc[ai][bj][m][1];
                    u32x4 w; w.x = cvt_pk_bf16(v0[0], v0[1]); w.y = cvt_pk_bf16(v0[2], v0[3]); w.z = cvt_pk_bf16(v1[0], v1[1]); w.w = cvt_pk_bf16(v1[2], v1[3]);
                    *(u32x4*)(rowp + bj * HALF) = w; } }
    }
};
struct EpiSwiGLU {
    static constexpr bool PERM = true, AFTER_DRAIN = false;
    bf16_t* O; int ldc;
    __device__ __forceinline__ void operator()(const f32x4 (&acc)[2][2][4][2], const Unit& u, int wr, int wc, int fr, int fq) const {
        const int row0 = u.pm * BM + wr * 64 + fr, col0 = u.pn * HALF + wc * 32 + 8 * fq;
#pragma unroll
        for (int ai = 0; ai < 2; ++ai)
#pragma unroll
            for (int m = 0; m < 4; ++m) { bf16_t* rowp = O + (size_t)(row0 + ai * HALF + m * 16) * ldc + col0;
                float r[8];
#pragma unroll
                for (int n = 0; n < 2; ++n)
#pragma unroll
                    for (int e = 0; e < 4; ++e) { const float g = acc[ai][0][m][n][e], up = acc[ai][1][m][n][e]; r[n * 4 + e] = g * fast_sigmoid(g) * up; }
                u32x4 w; w.x = cvt_pk_bf16(r[0], r[1]); w.y = cvt_pk_bf16(r[2], r[3]); w.z = cvt_pk_bf16(r[4], r[5]); w.w = cvt_pk_bf16(r[6], r[7]);
                *(u32x4*)rowp = w; }
    }
};
struct EpiGates {
    static constexpr bool PERM = true, AFTER_DRAIN = false;
    float* ADEC; bf16_t* INP; const bf16_t* XC; const float* ba; const float* bx; const float* sp8;
    __device__ __forceinline__ void operator()(const f32x4 (&acc)[2][2][4][2], const Unit& u, int wr, int wc, int fr, int fq) const {
        const int row0 = u.pm * BM + wr * 64 + fr, c0 = (u.pn >> 1) * 256 + (u.pn & 1) * HALF + wc * 32 + 8 * fq;
#pragma unroll
        for (int ai = 0; ai < 2; ++ai)
#pragma unroll
            for (int m = 0; m < 4; ++m) { const size_t off = (size_t)(row0 + ai * HALF + m * 16) * 2048 + c0;
                const u32x4 xw = *(const u32x4*)(XC + off);
                f32x4 bav[2], bxv[2], spv[2];
#pragma unroll
                for (int n = 0; n < 2; ++n) { bav[n] = *(const f32x4*)(ba + c0 + 4 * n); bxv[n] = *(const f32x4*)(bx + c0 + 4 * n); spv[n] = *(const f32x4*)(sp8 + c0 + 4 * n); }
                const float xc[8] = {bfl(xw.x), bfh(xw.x), bfl(xw.y), bfh(xw.y), bfl(xw.z), bfh(xw.z), bfl(xw.w), bfh(xw.w)};
                float av[8], iv[8];
#pragma unroll
                for (int n = 0; n < 2; ++n)
#pragma unroll
                    for (int e = 0; e < 4; ++e) { const float r = fast_sigmoid(acc[ai][0][m][n][e] + bav[n][e]), ig = fast_sigmoid(acc[ai][1][m][n][e] + bxv[n][e]);
                        const float a = __expf(spv[n][e] * r); av[n * 4 + e] = a; iv[n * 4 + e] = sqrtf(fmaxf(1.0f - a * a, 0.0f)) * ig * xc[n * 4 + e]; }
                *(f32x4*)(ADEC + off) = (f32x4){av[0], av[1], av[2], av[3]}; *(f32x4*)(ADEC + off + 4) = (f32x4){av[4], av[5], av[6], av[7]};
                u32x4 w; w.x = cvt_pk_bf16(iv[0], iv[1]); w.y = cvt_pk_bf16(iv[2], iv[3]); w.z = cvt_pk_bf16(iv[4], iv[5]); w.w = cvt_pk_bf16(iv[6], iv[7]);
                *(u32x4*)(INP + off) = w;
                asm volatile("" ::: "memory"); }
    }
};

template <class Epi, class Sched, bool ALIGN_EPI = false, bool SP2 = false>
__device__ __forceinline__ void gemm_phase(PG8_LAS unsigned char* lds, const Gemm g, const Sched& S, const Epi& E) {
    int tid_ = threadIdx.x; asm volatile("" : "+v"(tid_));
    const int tid = tid_, wid = __builtin_amdgcn_readfirstlane(tid >> 6), lane = tid & 63, wr = wid >> 2, wc = wid & 3, fr = lane & 15, fq = lane >> 4;
    const int K = g.K, nt = K / BK;
    unsigned voffA[2], voffB[2];
#pragma unroll
    for (int i = 0; i < 2; ++i) { int R, C; stage_rc(tid * 16 + i * 8192, R, C); const int Rb = Epi::PERM ? ((R & ~31) + perm32(R & 31)) : R;
        voffA[i] = (unsigned)(R * g.lda + C) * 2u; voffB[i] = (unsigned)(Rb * K + C) * 2u; }
    const size_t kstep = (size_t)(BK * 2);
    const size_t hstep = (size_t)HALF * K * 2, hstepA = (size_t)HALF * g.lda * 2;
    const size_t tstep = 2 * hstep, tstepA = 2 * hstepA;
    const unsigned ldsw = (unsigned)wid * 1024u;
    const int aoff = lds_byte(wr * 64 + fr, fq * 8), boff = lds_byte(wc * 32 + fr, fq * 8);
#define PG8_SA(b, h) (((b) * 2 + (h)) * HTB)
#define PG8_SB(b, h) ((4 + (b) * 2 + (h)) * HTB)
#define PG8_STAGE(bufoff, gbase, voff) do { _Pragma("unroll") for (int _i = 0; _i < 2; ++_i) \
        __builtin_amdgcn_global_load_lds((const unsigned*)((const char*)(gbase) + (voff)[_i]), (PG8_LAS unsigned*)(lds + (bufoff) + ldsw + _i * 8192), 16, 0, 0); } while (0)
#define PG8_LDA(dst, b, h) do { _Pragma("unroll") for (int m = 0; m < 4; ++m) _Pragma("unroll") for (int k = 0; k < 2; ++k) dst[m][k] = *(const PG8_LAS bf16x8*)(lds + PG8_SA(b, h) + aoff + m * 2048 + k * 1024); } while (0)
#define PG8_LDB(dst, b, h) do { _Pragma("unroll") for (int n = 0; n < 2; ++n) _Pragma("unroll") for (int k = 0; k < 2; ++k) dst[n][k] = *(const PG8_LAS bf16x8*)(lds + PG8_SB(b, h) + boff + n * 2048 + k * 1024); } while (0)
#define PG8_MMA(ai, bj, At, Bt) do { __builtin_amdgcn_s_setprio(1); _Pragma("unroll") for (int m = 0; m < 4; ++m) _Pragma("unroll") for (int n = 0; n < 2; ++n) _Pragma("unroll") for (int k = 0; k < 2; ++k) \
        acc[ai][bj][m][n] = __builtin_amdgcn_mfma_f32_16x16x32_bf16(Bt[n][k], At[m][k], acc[ai][bj][m][n], 0, 0, 0); __builtin_amdgcn_s_setprio(0); } while (0)
#define PG8_WAIT_V(n) asm volatile("s_waitcnt vmcnt(" #n ")" ::: "memory")
#define PG8_WAIT_L(n) asm volatile("s_waitcnt lgkmcnt(" #n ")" ::: "memory")
#define PG8_BAR __builtin_amdgcn_s_barrier()
#define PG8_SCHED __builtin_amdgcn_sched_barrier(0)
    Unit cur, nxt; int ui = 0;
    if (!S.next(0, cur)) return;
    f32x4 acc[2][2][4][2];
#pragma unroll
    for (int a = 0; a < 2; ++a)
#pragma unroll
        for (int b = 0; b < 2; ++b)
#pragma unroll
            for (int m = 0; m < 4; ++m)
#pragma unroll
                for (int n = 0; n < 2; ++n) acc[a][b][m][n] = (f32x4){0.f, 0.f, 0.f, 0.f};
    bf16x8 At[4][2], B0[2][2], B1[2][2];
    const char* cA = (const char*)g.A + (size_t)cur.pm * tstepA + (g.ablk ? (size_t)(cur.pn / g.ablk) * K * 2 : (size_t)0); const char* cB = (const char*)g.Bt + (size_t)cur.pn * tstep;
    S.a_ready(cur);
    if constexpr (SP2) {
        PG8_STAGE(PG8_SB(0, 0), cB, voffB); PG8_STAGE(PG8_SB(0, 1), cB + hstep, voffB); PG8_STAGE(PG8_SA(0, 0), cA, voffA); PG8_STAGE(PG8_SA(0, 1), cA + hstepA, voffA);
        if (wr == 1) PG8_BAR;
        PG8_WAIT_V(2); PG8_BAR;
        PG8_STAGE(PG8_SB(1, 0), cB + kstep, voffB); PG8_STAGE(PG8_SA(1, 0), cA + kstep, voffA); PG8_STAGE(PG8_SB(1, 1), cB + hstep + kstep, voffB);
        PG8_WAIT_V(6); PG8_BAR;
    } else {
        PG8_STAGE(PG8_SB(0, 0), cB, voffB); PG8_STAGE(PG8_SA(0, 0), cA, voffA); PG8_STAGE(PG8_SB(0, 1), cB + hstep, voffB); PG8_STAGE(PG8_SA(0, 1), cA + hstepA, voffA);
        if (wr == 1) PG8_BAR;
        PG8_WAIT_V(4); PG8_BAR;
        PG8_STAGE(PG8_SB(1, 0), cB + kstep, voffB); PG8_STAGE(PG8_SA(1, 0), cA + kstep, voffA); PG8_STAGE(PG8_SB(1, 1), cB + hstep + kstep, voffB);
        PG8_WAIT_V(6); PG8_BAR;
    }
    for (;;) {
        const bool has_next = S.next(ui + 1, nxt);
        const char* nA = has_next ? (const char*)g.A + (size_t)nxt.pm * tstepA + (g.ablk ? (size_t)(nxt.pn / g.ablk) * K * 2 : (size_t)0) : cA; const char* nB = has_next ? (const char*)g.Bt + (size_t)nxt.pn * tstep : cB;
        for (int t = 0; t < nt; t += 2) {
            const bool last = (t == nt - 2);
            const char* a1 = cA + (size_t)(t + 1) * kstep;
            const char* a2 = last ? nA : cA + (size_t)(t + 2) * kstep; const char* b2 = last ? nB : cB + (size_t)(t + 2) * kstep;
            const char* a3 = a2 + kstep; const char* b3 = b2 + kstep;
            if (last && has_next) S.a_ready(nxt);
            if constexpr (SP2) {
            PG8_LDB(B0, 0, 0); PG8_LDB(B1, 0, 1); PG8_SCHED; PG8_LDA(At, 0, 0); PG8_STAGE(PG8_SA(1, 1), a1 + hstepA, voffA);
            PG8_WAIT_V(8); PG8_WAIT_L(0); PG8_BAR; PG8_MMA(0, 0, At, B0); PG8_MMA(0, 1, At, B1); PG8_BAR; PG8_SCHED;
            PG8_LDA(At, 0, 1); PG8_STAGE(PG8_SB(0, 0), b2, voffB); PG8_STAGE(PG8_SB(0, 1), b2 + hstep, voffB); PG8_STAGE(PG8_SA(0, 0), a2, voffA);
            PG8_WAIT_V(8); PG8_WAIT_L(0); PG8_BAR; PG8_MMA(1, 0, At, B0); PG8_MMA(1, 1, At, B1); PG8_BAR; PG8_SCHED;
            PG8_LDB(B0, 1, 0); PG8_LDB(B1, 1, 1); PG8_SCHED; PG8_LDA(At, 1, 0); PG8_STAGE(PG8_SA(0, 1), a2 + hstepA, voffA);
            PG8_WAIT_V(8); PG8_WAIT_L(0); PG8_BAR; PG8_MMA(0, 0, At, B0); PG8_MMA(0, 1, At, B1); PG8_BAR; PG8_SCHED;
            PG8_LDA(At, 1, 1); PG8_STAGE(PG8_SB(1, 0), b3, voffB); PG8_STAGE(PG8_SB(1, 1), b3 + hstep, voffB); PG8_STAGE(PG8_SA(1, 0), a3, voffA);
            PG8_WAIT_V(8); PG8_WAIT_L(0); PG8_BAR; PG8_MMA(1, 0, At, B0); PG8_MMA(1, 1, At, B1); PG8_BAR; PG8_SCHED;
            } else {
            PG8_LDB(B0, 0, 0); PG8_SCHED; PG8_LDA(At, 0, 0); PG8_STAGE(PG8_SA(1, 1), a1 + hstepA, voffA);
            PG8_WAIT_L(8); PG8_BAR; PG8_WAIT_L(0); PG8_MMA(0, 0, At, B0); PG8_BAR; PG8_SCHED;
            PG8_LDB(B1, 0, 1); PG8_STAGE(PG8_SB(0, 0), b2, voffB);
            PG8_BAR; PG8_WAIT_L(0); PG8_MMA(0, 1, At, B1); PG8_BAR;
            PG8_LDA(At, 0, 1); PG8_STAGE(PG8_SA(0, 0), a2, voffA);
            PG8_BAR; PG8_WAIT_L(0); PG8_MMA(1, 0, At, B0); PG8_BAR; PG8_SCHED;
            PG8_STAGE(PG8_SB(0, 1), b2 + hstep, voffB);
            PG8_WAIT_V(6); PG8_BAR; PG8_MMA(1, 1, At, B1); PG8_BAR;
            PG8_LDB(B0, 1, 0); PG8_SCHED; PG8_LDA(At, 1, 0); PG8_STAGE(PG8_SA(0, 1), a2 + hstepA, voffA);
            PG8_WAIT_L(8); PG8_BAR; PG8_WAIT_L(0); PG8_MMA(0, 0, At, B0); PG8_BAR; PG8_SCHED;
            PG8_LDB(B1, 1, 1); PG8_STAGE(PG8_SB(1, 0), b3, voffB);
            PG8_BAR; PG8_WAIT_L(0); PG8_MMA(0, 1, At, B1); PG8_BAR;
            PG8_LDA(At, 1, 1); PG8_STAGE(PG8_SA(1, 0), a3, voffA);
            PG8_BAR; PG8_WAIT_L(0); PG8_MMA(1, 0, At, B0); PG8_BAR; PG8_SCHED;
            PG8_STAGE(PG8_SB(1, 1), b3 + hstep, voffB);
            PG8_WAIT_V(6); PG8_BAR; PG8_MMA(1, 1, At, B1); PG8_BAR;
            }
        }
        if constexpr (ALIGN_EPI) { if (wr == 0) PG8_BAR; }
        if constexpr (!Epi::AFTER_DRAIN) { E(acc, cur, wr, wc, fr, fq); S.done(cur); }
        if (!has_next) break;
#pragma unroll
        for (int a = 0; a < 2; ++a)
#pragma unroll
            for (int b = 0; b < 2; ++b)
#pragma unroll
                for (int m = 0; m < 4; ++m)
#pragma unroll
                    for (int n = 0; n < 2; ++n) acc[a][b][m][n] = (f32x4){0.f, 0.f, 0.f, 0.f};
        cur = nxt; cA = nA; cB = nB; ++ui;
        if constexpr (ALIGN_EPI) { if (wr == 1) PG8_BAR; }
    }
    PG8_WAIT_V(0);
    if constexpr (!ALIGN_EPI) { if (wr == 0) PG8_BAR; }
    PG8_BAR;
    if constexpr (Epi::AFTER_DRAIN) { E.fused(acc, cur, wr, wc, fr, fq, lds, wid, lane); S.done(cur); }
#undef PG8_SA
#undef PG8_SB
#undef PG8_STAGE
#undef PG8_LDA
#undef PG8_LDB
#undef PG8_MMA
#undef PG8_WAIT_V
#undef PG8_WAIT_L
#undef PG8_BAR
#undef PG8_SCHED
}
}

constexpr int NWAVES = 8;
constexpr int NB = 16, T = 2048, D = 2048, M = NB * T, DFF = 5632, NADA = 18432, EVW = 8208;
constexpr float EPS = 1e-6f;
#ifndef MK_PER_PHASE
#define MK_PER_PHASE 0
#endif
constexpr int NPHASE = 27;
#ifndef PROBE_GEMM_X2
#define PROBE_GEMM_X2 0
#endif
#ifndef PROBE_P0_X2
#define PROBE_P0_X2 0
#endif
#ifndef PROBE_REC_X2
#define PROBE_REC_X2 0
#endif

constexpr size_t MiB = 1u << 20;
constexpr size_t WS_CTL = 0, CTL_ZERO_BYTES = 1 * MiB;
constexpr size_t WS_MODV = 1 * MiB;
constexpr size_t WS_ROPE = 4 * MiB;
constexpr size_t WS_BG = 6 * MiB;
constexpr size_t WS_WBA = 8 * MiB;
constexpr size_t WS_SP8 = 8 * MiB + 256 * 1024;
constexpr size_t WS_W13 = 16 * MiB;
constexpr size_t W13_BYTES = (size_t)2 * DFF * D * 2;
constexpr size_t WS_W2 = WS_W13 + 4 * W13_BYTES;
constexpr size_t W2_BYTES = (size_t)D * DFF * 2;
constexpr size_t WS_WEVIN = WS_W2 + 4 * W2_BYTES;
constexpr size_t WS_WEVOUT = WS_WEVIN + (size_t)8192 * D * 2;
constexpr size_t WS_WODIN = WS_WEVOUT + (size_t)D * D * 2;
constexpr size_t WS_WGATE = WS_WODIN + (size_t)4096 * D * 2;
constexpr size_t WS_WODOUT = WS_WGATE + (size_t)4096 * 256 * 2;
constexpr size_t WS_H = WS_WODOUT + (size_t)D * D * 2;
constexpr size_t WS_Y = WS_H + (size_t)M * D * 2;
constexpr size_t WS_BIG = WS_Y + (size_t)M * D * 2;
constexpr size_t WS_ADEC = WS_BIG + 256 * MiB;
constexpr size_t WS_EXT = WS_BIG + 512 * MiB;
constexpr size_t WS_END = WS_EXT + 192 * MiB;
static_assert(WS_W13 % (1u << 20) == 0 && WS_H == 346 * MiB && WS_END == 1306 * MiB, "d_ws map");
constexpr int CW_BAR = 4096;

constexpr int RING_BYTES = 131072;
constexpr int WAVE_LDS = 19712;
constexpr int ADA_ACC_OFF = 131072;
constexpr int LDSCTL_OFF = 157696, MISC_OFF = LDSCTL_OFF + 320;
constexpr int LDS_BYTES = 158720;
static_assert(MISC_OFF + 128 <= LDS_BYTES && 8 * WAVE_LDS <= LDSCTL_OFF, "LDS map");

#define GAS __attribute__((address_space(1)))
#define LAS __attribute__((address_space(3)))
typedef unsigned short bf16;
typedef unsigned v4u __attribute__((ext_vector_type(4)));
typedef unsigned v2u __attribute__((ext_vector_type(2)));
typedef float f32x4 __attribute__((ext_vector_type(4)));
typedef GAS unsigned gu32;
#define RLX_AGENT __ATOMIC_RELAXED, __HIP_MEMORY_SCOPE_AGENT
#define LDS_WAIT() asm volatile("s_waitcnt lgkmcnt(0)" ::: "memory")
#define VM_WAIT() asm volatile("s_waitcnt vmcnt(0)" ::: "memory")
using pg8::cvt_pk_bf16; using pg8::bfl; using pg8::bfh; using pg8::fast_sigmoid;

#define XB_TMO      128
#define XB_XCNT(j)  (256  + 64 * (j))
#define XB_XSUB(j)  (1280 + 64 * (j))
#define XB_XGEN(j)  (2304 + 64 * (j))
#define XB_TOP      3328
#define XB_TOPGEN   3392
#define XCD_BAR_WORDS 3456
#define XB_SPIN_CAP (1u << 18)

__device__ __forceinline__ unsigned xb_ld(unsigned* p)              { return __hip_atomic_load(p, __ATOMIC_RELAXED, __HIP_MEMORY_SCOPE_AGENT); }
__device__ __forceinline__ unsigned xb_add(unsigned* p, unsigned v) { return __hip_atomic_fetch_add(p, v, __ATOMIC_RELAXED, __HIP_MEMORY_SCOPE_AGENT); }
__device__ __forceinline__ unsigned xb_xcc_id() { return (unsigned)__builtin_amdgcn_s_getreg((3 << 11) | 20) & 0xFu; }
#define XB_SPIN(cond, bar) do { unsigned _sp = 0; while (cond) { __builtin_amdgcn_s_sleep(1); \
    if ((++_sp & 255u) == 0u) { if (xb_ld(&(bar)[XB_TMO])) break; if (_sp > XB_SPIN_CAP) { atomicAdd(&(bar)[XB_TMO], 1u); break; } } } } while (0)

struct XcdBarrier {
    unsigned* bar; unsigned x;
    volatile LAS unsigned* st;
};

__device__ __forceinline__ XcdBarrier xcd_barrier_post(unsigned* bar, volatile LAS unsigned* st) {
    XcdBarrier b; b.bar = bar; b.x = xb_xcc_id(); b.st = st;
    if (threadIdx.x == 0) (void)xb_add(&bar[XB_XCNT(b.x)], 1u);
    return b;
}
__device__ __forceinline__ void xcd_barrier_complete(unsigned* bar, unsigned x, unsigned& nloc, unsigned& nx) {
    const unsigned G = gridDim.x * gridDim.y * gridDim.z;
    unsigned sum, cnt, mine, sp = 0u;
    for (;;) {
        sum = 0u; cnt = 0u; mine = 0u;
#pragma unroll
        for (unsigned j = 0; j < 16; ++j) { const unsigned c = xb_ld(&bar[XB_XCNT(j)]); sum += c; cnt += (c > 0u) ? 1u : 0u; mine = (j == x) ? c : mine; }
        if (sum == G) break;
        __builtin_amdgcn_s_sleep(1);
        if ((++sp & 255u) == 0u) { if (xb_ld(&bar[XB_TMO])) break; if (sp > XB_SPIN_CAP) { atomicAdd(&bar[XB_TMO], 1u); break; } }
    }
    nloc = mine > 0u ? mine : 1u; nx = cnt > 0u ? cnt : 1u;
}

__device__ __forceinline__ void xcd_barrier(const XcdBarrier& b) {
    asm volatile("s_waitcnt vmcnt(0)" ::: "memory");
    __syncthreads();
    if (threadIdx.x == 0) {
        unsigned* bar = b.bar;
        __builtin_amdgcn_s_waitcnt(0);
        unsigned nloc = b.st[0], nx = b.st[1];
        if (nloc == 0u) { xcd_barrier_complete(bar, b.x, nloc, nx); b.st[0] = nloc; b.st[1] = nx; }
        const unsigned old = xb_add(&bar[XB_XSUB(b.x)], 1u);
        const unsigned gen = old / nloc;
        if (old + 1u == (gen + 1u) * nloc) {
            __builtin_amdgcn_fence(__ATOMIC_RELEASE, "agent");
            asm volatile("s_waitcnt vmcnt(0)" ::: "memory");
            const unsigned og = xb_add(&bar[XB_TOP], 1u);
            const unsigned tg = og / nx;
            if (og + 1u == (tg + 1u) * nx) xb_add(&bar[XB_TOPGEN], 1u);
            else XB_SPIN(xb_ld(&bar[XB_TOPGEN]) == tg, bar);
            __builtin_amdgcn_fence(__ATOMIC_ACQUIRE, "agent");
            xb_add(&bar[XB_XGEN(b.x)], 1u);
            asm volatile("s_waitcnt vmcnt(0)" ::: "memory");
        } else {
            XB_SPIN(xb_ld(&bar[XB_XGEN(b.x)]) == gen, bar);
            __builtin_amdgcn_fence(__ATOMIC_ACQUIRE, "agent");
            asm volatile("s_waitcnt vmcnt(0)" ::: "memory");
        }
    }
    __syncthreads();
}

struct Args { const float* in[24]; float* out; unsigned char* ws; int ph_lo, ph_hi; };
struct Frame {
    LAS unsigned char* lds; volatile LAS unsigned* MISC; gu32* ctl;
    int tid, lane, wave, vcu, G;
};
__device__ __forceinline__ float wave_sum(float v) {
#pragma unroll
    for (int o = 1; o < 64; o <<= 1) v += __shfl_xor(v, o);
    return v;
}
__device__ __forceinline__ float silu_f(float x) { return x * fast_sigmoid(x); }
__device__ __forceinline__ void unpack8(const v4u w, float (&f)[8]) { f[0] = bfl(w.x); f[1] = bfh(w.x); f[2] = bfl(w.y); f[3] = bfh(w.y); f[4] = bfl(w.z); f[5] = bfh(w.z); f[6] = bfl(w.w); f[7] = bfh(w.w); }
__device__ __forceinline__ v4u pack8(const float (&f)[8]) { v4u w; w.x = cvt_pk_bf16(f[0], f[1]); w.y = cvt_pk_bf16(f[2], f[3]); w.z = cvt_pk_bf16(f[4], f[5]); w.w = cvt_pk_bf16(f[6], f[7]); return w; }

__device__ __forceinline__ void transpose_item(const float* W, int ldw, int k0, int n0, bf16* WT, int ldt, int drow0, LAS float* scr, int lane) {
#pragma unroll 8
    for (int i = 0; i < 32; ++i) { const int kk = 2 * i + (lane >> 5); scr[kk * 33 + (lane & 31)] = W[(size_t)(k0 + kk) * ldw + n0 + (lane & 31)]; }
    LDS_WAIT(); asm volatile("" ::: "memory");
    const int c = lane & 7;
#pragma unroll
    for (int j = 0; j < 4; ++j) { const int n = (lane >> 3) + 8 * j; const LAS float* s = scr + (8 * c) * 33 + n;
        v4u o; o.x = cvt_pk_bf16(s[0 * 33], s[1 * 33]); o.y = cvt_pk_bf16(s[2 * 33], s[3 * 33]); o.z = cvt_pk_bf16(s[4 * 33], s[5 * 33]); o.w = cvt_pk_bf16(s[6 * 33], s[7 * 33]);
        *(GAS v4u*)(WT + (size_t)(drow0 + n) * ldt + k0 + 8 * c) = o; }
    LDS_WAIT(); asm volatile("" ::: "memory");
}
__device__ __forceinline__ void p0_prologue(Frame& F, const Args& a) {
    unsigned char* ws = a.ws;
    {
        LAS float* sc = (LAS float*)F.lds;
        LAS float* accl = (LAS float*)(F.lds + ADA_ACC_OFF);
        const float* c = a.in[1];
        for (int idx = F.tid; idx < NB * D; idx += NWAVES * 64) { const int b = idx >> 11, k = idx & 2047; const float v = c[idx]; sc[k * 16 + b] = v / (1.0f + __expf(-v)); }
        __syncthreads();
        float* modv = (float*)(ws + WS_MODV);
        for (int u = blockIdx.x; u < 2 * (NADA / 64); u += F.G) {
            const int layer = u / (NADA / 64), n0 = (u % (NADA / 64)) * 64;
            for (int e = F.tid; e < 1024; e += NWAVES * 64) accl[e] = 0.f;
            __syncthreads();
            const float* W = a.in[2] + (size_t)layer * D * NADA + n0 + F.lane;
            float acc[16];
#pragma unroll
            for (int b = 0; b < 16; ++b) acc[b] = 0.f;
            const int kbeg = F.wave * 256;
#pragma unroll 4
            for (int kk = 0; kk < 256; ++kk) { const int k = kbeg + kk; const float w = W[(size_t)k * NADA];
#pragma unroll
                for (int i = 0; i < 4; ++i) { const f32x4 s4 = *(const LAS f32x4*)(sc + k * 16 + 4 * i);
                    acc[4 * i + 0] += w * s4[0]; acc[4 * i + 1] += w * s4[1]; acc[4 * i + 2] += w * s4[2]; acc[4 * i + 3] += w * s4[3]; } }
            for (int w = 0; w < NWAVES; ++w) {
                if (F.wave == w) {
#pragma unroll
                    for (int b = 0; b < 16; ++b) accl[b * 64 + F.lane] += acc[b];
                }
                __syncthreads();
            }
            for (int e = F.tid; e < 1024; e += NWAVES * 64) { const int b = e >> 6, col = e & 63, n = n0 + col;
                const float v = accl[e] + a.in[3][layer * NADA + n];
                const int s = n / (3 * D), j = (n / D) % 3, d = n % D, q = layer * 3 + s;
                float o = v;
                if (j == 1) o = a.in[4][(size_t)q * D + d] * (1.0f + v);
                if (j == 2) o = (s == 1 ? 1.0f : 0.5f) * a.in[5][(size_t)q * D + d] * (1.0f + v);
                modv[((size_t)(q * 3 + j) * 16 + b) * D + d] = o; }
            __syncthreads();
        }
    }
    const int gw = F.vcu * NWAVES + F.wave, NGW = F.G * NWAVES;
    {
        LAS float* scr = (LAS float*)(F.lds + F.wave * 16384);
        constexpr int I13 = 32 * 352, I2 = 88 * 64, IEV = 32 * 256, IEO = 32 * 64, IOI = 32 * 128, IG = 16 * 32, IOO = 32 * 64;
        constexpr int NITEMS = 4 * I13 + 4 * I2 + IEV + IEO + IOI + IG + IOO;
        for (int it = gw; it < NITEMS; it += NGW) {
            int r = it;
            if (r < 4 * I13) { const int mat = r / I13; r -= mat * I13; const int kb = r / 352, nb = r % 352, n0 = 32 * nb;
                const int dr = n0 < DFF ? (n0 >> 7) * 256 + (n0 & 127) : ((n0 - DFF) >> 7) * 256 + 128 + ((n0 - DFF) & 127);
                transpose_item(a.in[6] + (size_t)mat * D * 2 * DFF, 2 * DFF, 64 * kb, n0, (bf16*)(ws + WS_W13 + mat * W13_BYTES), D, dr, scr, F.lane); continue; }
            r -= 4 * I13;
            if (r < 4 * I2) { const int mat = r / I2; r -= mat * I2; const int kb = r / 64, nb = r % 64;
                transpose_item(a.in[7] + (size_t)mat * DFF * D, D, 64 * kb, 32 * nb, (bf16*)(ws + WS_W2 + mat * W2_BYTES), DFF, 32 * nb, scr, F.lane); continue; }
            r -= 4 * I2;
            if (r < IEV) { const int kb = r / 256, nb = r % 256, d0 = 32 * nb, n0 = d0 + (d0 >= 3072 ? 16 : 0);
                transpose_item(a.in[8], EVW, 64 * kb, n0, (bf16*)(ws + WS_WEVIN), D, d0, scr, F.lane); continue; }
            r -= IEV;
            if (r < IEO) { const int kb = r / 64, nb = r % 64;
                transpose_item(a.in[14], D, 64 * kb, 32 * nb, (bf16*)(ws + WS_WEVOUT), D, 32 * nb, scr, F.lane); continue; }
            r -= IEO;
            if (r < IOI) { const int kb = r / 128, nb = r % 128;
                transpose_item(a.in[15], 2 * D, 64 * kb, 32 * nb, (bf16*)(ws + WS_WODIN), D, 32 * nb, scr, F.lane); continue; }
            r -= IOI;
            if (r < IG) { const int mat = r / 32; r -= mat * 32; const int gsel = mat >> 3, blk = mat & 7, kb = r / 8, nb = r % 8, j0 = 32 * nb;
                const int dr = (blk * 2 + (j0 >> 7)) * 256 + gsel * 128 + (j0 & 127);
                transpose_item((gsel ? a.in[20] : a.in[18]) + (size_t)blk * 65536, 256, 64 * kb, j0, (bf16*)(ws + WS_WGATE), 256, dr, scr, F.lane); continue; }
            r -= IG;
            { const int kb = r / 64, nb = r % 64;
                transpose_item(a.in[23], D, 64 * kb, 32 * nb, (bf16*)(ws + WS_WODOUT), D, 32 * nb, scr, F.lane); }
        }
    }
    const int gt = (F.vcu * NWAVES + F.wave) * 64 + F.lane, NGT = F.G * NWAVES * 64;
    { float* wba = (float*)(ws + WS_WBA);
      for (int i = gt; i < 16 * D; i += NGT) { const int o = i >> 11, k = i & 2047; wba[i] = a.in[8][(size_t)k * EVW + 3072 + o]; } }
    { float* sp8 = (float*)(ws + WS_SP8);
      for (int i = gt; i < D; i += NGT) sp8[i] = -8.0f * log1pf(expf(-a.in[22][i])); }
    { float* rc = (float*)(ws + WS_ROPE); float* rs = rc + T * 128;
      for (int i = gt; i < T * 128; i += NGT) { const int t = i >> 7, f = i & 127;
          const double ang = (double)t * pow(10000.0, -(double)f / 128.0); rc[i] = (float)cos(ang); rs[i] = (float)sin(ang); } }
}

template <bool DO_BA>
__device__ __forceinline__ void norm_pass(Frame& F, const Args& a, const int q) {
    unsigned char* ws = a.ws;
    const bool has_prev = q > 0, has_next = q < 6;
    const float* xold = (q <= 1) ? a.in[0] : a.out;
    float* xnew = a.out;
    const bf16* Y = (const bf16*)(ws + WS_Y); bf16* H = (bf16*)(ws + WS_H);
    const float* modv = (const float*)(ws + WS_MODV);
    LAS float* wl = (LAS float*)F.lds;
    if (DO_BA) {
        const float* wba = (const float*)(ws + WS_WBA);
        for (int i = F.tid; i < 16 * D; i += NWAVES * 64) { const int o = i >> 11, col = i & 2047, j = col >> 9, l = (col >> 3) & 63, hf = (col >> 2) & 1, e = col & 3;
            wl[o * 2048 + j * 512 + hf * 256 + l * 4 + e] = wba[i]; }
        __syncthreads();
    }
    const int gw = F.vcu * NWAVES + F.wave, l = F.lane;
    for (int r = 0; r < 16; ++r) {
        const int m = gw * 16 + r, b = m >> 11;
        const size_t ro = (size_t)m * D + 8 * l;
        float x[4][8];
#pragma unroll
        for (int j = 0; j < 4; ++j) { const f32x4 x0 = *(const f32x4*)(xold + ro + 512 * j), x1 = *(const f32x4*)(xold + ro + 512 * j + 4);
            x[j][0] = x0[0]; x[j][1] = x0[1]; x[j][2] = x0[2]; x[j][3] = x0[3]; x[j][4] = x1[0]; x[j][5] = x1[1]; x[j][6] = x1[2]; x[j][7] = x1[3]; }
        if (has_prev) {
            float y[4][8]; float ss = 0.f;
#pragma unroll
            for (int j = 0; j < 4; ++j) { const v4u yw = *(const v4u*)(Y + ro + 512 * j); unpack8(yw, y[j]);
#pragma unroll
                for (int e = 0; e < 8; ++e) ss += y[j][e] * y[j][e]; }
            const float ry = 1.0f / sqrtf(wave_sum(ss) * (1.0f / D) + EPS);
            const float* al = modv + ((size_t)((q - 1) * 3 + 2) * 16 + b) * D + 8 * l;
#pragma unroll
            for (int j = 0; j < 4; ++j) { const f32x4 a0 = *(const f32x4*)(al + 512 * j), a1 = *(const f32x4*)(al + 512 * j + 4);
#pragma unroll
                for (int e = 0; e < 4; ++e) { x[j][e] += a0[e] * (y[j][e] * ry); x[j][4 + e] += a1[e] * (y[j][4 + e] * ry); }
                *(f32x4*)(xnew + ro + 512 * j) = (f32x4){x[j][0], x[j][1], x[j][2], x[j][3]}; *(f32x4*)(xnew + ro + 512 * j + 4) = (f32x4){x[j][4], x[j][5], x[j][6], x[j][7]}; }
        }
        if (has_next) {
            float ss = 0.f;
#pragma unroll
            for (int j = 0; j < 4; ++j)
#pragma unroll
                for (int e = 0; e < 8; ++e) ss += x[j][e] * x[j][e];
            const float rx = 1.0f / sqrtf(wave_sum(ss) * (1.0f / D) + EPS);
            const float* Bv = modv + ((size_t)(q * 3 + 1) * 16 + b) * D + 8 * l;
            const float* Cv = modv + ((size_t)(q * 3 + 0) * 16 + b) * D + 8 * l;
#pragma unroll
            for (int j = 0; j < 4; ++j) { const f32x4 b0 = *(const f32x4*)(Bv + 512 * j), b1 = *(const f32x4*)(Bv + 512 * j + 4), c0 = *(const f32x4*)(Cv + 512 * j), c1 = *(const f32x4*)(Cv + 512 * j + 4);
#pragma unroll
                for (int e = 0; e < 4; ++e) { x[j][e] = x[j][e] * rx * b0[e] + c0[e]; x[j][4 + e] = x[j][4 + e] * rx * b1[e] + c1[e]; }
                *(v4u*)(H + ro + 512 * j) = pack8(x[j]); }
            if (DO_BA) {
                float mine = 0.f;
#pragma unroll
                for (int o = 0; o < 16; ++o) { float p = 0.f;
#pragma unroll
                    for (int j = 0; j < 4; ++j) { const f32x4 w0 = *(const LAS f32x4*)(wl + o * 2048 + j * 512 + l * 4), w1 = *(const LAS f32x4*)(wl + o * 2048 + j * 512 + 256 + l * 4);
                        p += x[j][0] * w0[0] + x[j][1] * w0[1] + x[j][2] * w0[2] + x[j][3] * w0[3] + x[j][4] * w1[0] + x[j][5] * w1[1] + x[j][6] * w1[2] + x[j][7] * w1[3]; }
                    p = wave_sum(p); mine = (l == o) ? p : mine; }
                if (l < 16) { float v;
                    if (l < 8) v = 1.0f / (1.0f + expf(-mine));
                    else { const float z = mine + a.in[11][l - 8]; const float sp = z > 20.f ? z : log1pf(expf(z)); v = -expf(a.in[10][l - 8]) * sp; }
                    ((float*)(ws + WS_BG))[(size_t)m * 16 + l] = v; }
            }
        }
    }
}

__device__ __forceinline__ void ev_prep(Frame& F, const Args& a) {
    unsigned char* ws = a.ws;
    bf16* P = (bf16*)(ws + WS_BIG); bf16* QKV = (bf16*)(ws + WS_EXT);
    const float* cw = a.in[9];
    const float* rc = (const float*)(ws + WS_ROPE); const float* rs = rc + T * 128;
    const int gw = F.vcu * NWAVES + F.wave, l = F.lane;
    for (int r = 0; r < 16; ++r) {
        const int m = gw * 16 + r, t = m & (T - 1);
#pragma unroll
        for (int g = 0; g < 6; ++g) {
            const int c0 = 512 * g + 8 * l;
            float acc[8];
#pragma unroll
            for (int e = 0; e < 8; ++e) acc[e] = 0.f;
#pragma unroll
            for (int tap = 0; tap < 4; ++tap) {
                if (t - 3 + tap >= 0) {
                    const v4u pw = *(const v4u*)(P + (size_t)(m - 3 + tap) * 8192 + c0); float pv[8]; unpack8(pw, pv);
                    const f32x4 w0 = *(const f32x4*)(cw + tap * 3072 + c0), w1 = *(const f32x4*)(cw + tap * 3072 + c0 + 4);
#pragma unroll
                    for (int e = 0; e < 4; ++e) { acc[e] += w0[e] * pv[e]; acc[4 + e] += w1[e] * pv[4 + e]; }
                }
            }
#pragma unroll
            for (int e = 0; e < 8; ++e) acc[e] = silu_f(acc[e]);
            if (g < 4) {
                float ss = 0.f;
#pragma unroll
                for (int e = 0; e < 8; ++e) ss += acc[e] * acc[e];
                ss += __shfl_xor(ss, 1); ss += __shfl_xor(ss, 2); ss += __shfl_xor(ss, 4); ss += __shfl_xor(ss, 8);
                float rn = 1.0f / sqrtf(ss + EPS);
                if (g < 2) rn *= 0.08838834764831845f;
#pragma unroll
                for (int e = 0; e < 8; ++e) acc[e] *= rn;
            }
            *(v4u*)(QKV + (size_t)m * 3072 + c0) = pack8(acc);
        }
        {
            const int hh = l >> 4, i0 = (l & 15) * 8;
            const f32x4 cs0 = *(const f32x4*)(rc + t * 128 + i0), cs1 = *(const f32x4*)(rc + t * 128 + i0 + 4);
            const f32x4 sn0 = *(const f32x4*)(rs + t * 128 + i0), sn1 = *(const f32x4*)(rs + t * 128 + i0 + 4);
            const float cs[8] = {cs0[0], cs0[1], cs0[2], cs0[3], cs1[0], cs1[1], cs1[2], cs1[3]};
            const float sn[8] = {sn0[0], sn0[1], sn0[2], sn0[3], sn1[0], sn1[1], sn1[2], sn1[3]};
#pragma unroll
            for (int w = 0; w < 2; ++w) {
                bf16* base = P + (size_t)m * 8192 + 4096 + 1024 * w + 256 * hh + i0;
                const float scl = w ? 0.0625f * exp2f((float)(63 - (t & 63)) * log2f(1.0f - exp2f(-5.0f - (float)hh))) : 1.0f;
                float x1[8], x2[8], o1[8], o2[8];
                unpack8(*(const v4u*)base, x1); unpack8(*(const v4u*)(base + 128), x2);
#pragma unroll
                for (int e = 0; e < 8; ++e) { o1[e] = (x1[e] * cs[e] - x2[e] * sn[e]) * scl; o2[e] = (x2[e] * cs[e] + x1[e] * sn[e]) * scl; }
                *(v4u*)base = pack8(o1); *(v4u*)(base + 128) = pack8(o2);
            }
        }
    }
}

typedef short bf16x8 __attribute__((ext_vector_type(8)));
typedef short s16x4 __attribute__((ext_vector_type(4)));
typedef short v4i16_t __attribute__((ext_vector_type(4)));
__device__ __forceinline__ f32x4 mfma16(bf16x8 a, bf16x8 b, f32x4 c) { return __builtin_amdgcn_mfma_f32_16x16x32_bf16(a, b, c, 0, 0, 0); }
__device__ __forceinline__ bf16x8 mkfrag(const f32x4 x0, const f32x4 x1) {
    v4u w; w.x = cvt_pk_bf16(x0[0], x0[1]); w.y = cvt_pk_bf16(x0[2], x0[3]); w.z = cvt_pk_bf16(x1[0], x1[1]); w.w = cvt_pk_bf16(x1[2], x1[3]);
    return __builtin_bit_cast(bf16x8, w);
}
__device__ __forceinline__ bf16x8 join64(const v2u lo, const v2u hi) { v4u w; w.x = lo.x; w.y = lo.y; w.z = hi.x; w.w = hi.y; return __builtin_bit_cast(bf16x8, w); }
__device__ __forceinline__ bf16x8 frag_pi(const LAS unsigned char* rowp, int k0, int kq) {
    return join64(*(const LAS v2u*)(rowp + (k0 + 4 * kq) * 2), *(const LAS v2u*)(rowp + (k0 + 16 + 4 * kq) * 2));
}
__device__ __forceinline__ v2u tr_read(const LAS unsigned char* p) {
    return __builtin_bit_cast(v2u, __builtin_amdgcn_ds_read_tr16_b64_v4i16((LAS v4i16_t*)p));
}
constexpr size_t PW_GT = WS_H, PW_GQK = WS_H + 32 * MiB, PW_GVEC = WS_H + 64 * MiB, PW_RQK = WS_H + 72 * MiB;

__device__ __forceinline__ void ev_chunk_prep(Frame& F, const Args& a) {
    unsigned char* ws = a.ws;
    const bf16* P = (const bf16*)(ws + WS_BIG); const bf16* QKV = (const bf16*)(ws + WS_EXT); const float* BG = (const float*)(ws + WS_BG);
    const int l = F.lane, c = l & 15, rq = l >> 4;
    const int gw = F.vcu * NWAVES + F.wave;
    LAS float* Al = (LAS float*)(F.lds + F.wave * WAVE_LDS);
    for (int jg = gw; jg < 4096; jg += 2048) {
        const int bh = jg >> 5, n = jg & 31, b = bh >> 3, h = bh & 7;
        const size_t m0 = (size_t)b * T + 64 * n;
        const float beta = BG[(m0 + l) * 16 + h], g = BG[(m0 + l) * 16 + 8 + h];
        float G = g;
#pragma unroll
        for (int o = 1; o < 64; o <<= 1) { const float t = __shfl_up(G, o); if (l >= o) G += t; }
        const float Glast = __shfl(G, 63);
        { float* vec = (float*)(ws + PW_GVEC) + (size_t)jg * 256;
          vec[l] = beta; vec[64 + l] = __expf(G); vec[128 + l] = __expf(Glast - G); vec[192 + l] = __expf(Glast); }
        f32x4 kk[4][4], qk[4][4];
#pragma unroll
        for (int ib = 0; ib < 4; ++ib)
#pragma unroll
            for (int jb = 0; jb < 4; ++jb) { kk[ib][jb] = (f32x4){0.f, 0.f, 0.f, 0.f}; qk[ib][jb] = (f32x4){0.f, 0.f, 0.f, 0.f}; }
#pragma unroll
        for (int s = 0; s < 4; ++s) {
            bf16x8 kf[4], qf[4];
#pragma unroll
            for (int ib = 0; ib < 4; ++ib) { const bf16* rp = QKV + (m0 + 16 * ib + c) * 3072 + 128 * h + 32 * s + 8 * rq;
                qf[ib] = *(const bf16x8*)rp; kf[ib] = *(const bf16x8*)(rp + 1024); }
#pragma unroll
            for (int ib = 0; ib < 4; ++ib)
#pragma unroll
                for (int jb = 0; jb <= ib; ++jb) { kk[ib][jb] = mfma16(kf[ib], kf[jb], kk[ib][jb]); qk[ib][jb] = mfma16(qf[ib], kf[jb], qk[ib][jb]); }
        }
        float Gj[4];
#pragma unroll
        for (int jb = 0; jb < 4; ++jb) Gj[jb] = __shfl(G, 16 * jb + c);
        bf16* qko = (bf16*)(ws + PW_GQK) + (size_t)jg * 4096;
        LAS float* Alq = Al + (4 * rq) * 68 + c;
#pragma unroll
        for (int ib = 0; ib < 4; ++ib)
#pragma unroll
            for (int e = 0; e < 4; ++e) { const int i = 16 * ib + 4 * rq + e; const float Gi = __shfl(G, i);
#pragma unroll
                for (int jb = 0; jb < 4; ++jb) { const int j = 16 * jb + c; float qv = 0.f;
                    if (jb <= ib) qv = (i >= j) ? qk[ib][jb][e] * __expf(Gi - Gj[jb]) : 0.f;
                    Alq[(16 * ib + e) * 68 + 16 * jb] = qv; } }
#pragma unroll 4
        for (int i = 0; i < 64; ++i) qko[i * 64 + l] = (bf16)(cvt_pk_bf16(Al[i * 68 + l], 0.f) & 0xffffu);
#pragma unroll
        for (int ib = 0; ib < 4; ++ib)
#pragma unroll
            for (int e = 0; e < 4; ++e) { const int i = 16 * ib + 4 * rq + e; const float Gi = __shfl(G, i), bi = __shfl(beta, i);
#pragma unroll
                for (int jb = 0; jb < 4; ++jb) { const int j = 16 * jb + c; float av = 0.f;
                    if (jb <= ib) av = (i > j) ? bi * kk[ib][jb][e] * __expf(Gi - Gj[jb]) : 0.f;
                    Alq[(16 * ib + e) * 68 + 16 * jb] = av; } }
        for (int i = 0; i < 64; ++i) {
            float acc0 = (l == i) ? 1.f : 0.f, acc1 = 0.f;
            const int nj = (i + 3) >> 2;
            for (int jj = 0; jj < nj; ++jj) { const f32x4 a4 = *(const LAS f32x4*)(Al + i * 68 + 4 * jj);
                const float t0 = Al[(4 * jj) * 68 + l], t1 = Al[(4 * jj + 1) * 68 + l], t2 = Al[(4 * jj + 2) * 68 + l], t3 = Al[(4 * jj + 3) * 68 + l];
                acc0 = fmaf(-a4[0], t0, acc0); acc1 = fmaf(-a4[1], t1, acc1); acc0 = fmaf(-a4[2], t2, acc0); acc1 = fmaf(-a4[3], t3, acc1); }
            Al[i * 68 + l] = acc0 + acc1;
        }
        bf16* to = (bf16*)(ws + PW_GT) + (size_t)jg * 4096;
#pragma unroll 4
        for (int i = 0; i < 64; ++i) to[i * 64 + l] = (bf16)(cvt_pk_bf16(Al[i * 68 + l], 0.f) & 0xffffu);
    }
    {
        const int jr = gw, bhr = jr >> 5, n = jr & 31, b = bhr >> 2, hr = bhr & 3;
        const size_t m0 = (size_t)b * T + 64 * n;
        const float lg = log2f(1.0f - exp2f(-5.0f - (float)hr));
        f32x4 qk[4][4];
#pragma unroll
        for (int ib = 0; ib < 4; ++ib)
#pragma unroll
            for (int jb = 0; jb < 4; ++jb) qk[ib][jb] = (f32x4){0.f, 0.f, 0.f, 0.f};
        for (int s = 0; s < 8; ++s) {
            bf16x8 kf[4], qf[4];
#pragma unroll
            for (int ib = 0; ib < 4; ++ib) { const bf16* rp = P + (m0 + 16 * ib + c) * 8192 + 4096 + 256 * hr + 32 * s + 8 * rq;
                qf[ib] = *(const bf16x8*)rp; kf[ib] = *(const bf16x8*)(rp + 1024); }
#pragma unroll
            for (int ib = 0; ib < 4; ++ib)
#pragma unroll
                for (int jb = 0; jb <= ib; ++jb) qk[ib][jb] = mfma16(qf[ib], kf[jb], qk[ib][jb]);
        }
        bf16* qko = (bf16*)(ws + PW_RQK) + (size_t)jr * 4096;
        LAS float* Alq = Al + (4 * rq) * 68 + c;
#pragma unroll
        for (int ib = 0; ib < 4; ++ib)
#pragma unroll
            for (int e = 0; e < 4; ++e) { const int i = 16 * ib + 4 * rq + e; const float rs = exp2f((float)(i - 63) * lg);
#pragma unroll
                for (int jb = 0; jb < 4; ++jb) { const int j = 16 * jb + c; float qv = 0.f;
                    if (jb <= ib) qv = (i >= j) ? qk[ib][jb][e] * rs : 0.f;
                    Alq[(16 * ib + e) * 68 + 16 * jb] = qv; } }
#pragma unroll 4
        for (int i = 0; i < 64; ++i) qko[i * 64 + l] = (bf16)(cvt_pk_bf16(Al[i * 68 + l], 0.f) & 0xffffu);
    }
}
__device__ __forceinline__ void ev_chunk_scan(Frame& F, const Args& a) {
    unsigned char* ws = a.ws;
    const bf16* P = (const bf16*)(ws + WS_BIG); const bf16* QKV = (const bf16*)(ws + WS_EXT);
    bf16* O = (bf16*)(ws + WS_Y);
    const int l = F.lane, c = l & 15, rq = l >> 4, tid = F.tid, vs = F.wave;
    LAS unsigned char* L = F.lds;
    const f32x4 z4 = (f32x4){0.f, 0.f, 0.f, 0.f};
    if (blockIdx.x < 128) {
        const int bh = blockIdx.x, b = bh >> 3, h = bh & 7;
        constexpr int KL = 0, QL = 17408, VL = 34816, TL = 52224, QKL = 61440, VECL = 70656;
        f32x4 Sb[8];
#pragma unroll
        for (int kb = 0; kb < 8; ++kb) Sb[kb] = z4;
        v4u pk[2], pq[2], pv[2], pt, pqk, pvec;
#define GS_ISSUE(n) do { const size_t m0_ = (size_t)b * T + 64 * (n); const size_t job_ = (size_t)bh * 32 + (n); \
        _Pragma("unroll") for (int i = 0; i < 2; ++i) { const int ci = tid + 512 * i, row = ci >> 4, c16 = ci & 15; const bf16* sp = QKV + (m0_ + row) * 3072 + 128 * h + 8 * c16; \
            pq[i] = *(const v4u*)sp; pk[i] = *(const v4u*)(sp + 1024); pv[i] = *(const v4u*)(sp + 2048); } \
        pt = *(const v4u*)((const bf16*)(ws + PW_GT) + job_ * 4096 + tid * 8); pqk = *(const v4u*)((const bf16*)(ws + PW_GQK) + job_ * 4096 + tid * 8); \
        pvec = *(const v4u*)((const float*)(ws + PW_GVEC) + job_ * 256 + 4 * (tid & 63)); } while (0)
        GS_ISSUE(0);
        for (int n = 0; n < 32; ++n) {
            __syncthreads();
#pragma unroll
            for (int i = 0; i < 2; ++i) { const int ci = tid + 512 * i, row = ci >> 4, c16 = ci & 15;
                *(LAS v4u*)(L + KL + row * 272 + c16 * 16) = pk[i]; *(LAS v4u*)(L + QL + row * 272 + c16 * 16) = pq[i]; *(LAS v4u*)(L + VL + row * 272 + c16 * 16) = pv[i]; }
            *(LAS v4u*)(L + TL + (tid >> 3) * 144 + (tid & 7) * 16) = pt; *(LAS v4u*)(L + QKL + (tid >> 3) * 144 + (tid & 7) * 16) = pqk;
            if (tid < 64) *(LAS v4u*)(L + VECL + tid * 16) = pvec;
            __syncthreads();
            if (n + 1 < 32) GS_ISSUE(n + 1);
            const size_t m0 = (size_t)b * T + 64 * n;
            bf16x8 Sf[4];
#pragma unroll
            for (int s = 0; s < 4; ++s) Sf[s] = mkfrag(Sb[2 * s], Sb[2 * s + 1]);
            f32x4 KS[4], QS[4];
#pragma unroll
            for (int tb = 0; tb < 4; ++tb) { KS[tb] = z4; QS[tb] = z4;
                const LAS unsigned char* kr = L + KL + (16 * tb + c) * 272; const LAS unsigned char* qr = L + QL + (16 * tb + c) * 272;
#pragma unroll
                for (int s = 0; s < 4; ++s) { KS[tb] = mfma16(frag_pi(kr, 32 * s, rq), Sf[s], KS[tb]); QS[tb] = mfma16(frag_pi(qr, 32 * s, rq), Sf[s], QS[tb]); }
                __builtin_amdgcn_sched_barrier(0); }
            f32x4 R[4], eG[4], c3[4];
#pragma unroll
            for (int tb = 0; tb < 4; ++tb) {
                const v2u vw = tr_read(L + VL + (16 * tb + 4 * rq + (c >> 2)) * 272 + 32 * vs + 8 * (c & 3));
                const f32x4 be = *(const LAS f32x4*)(L + VECL + (16 * tb + 4 * rq) * 4);
                eG[tb] = *(const LAS f32x4*)(L + VECL + 256 + (16 * tb + 4 * rq) * 4); c3[tb] = *(const LAS f32x4*)(L + VECL + 512 + (16 * tb + 4 * rq) * 4);
                const float v0 = bfl(vw.x), v1 = bfh(vw.x), v2 = bfl(vw.y), v3 = bfh(vw.y);
                R[tb] = (f32x4){be[0] * (v0 - eG[tb][0] * KS[tb][0]), be[1] * (v1 - eG[tb][1] * KS[tb][1]), be[2] * (v2 - eG[tb][2] * KS[tb][2]), be[3] * (v3 - eG[tb][3] * KS[tb][3])};
            }
            const float dd = *(const LAS float*)(L + VECL + 768);
            bf16x8 Rf[2]; Rf[0] = mkfrag(R[0], R[1]); Rf[1] = mkfrag(R[2], R[3]);
            f32x4 Vn[4];
#pragma unroll
            for (int tb = 0; tb < 4; ++tb) { Vn[tb] = z4; const LAS unsigned char* tr = L + TL + (16 * tb + c) * 144;
#pragma unroll
                for (int s2 = 0; s2 <= (tb >> 1); ++s2) Vn[tb] = mfma16(frag_pi(tr, 32 * s2, rq), Rf[s2], Vn[tb]); }
            bf16x8 Vf[2], Wf[2];
            Vf[0] = mkfrag(Vn[0], Vn[1]); Vf[1] = mkfrag(Vn[2], Vn[3]);
            Wf[0] = mkfrag(Vn[0] * c3[0], Vn[1] * c3[1]); Wf[1] = mkfrag(Vn[2] * c3[2], Vn[3] * c3[3]);
#pragma unroll
            for (int tb = 0; tb < 4; ++tb) { f32x4 o2 = z4; const LAS unsigned char* qkr = L + QKL + (16 * tb + c) * 144;
#pragma unroll
                for (int s2 = 0; s2 <= (tb >> 1); ++s2) o2 = mfma16(frag_pi(qkr, 32 * s2, rq), Vf[s2], o2);
#pragma unroll
                for (int e = 0; e < 4; ++e) O[(m0 + 16 * tb + 4 * rq + e) * D + 128 * h + 16 * vs + c] = (bf16)(cvt_pk_bf16(eG[tb][e] * QS[tb][e] + o2[e], 0.f) & 0xffffu); }
#pragma unroll
            for (int kb = 0; kb < 8; ++kb) { f32x4 acc = Sb[kb] * dd;
#pragma unroll
                for (int s2 = 0; s2 < 2; ++s2) {
                    const v2u p0 = tr_read(L + KL + (32 * s2 + 4 * rq + (c >> 2)) * 272 + 32 * kb + 8 * (c & 3));
                    const v2u p1 = tr_read(L + KL + (32 * s2 + 16 + 4 * rq + (c >> 2)) * 272 + 32 * kb + 8 * (c & 3));
                    acc = mfma16(join64(p0, p1), Wf[s2], acc); }
                Sb[kb] = acc; if (kb & 1) __builtin_amdgcn_sched_barrier(0); }
        }
#undef GS_ISSUE
    } else {
        const int u = blockIdx.x - 128, bhr = u >> 1, half = u & 1, b = bhr >> 2, hr = bhr & 3;
        constexpr int QL = 0, KL = 33792, VL = 67584, QKL = 84992;
        const float lg = log2f(1.0f - exp2f(-5.0f - (float)hr)), dd = exp2f(64.0f * lg);
        f32x4 Sb[16];
#pragma unroll
        for (int kb = 0; kb < 16; ++kb) Sb[kb] = z4;
        v4u pq[4], pk[4], pv[2], pqk;
#define RS_ISSUE(n) do { const size_t m0_ = (size_t)b * T + 64 * (n); const size_t job_ = (size_t)bhr * 32 + (n); \
        _Pragma("unroll") for (int i = 0; i < 4; ++i) { const int ci = tid + 512 * i, row = ci >> 5, c16 = ci & 31; const bf16* sp = P + (m0_ + row) * 8192 + 4096 + 256 * hr + 8 * c16; \
            pq[i] = *(const v4u*)sp; pk[i] = *(const v4u*)(sp + 1024); } \
        _Pragma("unroll") for (int i = 0; i < 2; ++i) { const int ci = tid + 512 * i, row = ci >> 4, c16 = ci & 15; pv[i] = *(const v4u*)(P + (m0_ + row) * 8192 + 6144 + 256 * hr + 128 * half + 8 * c16); } \
        pqk = *(const v4u*)((const bf16*)(ws + PW_RQK) + job_ * 4096 + tid * 8); } while (0)
        RS_ISSUE(0);
        for (int n = 0; n < 32; ++n) {
            __syncthreads();
#pragma unroll
            for (int i = 0; i < 4; ++i) { const int ci = tid + 512 * i, row = ci >> 5, c16 = ci & 31;
                *(LAS v4u*)(L + QL + row * 528 + c16 * 16) = pq[i]; *(LAS v4u*)(L + KL + row * 528 + c16 * 16) = pk[i]; }
#pragma unroll
            for (int i = 0; i < 2; ++i) { const int ci = tid + 512 * i, row = ci >> 4, c16 = ci & 15; *(LAS v4u*)(L + VL + row * 272 + c16 * 16) = pv[i]; }
            *(LAS v4u*)(L + QKL + (tid >> 3) * 144 + (tid & 7) * 16) = pqk;
            __syncthreads();
            if (n + 1 < 32) RS_ISSUE(n + 1);
            const size_t m0 = (size_t)b * T + 64 * n;
            f32x4 QS[4];
#pragma unroll
            for (int tb = 0; tb < 4; ++tb) QS[tb] = z4;
#pragma unroll
            for (int s = 0; s < 8; ++s) { const bf16x8 sf = mkfrag(Sb[2 * s], Sb[2 * s + 1]);
#pragma unroll
                for (int tb = 0; tb < 4; ++tb) QS[tb] = mfma16(frag_pi(L + QL + (16 * tb + c) * 528, 32 * s, rq), sf, QS[tb]);
                __builtin_amdgcn_sched_barrier(0); }
            bf16x8 Vf[2];
#pragma unroll
            for (int s2 = 0; s2 < 2; ++s2) {
                const v2u p0 = tr_read(L + VL + (32 * s2 + 8 * rq + (c >> 2)) * 272 + 32 * vs + 8 * (c & 3));
                const v2u p1 = tr_read(L + VL + (32 * s2 + 8 * rq + 4 + (c >> 2)) * 272 + 32 * vs + 8 * (c & 3));
                Vf[s2] = join64(p0, p1); }
#pragma unroll
            for (int tb = 0; tb < 4; ++tb) { f32x4 o2 = z4;
#pragma unroll
                for (int s2 = 0; s2 <= (tb >> 1); ++s2) o2 = mfma16(*(const LAS bf16x8*)(L + QKL + (16 * tb + c) * 144 + (32 * s2 + 8 * rq) * 2), Vf[s2], o2);
#pragma unroll
                for (int e = 0; e < 4; ++e) { const int i = 16 * tb + 4 * rq + e;
                    O[(m0 + i) * D + 1024 + 256 * hr + 128 * half + 16 * vs + c] = (bf16)(cvt_pk_bf16(exp2f((float)(i + 1) * lg) * QS[tb][e] + o2[e], 0.f) & 0xffffu); } }
#pragma unroll
            for (int kb = 0; kb < 16; ++kb) { f32x4 acc = Sb[kb] * dd;
#pragma unroll
                for (int s2 = 0; s2 < 2; ++s2) {
                    const v2u p0 = tr_read(L + KL + (32 * s2 + 8 * rq + (c >> 2)) * 528 + 32 * kb + 8 * (c & 3));
                    const v2u p1 = tr_read(L + KL + (32 * s2 + 8 * rq + 4 + (c >> 2)) * 528 + 32 * kb + 8 * (c & 3));
                    acc = mfma16(join64(p0, p1), Vf[s2], acc); }
                Sb[kb] = acc; if (kb & 1) __builtin_amdgcn_sched_barrier(0); }
        }
#undef RS_ISSUE
    }
    __syncthreads();
}

__device__ __forceinline__ void ev_post(Frame& F, const Args& a) {
    unsigned char* ws = a.ws;
    const bf16* P = (const bf16*)(ws + WS_BIG); const bf16* O = (const bf16*)(ws + WS_Y); bf16* OM = (bf16*)(ws + WS_H);
    const int gw = F.vcu * NWAVES + F.wave, l = F.lane;
    for (int r = 0; r < 16; ++r) {
        const int m = gw * 16 + r;
#pragma unroll
        for (int j = 0; j < 4; ++j) {
            const int c0 = 512 * j + 8 * l;
            float o[8], z[8]; unpack8(*(const v4u*)(O + (size_t)m * D + c0), o);
            float ss = 0.f;
#pragma unroll
            for (int e = 0; e < 8; ++e) ss += o[e] * o[e];
            ss += __shfl_xor(ss, 1); ss += __shfl_xor(ss, 2); ss += __shfl_xor(ss, 4); ss += __shfl_xor(ss, 8);
            float rn; const float* gn;
            if (j < 2) { rn = 1.0f / sqrtf(ss * (1.0f / 128.0f) + EPS); gn = a.in[12] + (c0 & 127); unpack8(*(const v4u*)(P + (size_t)m * 8192 + 3072 + c0), z); }
            else { ss += __shfl_xor(ss, 16); rn = 1.0f / sqrtf(ss * (1.0f / 256.0f) + EPS); gn = a.in[13] + (c0 - 1024); unpack8(*(const v4u*)(P + (size_t)m * 8192 + 7168 + (c0 - 1024)), z); }
            const f32x4 g0 = *(const f32x4*)gn, g1 = *(const f32x4*)(gn + 4);
            const float gg[8] = {g0[0], g0[1], g0[2], g0[3], g1[0], g1[1], g1[2], g1[3]};
#pragma unroll
            for (int e = 0; e < 8; ++e) o[e] = o[e] * rn * gg[e] * silu_f(z[e]);
            *(v4u*)(OM + (size_t)m * D + c0) = pack8(o);
        }
    }
}

__device__ __forceinline__ void od_conv(Frame& F, const Args& a) {
    unsigned char* ws = a.ws;
    const bf16* P1 = (const bf16*)(ws + WS_BIG); bf16* XC = (bf16*)(ws + WS_H);
    const float* cw = a.in[16]; const float* cb = a.in[17];
    const int gw = F.vcu * NWAVES + F.wave, l = F.lane;
    for (int r = 0; r < 16; ++r) {
        const int m = gw * 16 + r, t = m & (T - 1);
#pragma unroll
        for (int j = 0; j < 4; ++j) {
            const int c0 = 512 * j + 8 * l;
            const f32x4 b0 = *(const f32x4*)(cb + c0), b1 = *(const f32x4*)(cb + c0 + 4);
            float acc[8] = {b0[0], b0[1], b0[2], b0[3], b1[0], b1[1], b1[2], b1[3]};
#pragma unroll
            for (int tap = 0; tap < 4; ++tap) {
                if (t - 3 + tap >= 0) {
                    float pv[8]; unpack8(*(const v4u*)(P1 + (size_t)(m - 3 + tap) * 4096 + 2048 + c0), pv);
                    const f32x4 w0 = *(const f32x4*)(cw + tap * 2048 + c0), w1 = *(const f32x4*)(cw + tap * 2048 + c0 + 4);
#pragma unroll
                    for (int e = 0; e < 4; ++e) { acc[e] += w0[e] * pv[e]; acc[4 + e] += w1[e] * pv[4 + e]; }
                }
            }
            *(v4u*)(XC + (size_t)m * D + c0) = pack8(acc);
        }
    }
}
__device__ __forceinline__ float gelu_tanh(float y) {
    const float u = 0.7978845608028654f * (y + 0.044715f * y * y * y);
    const float th = 1.0f - 2.0f * __builtin_amdgcn_rcpf(__expf(2.0f * u) + 1.0f);
    return 0.5f * y * (1.0f + th);
}
__device__ __forceinline__ void od_scan(Frame& F, const Args& a) {
    unsigned char* ws = a.ws;
    const bf16* P1 = (const bf16*)(ws + WS_BIG); const float* ADEC = (const float*)(ws + WS_ADEC); const bf16* INP = (const bf16*)(ws + WS_EXT); bf16* HSY = (bf16*)(ws + WS_H);
    typedef float f32x2 __attribute__((ext_vector_type(2)));
    LAS f32x4* seg = (LAS f32x4*)F.lds;
    const int b = blockIdx.x >> 4, c = (blockIdx.x & 15) * 128 + 2 * F.lane;
    const size_t m0 = (size_t)b * T + (size_t)F.wave * 256;
    float A0 = 1.f, A1 = 1.f, h0 = 0.f, h1 = 0.f;
    for (int t0 = 0; t0 < 256; t0 += 16) {
        f32x2 av[16]; unsigned iv[16];
#pragma unroll
        for (int i = 0; i < 16; ++i) { const size_t m = m0 + t0 + i; av[i] = *(const f32x2*)(ADEC + m * D + c); iv[i] = *(const unsigned*)(INP + m * D + c); }
#pragma unroll
        for (int i = 0; i < 16; ++i) { h0 = fmaf(av[i][0], h0, bfl(iv[i])); h1 = fmaf(av[i][1], h1, bfh(iv[i])); A0 *= av[i][0]; A1 *= av[i][1]; }
    }
    seg[F.wave * 64 + F.lane] = (f32x4){A0, h0, A1, h1};
    __syncthreads();
    h0 = 0.f; h1 = 0.f;
    for (int s = 0; s < F.wave; ++s) { const f32x4 g = seg[s * 64 + F.lane]; h0 = fmaf(g[0], h0, g[1]); h1 = fmaf(g[2], h1, g[3]); }
    for (int t0 = 0; t0 < 256; t0 += 16) {
        f32x2 av[16]; unsigned iv[16], yv[16];
#pragma unroll
        for (int i = 0; i < 16; ++i) { const size_t m = m0 + t0 + i; av[i] = *(const f32x2*)(ADEC + m * D + c); iv[i] = *(const unsigned*)(INP + m * D + c); yv[i] = *(const unsigned*)(P1 + m * 4096 + c); }
#pragma unroll
        for (int i = 0; i < 16; ++i) { const size_t m = m0 + t0 + i; h0 = fmaf(av[i][0], h0, bfl(iv[i])); h1 = fmaf(av[i][1], h1, bfh(iv[i]));
            *(unsigned*)(HSY + m * D + c) = cvt_pk_bf16(h0 * gelu_tanh(bfl(yv[i])), h1 * gelu_tanh(bfh(yv[i]))); }
    }
    __syncthreads();
}

__device__ __forceinline__ bool fresh(Frame& F) { int t = threadIdx.x; asm volatile("" : "+v"(t)); F.tid = t; F.lane = t & 63; return true; }
__global__ void __launch_bounds__(NWAVES * 64, 2) mk_fwd(Args args) {
    extern __shared__ __attribute__((aligned(16))) unsigned char lds[];
    Frame F;
    F.lds = (LAS unsigned char*)lds;
    F.MISC = (volatile LAS unsigned*)(F.lds + MISC_OFF);
    F.tid = threadIdx.x; F.lane = F.tid & 63; F.wave = __builtin_amdgcn_readfirstlane(F.tid >> 6);
    F.G = gridDim.x; { const int bx = blockIdx.x; F.vcu = (F.G % 8 == 0) ? (bx % 8) * (F.G / 8) + bx / 8 : bx; }
    unsigned char* ws = args.ws;
    F.ctl = (gu32*)(ws + WS_CTL);
    for (int u = F.tid; u < (LDS_BYTES - LDSCTL_OFF) / 4; u += NWAVES * 64) ((LAS unsigned*)(F.lds + LDSCTL_OFF))[u] = 0u;
    __syncthreads();
    XcdBarrier bar; bar.bar = (unsigned*)(F.ctl + CW_BAR); bar.x = 0; bar.st = nullptr;
    if (!MK_PER_PHASE) bar = xcd_barrier_post((unsigned*)(F.ctl + CW_BAR), F.MISC + 8);
    const int lo = args.ph_lo, hi = args.ph_hi;
#define IN(k) (lo <= (k) && (k) < hi && fresh(F))
#define GEMM_RUN(...) do { pg8::gemm_phase<__VA_ARGS__>(F.lds, g, S, E); if (PROBE_GEMM_X2) { __syncthreads(); pg8::gemm_phase<__VA_ARGS__>(F.lds, g, S, E); } } while (0)
#define SEAM(k) do { if (IN(k) && IN((k) + 1)) xcd_barrier(bar); } while (0)
    const pg8::bf16_t* Hb = (const pg8::bf16_t*)(ws + WS_H);
    pg8::bf16_t* Yb = (pg8::bf16_t*)(ws + WS_Y);
    pg8::bf16_t* BIGb = (pg8::bf16_t*)(ws + WS_BIG);
#define FFN_PHASES(k, q, wi) \
    if (IN(k)) { norm_pass<false>(F, args, (q)); } SEAM(k); \
    if (IN((k) + 1)) { pg8::Gemm g{Hb, (const pg8::bf16_t*)(ws + WS_W13 + (size_t)(wi) * W13_BYTES), M, 2 * DFF, D, D, 0}; pg8::StaticOrder S; S.init(M, 2 * DFF, F.G, (int)blockIdx.x); \
        pg8::EpiSwiGLU E{BIGb, DFF}; GEMM_RUN(pg8::EpiSwiGLU, pg8::StaticOrder, true, true); } SEAM((k) + 1); \
    if (IN((k) + 2)) { pg8::Gemm g{BIGb, (const pg8::bf16_t*)(ws + WS_W2 + (size_t)(wi) * W2_BYTES), M, D, DFF, DFF, 0}; pg8::StaticOrder S; S.init(M, D, F.G, (int)blockIdx.x); \
        pg8::EpiBf16 E{Yb, D}; GEMM_RUN(pg8::EpiBf16, pg8::StaticOrder, true, true); } SEAM((k) + 2);

    enum { PH_P0 = 0, PH_F0 = 1, PH_N1 = 4, PH_EVIN = 5, PH_EVPREP = 6, PH_EVCP = 7, PH_EVSCAN = 8, PH_EVPOST = 9, PH_EVOUT = 10, PH_F2 = 11, PH_F3 = 14,
           PH_N4 = 17, PH_ODIN = 18, PH_ODCONV = 19, PH_ODGATE = 20, PH_ODSCAN = 21, PH_ODOUT = 22, PH_F5 = 23, PH_FINAL = 26 };
    static_assert(PH_FINAL + 1 == NPHASE, "phase count");
    if (IN(PH_P0)) { p0_prologue(F, args); if (PROBE_P0_X2) { __syncthreads(); p0_prologue(F, args); } } SEAM(PH_P0);
    FFN_PHASES(PH_F0, 0, 0)
    if (IN(PH_N1)) { norm_pass<true>(F, args, 1); } SEAM(PH_N1);
    if (IN(PH_EVIN)) { pg8::Gemm g{Hb, (const pg8::bf16_t*)(ws + WS_WEVIN), M, 8192, D, D, 0}; pg8::StaticOrder S; S.init(M, 8192, F.G, (int)blockIdx.x);
        pg8::EpiBf16 E{BIGb, 8192}; GEMM_RUN(pg8::EpiBf16, pg8::StaticOrder, true, true); } SEAM(PH_EVIN);
    if (IN(PH_EVPREP)) { ev_prep(F, args); } SEAM(PH_EVPREP);
    if (IN(PH_EVCP)) { ev_chunk_prep(F, args); } SEAM(PH_EVCP);
    if (IN(PH_EVSCAN)) { ev_chunk_scan(F, args); if (PROBE_REC_X2) { __syncthreads(); ev_chunk_scan(F, args); } } SEAM(PH_EVSCAN);
    if (IN(PH_EVPOST)) { ev_post(F, args); } SEAM(PH_EVPOST);
    if (IN(PH_EVOUT)) { pg8::Gemm g{Hb, (const pg8::bf16_t*)(ws + WS_WEVOUT), M, D, D, D, 0}; pg8::StaticOrder S; S.init(M, D, F.G, (int)blockIdx.x);
        pg8::EpiBf16 E{Yb, D}; GEMM_RUN(pg8::EpiBf16, pg8::StaticOrder, true, true); } SEAM(PH_EVOUT);
    FFN_PHASES(PH_F2, 2, 1)
    FFN_PHASES(PH_F3, 3, 2)
    if (IN(PH_N4)) { norm_pass<false>(F, args, 4); } SEAM(PH_N4);
    if (IN(PH_ODIN)) { pg8::Gemm g{Hb, (const pg8::bf16_t*)(ws + WS_WODIN), M, 4096, D, D, 0}; pg8::StaticOrder S; S.init(M, 4096, F.G, (int)blockIdx.x);
        pg8::EpiBf16 E{BIGb, 4096}; GEMM_RUN(pg8::EpiBf16, pg8::StaticOrder, true, true); } SEAM(PH_ODIN);
    if (IN(PH_ODCONV)) { od_conv(F, args); } SEAM(PH_ODCONV);
    if (IN(PH_ODGATE)) { pg8::Gemm g{Hb, (const pg8::bf16_t*)(ws + WS_WGATE), M, 4096, 256, D, 2}; pg8::StaticOrder S; S.init(M, 4096, F.G, (int)blockIdx.x);
        pg8::EpiGates E{(float*)(ws + WS_ADEC), (pg8::bf16_t*)(ws + WS_EXT), Hb, args.in[19], args.in[21], (const float*)(ws + WS_SP8)};
        GEMM_RUN(pg8::EpiGates, pg8::StaticOrder, true, true); } SEAM(PH_ODGATE);
    if (IN(PH_ODSCAN)) { od_scan(F, args); } SEAM(PH_ODSCAN);
    if (IN(PH_ODOUT)) { pg8::Gemm g{Hb, (const pg8::bf16_t*)(ws + WS_WODOUT), M, D, D, D, 0}; pg8::StaticOrder S; S.init(M, D, F.G, (int)blockIdx.x);
        pg8::EpiBf16 E{Yb, D}; GEMM_RUN(pg8::EpiBf16, pg8::StaticOrder, true, true); } SEAM(PH_ODOUT);
    FFN_PHASES(PH_F5, 5, 3)
    if (IN(PH_FINAL)) { norm_pass<false>(F, args, 6); }
#undef IN
#undef SEAM
#undef FFN_PHASES
}

extern "C" void kernel_launch(void* const* d_in, const int* in_sizes, int n_in, void* d_out, int out_size, void* d_ws, size_t ws_size, hipStream_t stream) {
    static int grid = 0;
    if (grid == 0) {
        if (n_in != 24 || in_sizes[0] != M * D || out_size != M * D || ws_size < WS_END) {
            fprintf(stderr, "kernel_launch: unexpected problem (n_in %d, in0 %d, out %d, ws %zu < %zu); nothing launched\n", n_in, n_in > 0 ? in_sizes[0] : -1, out_size, ws_size, (size_t)WS_END); grid = -1; return; }
        int dev = 0, cus = 0, per_cu = 0;
        if (hipGetDevice(&dev) != hipSuccess || hipDeviceGetAttribute(&cus, hipDeviceAttributeMultiprocessorCount, dev) != hipSuccess) { grid = -1; return; }
        if (hipFuncSetAttribute((const void*)mk_fwd, hipFuncAttributeMaxDynamicSharedMemorySize, LDS_BYTES) != hipSuccess) { fprintf(stderr, "kernel_launch: hipFuncSetAttribute failed\n"); grid = -1; return; }
        if (hipOccupancyMaxActiveBlocksPerMultiprocessor(&per_cu, (const void*)mk_fwd, NWAVES * 64, LDS_BYTES) != hipSuccess || per_cu < 1)
            fprintf(stderr, "kernel_launch: note: occupancy query reports %d workgroups per CU\n", per_cu);
        (void)hipGetLastError();
        grid = cus;
        if (grid != 256) fprintf(stderr, "kernel_launch: note: %d CUs (built for 256)\n", grid);
    }
    if (grid < 0) return;
    if (hipMemsetAsync((char*)d_ws + WS_CTL, 0, CTL_ZERO_BYTES, stream) != hipSuccess) return;
    Args a{};
    for (int i = 0; i < 24; ++i) a.in[i] = (const float*)d_in[i];
    a.out = (float*)d_out; a.ws = (unsigned char*)d_ws;
#if MK_PER_PHASE
    for (int k = 0; k < NPHASE; ++k) { a.ph_lo = k; a.ph_hi = k + 1; hipLaunchKernelGGL(mk_fwd, dim3(grid), dim3(NWAVES * 64), LDS_BYTES, stream, a); }
#else
    a.ph_lo = 0; a.ph_hi = NPHASE; hipLaunchKernelGGL(mk_fwd, dim3(grid), dim3(NWAVES * 64), LDS_BYTES, stream, a);
#endif
}
```

```cpp
#include <hip/hip_runtime.h>
#include <cstdio>
#include <cstdint>
#include <cmath>
namespace pg8 {
#define PG8_LAS __attribute__((address_space(3)))
typedef unsigned short bf16_t;
typedef short bf16x8 __attribute__((ext_vector_type(8)));
typedef float f32x4 __attribute__((ext_vector_type(4)));
typedef unsigned u32x4 __attribute__((ext_vector_type(4)));
constexpr int BM = 256, BK = 64, HALF = 128, HTB = HALF * BK * 2  , STAGE_BYTES = 8 * HTB, NXCD = 8, WGM = 8;

__host__ __device__ __forceinline__ int lds_byte(int r, int c) { const int st = (r >> 4) * 2 + (c >> 5), rr = r & 15, cc = c & 31, ob = rr * 64 + cc * 2; return st * 1024 + (ob ^ (((ob >> 9) & 1) << 5)); }
__host__ __device__ __forceinline__ void stage_rc(int b, int& R, int& C) { const int st = b / 1024, sb = b % 1024, swz = sb ^ (((sb >> 9) & 1) << 5); R = (st >> 1) * 16 + swz / 64; C = (st & 1) * 32 + (swz % 64) / 2; }
__host__ __device__ __forceinline__ int perm32(int rho) { const int n = rho >> 4, i = rho & 15; return 8 * (i >> 2) + 4 * n + (i & 3); }

struct Unit { int pm, pn; };
struct Gemm { const bf16_t* A; const bf16_t* Bt; int M, N, K, lda, ablk; };

struct StaticOrder {
    int nM, nN, nwg, G, c;
    __host__ __device__ void init(int M, int N, int G_, int c_) { nM = M / BM; nN = N / BM; nwg = nM * nN; G = G_; c = c_; }
    __host__ __device__ bool next(int i, Unit& u) const {
        const long L = (long)i * G + c; if (L >= nwg) return false;
        int wgid = (int)L; { const int q = nwg / NXCD, r = nwg % NXCD, xcd = wgid % NXCD, off = wgid / NXCD; wgid = (xcd < r ? xcd * (q + 1) : r * (q + 1) + (xcd - r) * q) + off; }
        const int nig = WGM * nN, gid = wgid / nig, fm = gid * WGM, gsz = (nM - fm) < WGM ? (nM - fm) : WGM;
        u.pm = fm + ((wgid % nig) % gsz); u.pn = (wgid % nig) / gsz; return true;
    }
    __device__ __forceinline__ void a_ready(const Unit&) const {}
    __device__ __forceinline__ void done(const Unit&) const {}
};

__device__ __forceinline__ unsigned cvt_pk_bf16(float lo, float hi) { unsigned r; asm volatile("v_cvt_pk_bf16_f32 %0, %1, %2" : "=v"(r) : "v"(lo), "v"(hi)); return r; }
__device__ __forceinline__ float fast_sigmoid(float x) { return __builtin_amdgcn_rcpf(1.0f + __expf(-x)); }
__device__ __forceinline__ float bfl(unsigned w) { return __uint_as_float(w << 16); }
__device__ __forceinline__ float bfh(unsigned w) { return __uint_as_float(w & 0xffff0000u); }

struct EpiBf16 {
    static constexpr bool PERM = true, AFTER_DRAIN = false;
    bf16_t* O; int ldc;
    __device__ __forceinline__ void operator()(const f32x4 (&acc)[2][2][4][2], const Unit& u, int wr, int wc, int fr, int fq) const {
        const int row0 = u.pm * BM + wr * 64 + fr, col0 = u.pn * BM + wc * 32 + 8 * fq;
#pragma unroll
        for (int ai = 0; ai < 2; ++ai)
#pragma unroll
            for (int m = 0; m < 4; ++m) { bf16_t* rowp = O + (size_t)(row0 + ai * HALF + m * 16) * ldc + col0;
#pragma unroll
                for (int bj = 0; bj < 2; ++bj) { const f32x4 v0 = acc[ai][bj][m][0], v1 = acc[ai][bj][m][1];
                    u32x4 w; w.x = cvt_pk_bf16(v0[0], v0[1]); w.y = cvt_pk_bf16(v0[2], v0[3]); w.z = cvt_pk_bf16(v1[0], v1[1]); w.w = cvt_pk_bf16(v1[2], v1[3]);
                    *(u32x4*)(rowp + bj * HALF) = w; } }
    }
};
struct EpiSwiGLU {
    static constexpr bool PERM = true, AFTER_DRAIN = false;
    bf16_t* O; int ldc;
    __device__ __forceinline__ void operator()(const f32x4 (&acc)[2][2][4][2], const Unit& u, int wr, int wc, int fr, int fq) const {
        const int row0 = u.pm * BM + wr * 64 + fr, col0 = u.pn * HALF + wc * 32 + 8 * fq;
#pragma unroll
        for (int ai = 0; ai < 2; ++ai)
#pragma unroll
            for (int m = 0; m < 4; ++m) { bf16_t* rowp = O + (size_t)(row0 + ai * HALF + m * 16) * ldc + col0;
                float r[8];
#pragma unroll
                for (int n = 0; n < 2; ++n)
#pragma unroll
                    for (int e = 0; e < 4; ++e) { const float g = acc[ai][0][m][n][e], up = acc[ai][1][m][n][e]; r[n * 4 + e] = g * fast_sigmoid(g) * up; }
                u32x4 w; w.x = cvt_pk_bf16(r[0], r[1]); w.y = cvt_pk_bf16(r[2], r[3]); w.z = cvt_pk_bf16(r[4], r[5]); w.w = cvt_pk_bf16(r[6], r[7]);
                *(u32x4*)rowp = w; }
    }
};
struct EpiGates {
    static constexpr bool PERM = true, AFTER_DRAIN = false;
    float* ADEC; bf16_t* INP; const bf16_t* XC; const float* ba; const float* bx; const float* sp8;
    __device__ __forceinline__ void operator()(const f32x4 (&acc)[2][2][4][2], const Unit& u, int wr, int wc, int fr, int fq) const {
        const int row0 = u.pm * BM + wr * 64 + fr, c0 = (u.pn >> 1) * 256 + (u.pn & 1) * HALF + wc * 32 + 8 * fq;
#pragma unroll
        for (int ai = 0; ai < 2; ++ai)
#pragma unroll
            for (int m = 0; m < 4; ++m) { const size_t off = (size_t)(row0 + ai * HALF + m * 16) * 2048 + c0;
                const u32x4 xw = *(const u32x4*)(XC + off);
                f32x4 bav[2], bxv[2], spv[2];
#pragma unroll
                for (int n = 0; n < 2; ++n) { bav[n] = *(const f32x4*)(ba + c0 + 4 * n); bxv[n] = *(const f32x4*)(bx + c0 + 4 * n); spv[n] = *(const f32x4*)(sp8 + c0 + 4 * n); }
                const float xc[8] = {bfl(xw.x), bfh(xw.x), bfl(xw.y), bfh(xw.y), bfl(xw.z), bfh(xw.z), bfl(xw.w), bfh(xw.w)};
                float av[8], iv[8];
#pragma unroll
                for (int n = 0; n < 2; ++n)
#pragma unroll
                    for (int e = 0; e < 4; ++e) { const float r = fast_sigmoid(acc[ai][0][m][n][e] + bav[n][e]), ig = fast_sigmoid(acc[ai][1][m][n][e] + bxv[n][e]);
                        const float a = __expf(spv[n][e] * r); av[n * 4 + e] = a; iv[n * 4 + e] = sqrtf(fmaxf(1.0f - a * a, 0.0f)) * ig * xc[n * 4 + e]; }
                *(f32x4*)(ADEC + off) = (f32x4){av[0], av[1], av[2], av[3]}; *(f32x4*)(ADEC + off + 4) = (f32x4){av[4], av[5], av[6], av[7]};
                u32x4 w; w.x = cvt_pk_bf16(iv[0], iv[1]); w.y = cvt_pk_bf16(iv[2], iv[3]); w.z = cvt_pk_bf16(iv[4], iv[5]); w.w = cvt_pk_bf16(iv[6], iv[7]);
                *(u32x4*)(INP + off) = w;
                asm volatile("" ::: "memory"); }
    }
};

template <class Epi, class Sched, bool ALIGN_EPI = false, bool SP2 = false>
__device__ __forceinline__ void gemm_phase(PG8_LAS unsigned char* lds, const Gemm g, const Sched& S, const Epi& E) {
    int tid_ = threadIdx.x; asm volatile("" : "+v"(tid_));
    const int tid = tid_, wid = __builtin_amdgcn_readfirstlane(tid >> 6), lane = tid & 63, wr = wid >> 2, wc = wid & 3, fr = lane & 15, fq = lane >> 4;
    const int K = g.K, nt = K / BK;
    unsigned voffA[2], voffB[2];
#pragma unroll
    for (int i = 0; i < 2; ++i) { int R, C; stage_rc(tid * 16 + i * 8192, R, C); const int Rb = Epi::PERM ? ((R & ~31) + perm32(R & 31)) : R;
        voffA[i] = (unsigned)(R * g.lda + C) * 2u; voffB[i] = (unsigned)(Rb * K + C) * 2u; }
    const size_t kstep = (size_t)(BK * 2);
    const size_t hstep = (size_t)HALF * K * 2, hstepA = (size_t)HALF * g.lda * 2;
    const size_t tstep = 2 * hstep, tstepA = 2 * hstepA;
    const unsigned ldsw = (unsigned)wid * 1024u;
    const int aoff = lds_byte(wr * 64 + fr, fq * 8), boff = lds_byte(wc * 32 + fr, fq * 8);
#define PG8_SA(b, h) (((b) * 2 + (h)) * HTB)
#define PG8_SB(b, h) ((4 + (b) * 2 + (h)) * HTB)
#define PG8_STAGE(bufoff, gbase, voff) do { _Pragma("unroll") for (int _i = 0; _i < 2; ++_i) \
        __builtin_amdgcn_global_load_lds((const unsigned*)((const char*)(gbase) + (voff)[_i]), (PG8_LAS unsigned*)(lds + (bufoff) + ldsw + _i * 8192), 16, 0, 0); } while (0)
#define PG8_LDA(dst, b, h) do { _Pragma("unroll") for (int m = 0; m < 4; ++m) _Pragma("unroll") for (int k = 0; k < 2; ++k) dst[m][k] = *(const PG8_LAS bf16x8*)(lds + PG8_SA(b, h) + aoff + m * 2048 + k * 1024); } while (0)
#define PG8_LDB(dst, b, h) do { _Pragma("unroll") for (int n = 0; n < 2; ++n) _Pragma("unroll") for (int k = 0; k < 2; ++k) dst[n][k] = *(const PG8_LAS bf16x8*)(lds + PG8_SB(b, h) + boff + n * 2048 + k * 1024); } while (0)
#define PG8_MMA(ai, bj, At, Bt) do { __builtin_amdgcn_s_setprio(1); _Pragma("unroll") for (int m = 0; m < 4; ++m) _Pragma("unroll") for (int n = 0; n < 2; ++n) _Pragma("unroll") for (int k = 0; k < 2; ++k) \
        acc[ai][bj][m][n] = __builtin_amdgcn_mfma_f32_16x16x32_bf16(Bt[n][k], At[m][k], acc[ai][bj][m][n], 0, 0, 0); __builtin_amdgcn_s_setprio(0); } while (0)
#define PG8_WAIT_V(n) asm volatile("s_waitcnt vmcnt(" #n ")" ::: "memory")
#define PG8_WAIT_L(n) asm volatile("s_waitcnt lgkmcnt(" #n ")" ::: "memory")
#define PG8_BAR __builtin_amdgcn_s_barrier()
#define PG8_SCHED __builtin_amdgcn_sched_barrier(0)
    Unit cur, nxt; int ui = 0;
    if (!S.next(0, cur)) return;
    f32x4 acc[2][2][4][2];
#pragma unroll
    for (int a = 0; a < 2; ++a)
#pragma unroll
        for (int b = 0; b < 2; ++b)
#pragma unroll
            for (int m = 0; m < 4; ++m)
#pragma unroll
                for (int n = 0; n < 2; ++n) acc[a][b][m][n] = (f32x4){0.f, 0.f, 0.f, 0.f};
    bf16x8 At[4][2], B0[2][2], B1[2][2];
    const char* cA = (const char*)g.A + (size_t)cur.pm * tstepA + (g.ablk ? (size_t)(cur.pn / g.ablk) * K * 2 : (size_t)0); const char* cB = (const char*)g.Bt + (size_t)cur.pn * tstep;
    S.a_ready(cur);
    if constexpr (SP2) {
        PG8_STAGE(PG8_SB(0, 0), cB, voffB); PG8_STAGE(PG8_SB(0, 1), cB + hstep, voffB); PG8_STAGE(PG8_SA(0, 0), cA, voffA); PG8_STAGE(PG8_SA(0, 1), cA + hstepA, voffA);
        if (wr == 1) PG8_BAR;
        PG8_WAIT_V(2); PG8_BAR;
        PG8_STAGE(PG8_SB(1, 0), cB + kstep, voffB); PG8_STAGE(PG8_SA(1, 0), cA + kstep, voffA); PG8_STAGE(PG8_SB(1, 1), cB + hstep + kstep, voffB);
        PG8_WAIT_V(6); PG8_BAR;
    } else {
        PG8_STAGE(PG8_SB(0, 0), cB, voffB); PG8_STAGE(PG8_SA(0, 0), cA, voffA); PG8_STAGE(PG8_SB(0, 1), cB + hstep, voffB); PG8_STAGE(PG8_SA(0, 1), cA + hstepA, voffA);
        if (wr == 1) PG8_BAR;
        PG8_WAIT_V(4); PG8_BAR;
        PG8_STAGE(PG8_SB(1, 0), cB + kstep, voffB); PG8_STAGE(PG8_SA(1, 0), cA + kstep, voffA); PG8_STAGE(PG8_SB(1, 1), cB + hstep + kstep, voffB);
        PG8_WAIT_V(6); PG8_BAR;
    }
    for (;;) {
        const bool has_next = S.next(ui + 1, nxt);
        const char* nA = has_next ? (const char*)g.A + (size_t)nxt.pm * tstepA + (g.ablk ? (size_t)(nxt.pn / g.ablk) * K * 2 : (size_t)0) : cA; const char* nB = has_next ? (const char*)g.Bt + (size_t)nxt.pn * tstep : cB;
        for (int t = 0; t < nt; t += 2) {
            const bool last = (t == nt - 2);
            const char* a1 = cA + (size_t)(t + 1) * kstep;
            const char* a2 = last ? nA : cA + (size_t)(t + 2) * kstep; const char* b2 = last ? nB : cB + (size_t)(t + 2) * kstep;
            const char* a3 = a2 + kstep; const char* b3 = b2 + kstep;
            if (last && has_next) S.a_ready(nxt);
            if constexpr (SP2) {
            PG8_LDB(B0, 0, 0); PG8_LDB(B1, 0, 1); PG8_SCHED; PG8_LDA(At, 0, 0); PG8_STAGE(PG8_SA(1, 1), a1 + hstepA, voffA);
            PG8_WAIT_V(8); PG8_WAIT_L(0); PG8_BAR; PG8_MMA(0, 0, At, B0); PG8_MMA(0, 1, At, B1); PG8_BAR; PG8_SCHED;
            PG8_LDA(At, 0, 1); PG8_STAGE(PG8_SB(0, 0), b2, voffB); PG8_STAGE(PG8_SB(0, 1), b2 + hstep, voffB); PG8_STAGE(PG8_SA(0, 0), a2, voffA);
            PG8_WAIT_V(8); PG8_WAIT_L(0); PG8_BAR; PG8_MMA(1, 0, At, B0); PG8_MMA(1, 1, At, B1); PG8_BAR; PG8_SCHED;
            PG8_LDB(B0, 1, 0); PG8_LDB(B1, 1, 1); PG8_SCHED; PG8_LDA(At, 1, 0); PG8_STAGE(PG8_SA(0, 1), a2 + hstepA, voffA);
            PG8_WAIT_V(8); PG8_WAIT_L(0); PG8_BAR; PG8_MMA(0, 0, At, B0); PG8_MMA(0, 1, At, B1); PG8_BAR; PG8_SCHED;
            PG8_LDA(At, 1, 1); PG8_STAGE(PG8_SB(1, 0), b3, voffB); PG8_STAGE(PG8_SB(1, 1), b3 + hstep, voffB); PG8_STAGE(PG8_SA(1, 0), a3, voffA);
            PG8_WAIT_V(8); PG8_WAIT_L(0); PG8_BAR; PG8_MMA(1, 0, At, B0); PG8_MMA(1, 1, At, B1); PG8_BAR; PG8_SCHED;
            } else {
            PG8_LDB(B0, 0, 0); PG8_SCHED; PG8_LDA(At, 0, 0); PG8_STAGE(PG8_SA(1, 1), a1 + hstepA, voffA);
            PG8_WAIT_L(8); PG8_BAR; PG8_WAIT_L(0); PG8_MMA(0, 0, At, B0); PG8_BAR; PG8_SCHED;
            PG8_LDB(B1, 0, 1); PG8_STAGE(PG8_SB(0, 0), b2, voffB);
            PG8_BAR; PG8_WAIT_L(0); PG8_MMA(0, 1, At, B1); PG8_BAR;
            PG8_LDA(At, 0, 1); PG8_STAGE(PG8_SA(0, 0), a2, voffA);
            PG8_BAR; PG8_WAIT_L(0); PG8_MMA(1, 0, At, B0); PG8_BAR; PG8_SCHED;
            PG8_STAGE(PG8_SB(0, 1), b2 + hstep, voffB);
            PG8_WAIT_V(6); PG8_BAR; PG8_MMA(1, 1, At, B1); PG8_BAR;
            PG8_LDB(B0, 1, 0); PG8_SCHED; PG8_LDA(At, 1, 0); PG8_STAGE(PG8_SA(0, 1), a2 + hstepA, voffA);
            PG8_WAIT_L(8); PG8_BAR; PG8_WAIT_L(0); PG8_MMA(0, 0, At, B0); PG8_BAR; PG8_SCHED;
            PG8_LDB(B1, 1, 1); PG8_STAGE(PG8_SB(1, 0), b3, voffB);
            PG8_BAR; PG8_WAIT_L(0); PG8_MMA(0, 1, At, B1); PG8_BAR;
            PG8_LDA(At, 1, 1); PG8_STAGE(PG8_SA(1, 0), a3, voffA);
            PG8_BAR; PG8_WAIT_L(0); PG8_MMA(1, 0, At, B0); PG8_BAR; PG8_SCHED;
            PG8_STAGE(PG8_SB(1, 1), b3 + hstep, voffB);
            PG8_WAIT_V(6); PG8_BAR; PG8_MMA(1, 1, At, B1); PG8_BAR;
            }
        }
        if constexpr (ALIGN_EPI) { if (wr == 0) PG8_BAR; }
        if constexpr (!Epi::AFTER_DRAIN) { E(acc, cur, wr, wc, fr, fq); S.done(cur); }
        if (!has_next) break;
#pragma unroll
        for (int a = 0; a < 2; ++a)
#pragma unroll
            for (int b = 0; b < 2; ++b)
#pragma unroll
                for (int m = 0; m < 4; ++m)
#pragma unroll
                    for (int n = 0; n < 2; ++n) acc[a][b][m][n] = (f32x4){0.f, 0.f, 0.f, 0.f};
        cur = nxt; cA = nA; cB = nB; ++ui;
        if constexpr (ALIGN_EPI) { if (wr == 1) PG8_BAR; }
    }
    PG8_WAIT_V(0);
    if constexpr (!ALIGN_EPI) { if (wr == 0) PG8_BAR; }
    PG8_BAR;
    if constexpr (Epi::AFTER_DRAIN) { E.fused(acc, cur, wr, wc, fr, fq, lds, wid, lane); S.done(cur); }
#undef PG8_SA
#undef PG8_SB
#undef PG8_STAGE
#undef PG8_LDA
#undef PG8_LDB
#undef PG8_MMA
#undef PG8_WAIT_V
#undef PG8_WAIT_L
#undef PG8_BAR
#undef PG8_SCHED
}
}

constexpr int NWAVES = 8;
constexpr int NB = 16, T = 2048, D = 2048, M = NB * T, DFF = 5632, NADA = 18432, EVW = 8208;
constexpr float EPS = 1e-6f;
#ifndef MK_PER_PHASE
#define MK_PER_PHASE 0
#endif
constexpr int NPHASE = 27;
#ifndef PROBE_GEMM_X2
#define PROBE_GEMM_X2 0
#endif
#ifndef PROBE_P0_X2
#define PROBE_P0_X2 0
#endif
#ifndef PROBE_NORM_X2
#define PROBE_NORM_X2 0
#endif
#ifndef PROBE_EW_X2
#define PROBE_EW_X2 0
#endif
#ifndef PROBE_ECHO_MASK
#define PROBE_ECHO_MASK 0u
#endif
#ifndef PROBE_POISON_PHASE
#define PROBE_POISON_PHASE (-1)
#endif
#ifndef FINAL_BAR
#define FINAL_BAR 1
#endif
#ifndef PROBE_ECHO_SLEEP
#define PROBE_ECHO_SLEEP 0
#endif
#ifndef PROBE_START_BUSY
#define PROBE_START_BUSY 0
#endif
#ifndef PROBE_PERM_BLOCKS
#define PROBE_PERM_BLOCKS 0
#endif
#ifndef PROBE_POISON_LDS
#define PROBE_POISON_LDS 0
#endif
#ifndef PROBE_POISON_VGPR
#define PROBE_POISON_VGPR 0
#endif
#ifndef PROBE_REC_X2
#define PROBE_REC_X2 0
#endif

constexpr size_t MiB = 1u << 20;
constexpr size_t WS_CTL = 0, CTL_ZERO_BYTES = 1 * MiB;
constexpr size_t WS_MODV = 1 * MiB;
constexpr size_t WS_ROPE = 4 * MiB;
constexpr size_t WS_BG = 6 * MiB;
constexpr size_t WS_WBA = 8 * MiB;
constexpr size_t WS_SP8 = 8 * MiB + 256 * 1024;
constexpr size_t WS_W13 = 16 * MiB;
constexpr size_t W13_BYTES = (size_t)2 * DFF * D * 2;
constexpr size_t WS_W2 = WS_W13 + 4 * W13_BYTES;
constexpr size_t W2_BYTES = (size_t)D * DFF * 2;
constexpr size_t WS_WEVIN = WS_W2 + 4 * W2_BYTES;
constexpr size_t WS_WEVOUT = WS_WEVIN + (size_t)8192 * D * 2;
constexpr size_t WS_WODIN = WS_WEVOUT + (size_t)D * D * 2;
constexpr size_t WS_WGATE = WS_WODIN + (size_t)4096 * D * 2;
constexpr size_t WS_WODOUT = WS_WGATE + (size_t)4096 * 256 * 2;
constexpr size_t WS_H = WS_WODOUT + (size_t)D * D * 2;
constexpr size_t WS_Y = WS_H + (size_t)M * D * 2;
constexpr size_t WS_BIG = WS_Y + (size_t)M * D * 2;
constexpr size_t WS_ADEC = WS_BIG + 256 * MiB;
constexpr size_t WS_EXT = WS_BIG + 512 * MiB;
constexpr size_t WS_END = WS_EXT + 192 * MiB;
static_assert(WS_W13 % (1u << 20) == 0 && WS_H == 346 * MiB && WS_END == 1306 * MiB, "d_ws map");
constexpr int CW_BAR = 4096;

constexpr int RING_BYTES = 131072;
constexpr int WAVE_LDS = 19712;
constexpr int ADA_ACC_OFF = 131072;
constexpr int LDSCTL_OFF = 157696, MISC_OFF = LDSCTL_OFF + 320;
constexpr int LDS_BYTES = 158720;
static_assert(MISC_OFF + 128 <= LDS_BYTES && 8 * WAVE_LDS <= LDSCTL_OFF, "LDS map");

#define GAS __attribute__((address_space(1)))
#define LAS __attribute__((address_space(3)))
typedef unsigned short bf16;
typedef unsigned v4u __attribute__((ext_vector_type(4)));
typedef unsigned v2u __attribute__((ext_vector_type(2)));
typedef float f32x4 __attribute__((ext_vector_type(4)));
typedef GAS unsigned gu32;
#define RLX_AGENT __ATOMIC_RELAXED, __HIP_MEMORY_SCOPE_AGENT
#define LDS_WAIT() asm volatile("s_waitcnt lgkmcnt(0)" ::: "memory")
#define VM_WAIT() asm volatile("s_waitcnt vmcnt(0)" ::: "memory")
using pg8::cvt_pk_bf16; using pg8::bfl; using pg8::bfh; using pg8::fast_sigmoid;

#define XB_TMO      128
#define XB_XCNT(j)  (256  + 64 * (j))
#define XB_XSUB(j)  (1280 + 64 * (j))
#define XB_XGEN(j)  (2304 + 64 * (j))
#define XB_TOP      3328
#define XB_TOPGEN   3392
#define XCD_BAR_WORDS 3456
#define XB_SPIN_CAP (1u << 18)

__device__ __forceinline__ unsigned xb_ld(unsigned* p)              { return __hip_atomic_load(p, __ATOMIC_RELAXED, __HIP_MEMORY_SCOPE_AGENT); }
__device__ __forceinline__ unsigned xb_add(unsigned* p, unsigned v) { return __hip_atomic_fetch_add(p, v, __ATOMIC_RELAXED, __HIP_MEMORY_SCOPE_AGENT); }
__device__ __forceinline__ unsigned xb_xcc_id() { return (unsigned)__builtin_amdgcn_s_getreg((3 << 11) | 20) & 0xFu; }
#define XB_SPIN(cond, bar) do { unsigned _sp = 0; while (cond) { __builtin_amdgcn_s_sleep(1); \
    if ((++_sp & 255u) == 0u) { if (xb_ld(&(bar)[XB_TMO])) break; if (_sp > XB_SPIN_CAP) { atomicAdd(&(bar)[XB_TMO], 1u); break; } } } } while (0)

struct XcdBarrier {
    unsigned* bar; unsigned x;
    volatile LAS unsigned* st;
};

__device__ __forceinline__ XcdBarrier xcd_barrier_post(unsigned* bar, volatile LAS unsigned* st) {
    XcdBarrier b; b.bar = bar; b.x = xb_xcc_id(); b.st = st;
    if (threadIdx.x == 0) (void)xb_add(&bar[XB_XCNT(b.x)], 1u);
    return b;
}
__device__ __forceinline__ void xcd_barrier_complete(unsigned* bar, unsigned x, unsigned& nloc, unsigned& nx) {
    const unsigned G = gridDim.x * gridDim.y * gridDim.z;
    unsigned sum, cnt, mine, sp = 0u;
    for (;;) {
        sum = 0u; cnt = 0u; mine = 0u;
#pragma unroll
        for (unsigned j = 0; j < 16; ++j) { const unsigned c = xb_ld(&bar[XB_XCNT(j)]); sum += c; cnt += (c > 0u) ? 1u : 0u; mine = (j == x) ? c : mine; }
        if (sum == G) break;
        __builtin_amdgcn_s_sleep(1);
        if ((++sp & 255u) == 0u) { if (xb_ld(&bar[XB_TMO])) break; if (sp > XB_SPIN_CAP) { atomicAdd(&bar[XB_TMO], 1u); break; } }
    }
    nloc = mine > 0u ? mine : 1u; nx = cnt > 0u ? cnt : 1u;
}

__device__ __forceinline__ void xcd_barrier(const XcdBarrier& b) {
    asm volatile("s_waitcnt vmcnt(0)" ::: "memory");
    __syncthreads();
    if (threadIdx.x == 0) {
        unsigned* bar = b.bar;
        __builtin_amdgcn_s_waitcnt(0);
        unsigned nloc = b.st[0], nx = b.st[1];
        if (nloc == 0u) { xcd_barrier_complete(bar, b.x, nloc, nx); b.st[0] = nloc; b.st[1] = nx; }
        const unsigned old = xb_add(&bar[XB_XSUB(b.x)], 1u);
        const unsigned gen = old / nloc;
        if (old + 1u == (gen + 1u) * nloc) {
            __builtin_amdgcn_fence(__ATOMIC_RELEASE, "agent");
            asm volatile("s_waitcnt vmcnt(0)" ::: "memory");
            const unsigned og = xb_add(&bar[XB_TOP], 1u);
            const unsigned tg = og / nx;
            if (og + 1u == (tg + 1u) * nx) xb_add(&bar[XB_TOPGEN], 1u);
            else XB_SPIN(xb_ld(&bar[XB_TOPGEN]) == tg, bar);
            __builtin_amdgcn_fence(__ATOMIC_ACQUIRE, "agent");
            xb_add(&bar[XB_XGEN(b.x)], 1u);
            asm volatile("s_waitcnt vmcnt(0)" ::: "memory");
        } else {
            XB_SPIN(xb_ld(&bar[XB_XGEN(b.x)]) == gen, bar);
            __builtin_amdgcn_fence(__ATOMIC_ACQUIRE, "agent");
            asm volatile("s_waitcnt vmcnt(0)" ::: "memory");
        }
    }
    __syncthreads();
}

struct Args { const float* in[24]; float* out; unsigned char* ws; int ph_lo, ph_hi; };
struct Frame {
    LAS unsigned char* lds; volatile LAS unsigned* MISC; gu32* ctl;
    int tid, lane, wave, vcu, G, bid;
};
__device__ __forceinline__ float wave_sum(float v) {
#pragma unroll
    for (int o = 1; o < 64; o <<= 1) v += __shfl_xor(v, o);
    return v;
}
__device__ __forceinline__ float silu_f(float x) { return x * fast_sigmoid(x); }
__device__ __forceinline__ void unpack8(const v4u w, float (&f)[8]) { f[0] = bfl(w.x); f[1] = bfh(w.x); f[2] = bfl(w.y); f[3] = bfh(w.y); f[4] = bfl(w.z); f[5] = bfh(w.z); f[6] = bfl(w.w); f[7] = bfh(w.w); }
__device__ __forceinline__ v4u pack8(const float (&f)[8]) { v4u w; w.x = cvt_pk_bf16(f[0], f[1]); w.y = cvt_pk_bf16(f[2], f[3]); w.z = cvt_pk_bf16(f[4], f[5]); w.w = cvt_pk_bf16(f[6], f[7]); return w; }

__device__ __forceinline__ void transpose_item(const float* W, int ldw, int k0, int n0, bf16* WT, int ldt, int drow0, LAS float* scr, int lane) {
#pragma unroll 8
    for (int i = 0; i < 32; ++i) { const int kk = 2 * i + (lane >> 5); scr[kk * 33 + (lane & 31)] = W[(size_t)(k0 + kk) * ldw + n0 + (lane & 31)]; }
    LDS_WAIT(); asm volatile("" ::: "memory");
    const int c = lane & 7;
#pragma unroll
    for (int j = 0; j < 4; ++j) { const int n = (lane >> 3) + 8 * j; const LAS float* s = scr + (8 * c) * 33 + n;
        v4u o; o.x = cvt_pk_bf16(s[0 * 33], s[1 * 33]); o.y = cvt_pk_bf16(s[2 * 33], s[3 * 33]); o.z = cvt_pk_bf16(s[4 * 33], s[5 * 33]); o.w = cvt_pk_bf16(s[6 * 33], s[7 * 33]);
        *(GAS v4u*)(WT + (size_t)(drow0 + n) * ldt + k0 + 8 * c) = o; }
    LDS_WAIT(); asm volatile("" ::: "memory");
}
__device__ __forceinline__ void p0_prologue(Frame& F, const Args& a) {
    unsigned char* ws = a.ws;
    {
        LAS float* sc = (LAS float*)F.lds;
        LAS float* accl = (LAS float*)(F.lds + ADA_ACC_OFF);
        const float* c = a.in[1];
        for (int idx = F.tid; idx < NB * D; idx += NWAVES * 64) { const int b = idx >> 11, k = idx & 2047; const float v = c[idx]; sc[k * 16 + b] = v / (1.0f + __expf(-v)); }
        __syncthreads();
        float* modv = (float*)(ws + WS_MODV);
        for (int u = F.bid; u < 2 * (NADA / 64); u += F.G) {
            const int layer = u / (NADA / 64), n0 = (u % (NADA / 64)) * 64;
            for (int e = F.tid; e < 1024; e += NWAVES * 64) accl[e] = 0.f;
            __syncthreads();
            const float* W = a.in[2] + (size_t)layer * D * NADA + n0 + F.lane;
            float acc[16];
#pragma unroll
            for (int b = 0; b < 16; ++b) acc[b] = 0.f;
            const int kbeg = F.wave * 256;
#pragma unroll 4
            for (int kk = 0; kk < 256; ++kk) { const int k = kbeg + kk; const float w = W[(size_t)k * NADA];
#pragma unroll
                for (int i = 0; i < 4; ++i) { const f32x4 s4 = *(const LAS f32x4*)(sc + k * 16 + 4 * i);
                    acc[4 * i + 0] += w * s4[0]; acc[4 * i + 1] += w * s4[1]; acc[4 * i + 2] += w * s4[2]; acc[4 * i + 3] += w * s4[3]; } }
            for (int w = 0; w < NWAVES; ++w) {
                if (F.wave == w) {
#pragma unroll
                    for (int b = 0; b < 16; ++b) accl[b * 64 + F.lane] += acc[b];
                }
                __syncthreads();
            }
            for (int e = F.tid; e < 1024; e += NWAVES * 64) { const int b = e >> 6, col = e & 63, n = n0 + col;
                const float v = accl[e] + a.in[3][layer * NADA + n];
                const int s = n / (3 * D), j = (n / D) % 3, d = n % D, q = layer * 3 + s;
                float o = v;
                if (j == 1) o = a.in[4][(size_t)q * D + d] * (1.0f + v);
                if (j == 2) o = (s == 1 ? 1.0f : 0.5f) * a.in[5][(size_t)q * D + d] * (1.0f + v);
                modv[((size_t)(q * 3 + j) * 16 + b) * D + d] = o; }
            __syncthreads();
        }
    }
    const int gw = F.vcu * NWAVES + F.wave, NGW = F.G * NWAVES;
    {
        LAS float* scr = (LAS float*)(F.lds + F.wave * 16384);
        constexpr int I13 = 32 * 352, I2 = 88 * 64, IEV = 32 * 256, IEO = 32 * 64, IOI = 32 * 128, IG = 16 * 32, IOO = 32 * 64;
        constexpr int NITEMS = 4 * I13 + 4 * I2 + IEV + IEO + IOI + IG + IOO;
        for (int it = gw; it < NITEMS; it += NGW) {
            int r = it;
            if (r < 4 * I13) { const int mat = r / I13; r -= mat * I13; const int kb = r / 352, nb = r % 352, n0 = 32 * nb;
                const int dr = n0 < DFF ? (n0 >> 7) * 256 + (n0 & 127) : ((n0 - DFF) >> 7) * 256 + 128 + ((n0 - DFF) & 127);
                transpose_item(a.in[6] + (size_t)mat * D * 2 * DFF, 2 * DFF, 64 * kb, n0, (bf16*)(ws + WS_W13 + mat * W13_BYTES), D, dr, scr, F.lane); continue; }
            r -= 4 * I13;
            if (r < 4 * I2) { const int mat = r / I2; r -= mat * I2; const int kb = r / 64, nb = r % 64;
                transpose_item(a.in[7] + (size_t)mat * DFF * D, D, 64 * kb, 32 * nb, (bf16*)(ws + WS_W2 + mat * W2_BYTES), DFF, 32 * nb, scr, F.lane); continue; }
            r -= 4 * I2;
            if (r < IEV) { const int kb = r / 256, nb = r % 256, d0 = 32 * nb, n0 = d0 + (d0 >= 3072 ? 16 : 0);
                transpose_item(a.in[8], EVW, 64 * kb, n0, (bf16*)(ws + WS_WEVIN), D, d0, scr, F.lane); continue; }
            r -= IEV;
            if (r < IEO) { const int kb = r / 64, nb = r % 64;
                transpose_item(a.in[14], D, 64 * kb, 32 * nb, (bf16*)(ws + WS_WEVOUT), D, 32 * nb, scr, F.lane); continue; }
            r -= IEO;
            if (r < IOI) { const int kb = r / 128, nb = r % 128;
                transpose_item(a.in[15], 2 * D, 64 * kb, 32 * nb, (bf16*)(ws + WS_WODIN), D, 32 * nb, scr, F.lane); continue; }
            r -= IOI;
            if (r < IG) { const int mat = r / 32; r -= mat * 32; const int gsel = mat >> 3, blk = mat & 7, kb = r / 8, nb = r % 8, j0 = 32 * nb;
                const int dr = (blk * 2 + (j0 >> 7)) * 256 + gsel * 128 + (j0 & 127);
                transpose_item((gsel ? a.in[20] : a.in[18]) + (size_t)blk * 65536, 256, 64 * kb, j0, (bf16*)(ws + WS_WGATE), 256, dr, scr, F.lane); continue; }
            r -= IG;
            { const int kb = r / 64, nb = r % 64;
                transpose_item(a.in[23], D, 64 * kb, 32 * nb, (bf16*)(ws + WS_WODOUT), D, 32 * nb, scr, F.lane); }
        }
    }
    const int gt = (F.vcu * NWAVES + F.wave) * 64 + F.lane, NGT = F.G * NWAVES * 64;
    { float* wba = (float*)(ws + WS_WBA);
      for (int i = gt; i < 16 * D; i += NGT) { const int o = i >> 11, k = i & 2047; wba[i] = a.in[8][(size_t)k * EVW + 3072 + o]; } }
    { float* sp8 = (float*)(ws + WS_SP8);
      for (int i = gt; i < D; i += NGT) sp8[i] = -8.0f * log1pf(expf(-a.in[22][i])); }
    { float* rc = (float*)(ws + WS_ROPE); float* rs = rc + T * 128;
      for (int i = gt; i < T * 128; i += NGT) { const int t = i >> 7, f = i & 127;
          const double ang = (double)t * pow(10000.0, -(double)f / 128.0); rc[i] = (float)cos(ang); rs[i] = (float)sin(ang); } }
}

template <bool DO_BA>
__device__ __forceinline__ void norm_pass(Frame& F, const Args& a, const int q) {
    unsigned char* ws = a.ws;
    const bool has_prev = q > 0, has_next = q < 6;
    const float* xold = (q <= 1) ? a.in[0] : a.out;
    float* xnew = a.out;
    const bf16* Y = (const bf16*)(ws + WS_Y); bf16* H = (bf16*)(ws + WS_H);
    const float* modv = (const float*)(ws + WS_MODV);
    LAS float* wl = (LAS float*)F.lds;
    if (DO_BA) {
        const float* wba = (const float*)(ws + WS_WBA);
        for (int i = F.tid; i < 16 * D; i += NWAVES * 64) { const int o = i >> 11, col = i & 2047, j = col >> 9, l = (col >> 3) & 63, hf = (col >> 2) & 1, e = col & 3;
            wl[o * 2048 + j * 512 + hf * 256 + l * 4 + e] = wba[i]; }
        __syncthreads();
    }
    const int gw = F.vcu * NWAVES + F.wave, l = F.lane;
    for (int r = 0; r < 16; ++r) {
        const int m = gw * 16 + r, b = m >> 11;
        const size_t ro = (size_t)m * D + 8 * l;
        float x[4][8];
#pragma unroll
        for (int j = 0; j < 4; ++j) { const f32x4 x0 = *(const f32x4*)(xold + ro + 512 * j), x1 = *(const f32x4*)(xold + ro + 512 * j + 4);
            x[j][0] = x0[0]; x[j][1] = x0[1]; x[j][2] = x0[2]; x[j][3] = x0[3]; x[j][4] = x1[0]; x[j][5] = x1[1]; x[j][6] = x1[2]; x[j][7] = x1[3]; }
        if (has_prev) {
            float y[4][8]; float ss = 0.f;
#pragma unroll
            for (int j = 0; j < 4; ++j) { const v4u yw = *(const v4u*)(Y + ro + 512 * j); unpack8(yw, y[j]);
#pragma unroll
                for (int e = 0; e < 8; ++e) ss += y[j][e] * y[j][e]; }
            const float ry = 1.0f / sqrtf(wave_sum(ss) * (1.0f / D) + EPS);
            const float* al = modv + ((size_t)((q - 1) * 3 + 2) * 16 + b) * D + 8 * l;
#pragma unroll
            for (int j = 0; j < 4; ++j) { const f32x4 a0 = *(const f32x4*)(al + 512 * j), a1 = *(const f32x4*)(al + 512 * j + 4);
#pragma unroll
                for (int e = 0; e < 4; ++e) { x[j][e] += a0[e] * (y[j][e] * ry); x[j][4 + e] += a1[e] * (y[j][4 + e] * ry); }
                *(f32x4*)(xnew + ro + 512 * j) = (f32x4){x[j][0], x[j][1], x[j][2], x[j][3]}; *(f32x4*)(xnew + ro + 512 * j + 4) = (f32x4){x[j][4], x[j][5], x[j][6], x[j][7]}; }
        }
        if (has_next) {
            float ss = 0.f;
#pragma unroll
            for (int j = 0; j < 4; ++j)
#pragma unroll
                for (int e = 0; e < 8; ++e) ss += x[j][e] * x[j][e];
            const float rx = 1.0f / sqrtf(wave_sum(ss) * (1.0f / D) + EPS);
            const float* Bv = modv + ((size_t)(q * 3 + 1) * 16 + b) * D + 8 * l;
            const float* Cv = modv + ((size_t)(q * 3 + 0) * 16 + b) * D + 8 * l;
#pragma unroll
            for (int j = 0; j < 4; ++j) { const f32x4 b0 = *(const f32x4*)(Bv + 512 * j), b1 = *(const f32x4*)(Bv + 512 * j + 4), c0 = *(const f32x4*)(Cv + 512 * j), c1 = *(const f32x4*)(Cv + 512 * j + 4);
#pragma unroll
                for (int e = 0; e < 4; ++e) { x[j][e] = x[j][e] * rx * b0[e] + c0[e]; x[j][4 + e] = x[j][4 + e] * rx * b1[e] + c1[e]; }
                *(v4u*)(H + ro + 512 * j) = pack8(x[j]); }
            if (DO_BA) {
                float mine = 0.f;
#pragma unroll
                for (int o = 0; o < 16; ++o) { float p = 0.f;
#pragma unroll
                    for (int j = 0; j < 4; ++j) { const f32x4 w0 = *(const LAS f32x4*)(wl + o * 2048 + j * 512 + l * 4), w1 = *(const LAS f32x4*)(wl + o * 2048 + j * 512 + 256 + l * 4);
                        p += x[j][0] * w0[0] + x[j][1] * w0[1] + x[j][2] * w0[2] + x[j][3] * w0[3] + x[j][4] * w1[0] + x[j][5] * w1[1] + x[j][6] * w1[2] + x[j][7] * w1[3]; }
                    p = wave_sum(p); mine = (l == o) ? p : mine; }
                if (l < 16) { float v;
                    if (l < 8) v = 1.0f / (1.0f + expf(-mine));
                    else { const float z = mine + a.in[11][l - 8]; const float sp = z > 20.f ? z : log1pf(expf(z)); v = -expf(a.in[10][l - 8]) * sp; }
                    ((float*)(ws + WS_BG))[(size_t)m * 16 + l] = v; }
            }
        }
    }
}

template <int MODE>
__device__ __forceinline__ void conv_slab(const bf16* src, const size_t spitch, const int t0, const float* w, const int wpitch, const float* bias, bf16* dst, const size_t dpitch, const int l) {
    float wt[4][8];
#pragma unroll
    for (int tap = 0; tap < 4; ++tap) { const f32x4 w0 = *(const f32x4*)(w + tap * wpitch + 8 * l), w1 = *(const f32x4*)(w + tap * wpitch + 8 * l + 4);
        wt[tap][0] = w0[0]; wt[tap][1] = w0[1]; wt[tap][2] = w0[2]; wt[tap][3] = w0[3]; wt[tap][4] = w1[0]; wt[tap][5] = w1[1]; wt[tap][6] = w1[2]; wt[tap][7] = w1[3]; }
    float bs[8];
#pragma unroll
    for (int e = 0; e < 8; ++e) bs[e] = 0.f;
    if (MODE == 3) { const f32x4 b0 = *(const f32x4*)(bias + 8 * l), b1 = *(const f32x4*)(bias + 8 * l + 4);
        bs[0] = b0[0]; bs[1] = b0[1]; bs[2] = b0[2]; bs[3] = b0[3]; bs[4] = b1[0]; bs[5] = b1[1]; bs[6] = b1[2]; bs[7] = b1[3]; }
    float xm3[8], xm2[8], xm1[8];
#pragma unroll
    for (int e = 0; e < 8; ++e) { xm3[e] = 0.f; xm2[e] = 0.f; xm1[e] = 0.f; }
    if (t0 > 0) { unpack8(*(const v4u*)(src - 3 * spitch + 8 * l), xm3); unpack8(*(const v4u*)(src - 2 * spitch + 8 * l), xm2); unpack8(*(const v4u*)(src - spitch + 8 * l), xm1); }
    for (int r0 = 0; r0 < 64; r0 += 4) {
        v4u xw[4];
#pragma unroll
        for (int i = 0; i < 4; ++i) xw[i] = *(const v4u*)(src + (size_t)(r0 + i) * spitch + 8 * l);
#pragma unroll
        for (int i = 0; i < 4; ++i) {
            float x0[8], o[8]; unpack8(xw[i], x0);
#pragma unroll
            for (int e = 0; e < 8; ++e) o[e] = bs[e] + wt[0][e] * xm3[e] + wt[1][e] * xm2[e] + wt[2][e] * xm1[e] + wt[3][e] * x0[e];
#pragma unroll
            for (int e = 0; e < 8; ++e) { xm3[e] = xm2[e]; xm2[e] = xm1[e]; xm1[e] = x0[e]; }
            if (MODE <= 2) {
#pragma unroll
                for (int e = 0; e < 8; ++e) o[e] = silu_f(o[e]);
            }
            if (MODE <= 1) {
                float ss = 0.f;
#pragma unroll
                for (int e = 0; e < 8; ++e) ss += o[e] * o[e];
                ss += __shfl_xor(ss, 1); ss += __shfl_xor(ss, 2); ss += __shfl_xor(ss, 4); ss += __shfl_xor(ss, 8);
                float rn = 1.0f / sqrtf(ss + EPS);
                if (MODE == 0) rn *= 0.08838834764831845f;
#pragma unroll
                for (int e = 0; e < 8; ++e) o[e] *= rn;
            }
            *(v4u*)(dst + (size_t)(r0 + i) * dpitch + 8 * l) = pack8(o);
        }
    }
}
__device__ __forceinline__ void ev_prep(Frame& F, const Args& a) {
    unsigned char* ws = a.ws;
    bf16* P = (bf16*)(ws + WS_BIG); bf16* QKV = (bf16*)(ws + WS_EXT);
    const float* rc = (const float*)(ws + WS_ROPE); const float* rs = rc + T * 128;
    const int gw = F.vcu * NWAVES + F.wave, l = F.lane;
    for (int u = gw; u < 4096; u += 2048) {
        if (u < 3072) {
            const int rb = u / 6, g = u - rb * 6; const size_t m0 = (size_t)rb * 64; const int t0 = (int)(m0 & (T - 1));
            const bf16* src = P + m0 * 8192 + 512 * g; bf16* dst = QKV + m0 * 3072 + 512 * g; const float* w = a.in[9] + 512 * g;
            if (g < 2) conv_slab<0>(src, 8192, t0, w, 3072, nullptr, dst, 3072, l);
            else if (g < 4) conv_slab<1>(src, 8192, t0, w, 3072, nullptr, dst, 3072, l);
            else conv_slab<2>(src, 8192, t0, w, 3072, nullptr, dst, 3072, l);
        } else {
            const int v = u - 3072, rb = v >> 1, w = v & 1; const size_t m0 = (size_t)rb * 64; const int t0 = (int)(m0 & (T - 1));
            const int hh = l >> 4, i0 = (l & 15) * 8;
            const float lgam = log2f(1.0f - exp2f(-5.0f - (float)hh));
            for (int r0 = 0; r0 < 64; r0 += 2) {
                v4u xa[2], xb[2]; f32x4 cs0[2], cs1[2], sn0[2], sn1[2];
#pragma unroll
                for (int i = 0; i < 2; ++i) { const int t = t0 + r0 + i; bf16* base = P + (m0 + r0 + i) * 8192 + 4096 + 1024 * w + 256 * hh + i0;
                    xa[i] = *(const v4u*)base; xb[i] = *(const v4u*)(base + 128);
                    cs0[i] = *(const f32x4*)(rc + t * 128 + i0); cs1[i] = *(const f32x4*)(rc + t * 128 + i0 + 4); sn0[i] = *(const f32x4*)(rs + t * 128 + i0); sn1[i] = *(const f32x4*)(rs + t * 128 + i0 + 4); }
#pragma unroll
                for (int i = 0; i < 2; ++i) { const int t = t0 + r0 + i; bf16* base = P + (m0 + r0 + i) * 8192 + 4096 + 1024 * w + 256 * hh + i0;
                    const float scl = w ? 0.0625f * exp2f((float)(63 - (t & 63)) * lgam) : 1.0f;
                    const float cs[8] = {cs0[i][0], cs0[i][1], cs0[i][2], cs0[i][3], cs1[i][0], cs1[i][1], cs1[i][2], cs1[i][3]};
                    const float sn[8] = {sn0[i][0], sn0[i][1], sn0[i][2], sn0[i][3], sn1[i][0], sn1[i][1], sn1[i][2], sn1[i][3]};
                    float x1[8], x2[8], o1[8], o2[8]; unpack8(xa[i], x1); unpack8(xb[i], x2);
#pragma unroll
                    for (int e = 0; e < 8; ++e) { o1[e] = (x1[e] * cs[e] - x2[e] * sn[e]) * scl; o2[e] = (x2[e] * cs[e] + x1[e] * sn[e]) * scl; }
                    *(v4u*)base = pack8(o1); *(v4u*)(base + 128) = pack8(o2); }
            }
        }
    }
}

typedef short bf16x8 __attribute__((ext_vector_type(8)));
typedef short s16x4 __attribute__((ext_vector_type(4)));
typedef short v4i16_t __attribute__((ext_vector_type(4)));
__device__ __forceinline__ f32x4 mfma16(bf16x8 a, bf16x8 b, f32x4 c) { return __builtin_amdgcn_mfma_f32_16x16x32_bf16(a, b, c, 0, 0, 0); }
__device__ __forceinline__ bf16x8 mkfrag(const f32x4 x0, const f32x4 x1) {
    v4u w; w.x = cvt_pk_bf16(x0[0], x0[1]); w.y = cvt_pk_bf16(x0[2], x0[3]); w.z = cvt_pk_bf16(x1[0], x1[1]); w.w = cvt_pk_bf16(x1[2], x1[3]);
    return __builtin_bit_cast(bf16x8, w);
}
__device__ __forceinline__ bf16x8 join64(const v2u lo, const v2u hi) { v4u w; w.x = lo.x; w.y = lo.y; w.z = hi.x; w.w = hi.y; return __builtin_bit_cast(bf16x8, w); }
__device__ __forceinline__ bf16x8 frag_pi(const LAS unsigned char* rowp, int k0, int kq) {
    return join64(*(const LAS v2u*)(rowp + (k0 + 4 * kq) * 2), *(const LAS v2u*)(rowp + (k0 + 16 + 4 * kq) * 2));
}
__device__ __forceinline__ v2u tr_read(const LAS unsigned char* p) {
    return __builtin_bit_cast(v2u, __builtin_amdgcn_ds_read_tr16_b64_v4i16((LAS v4i16_t*)p));
}
constexpr size_t PW_GT = WS_H, PW_GQK = WS_H + 32 * MiB, PW_GVEC = WS_H + 64 * MiB, PW_RQK = WS_H + 72 * MiB;

__device__ __forceinline__ void ev_chunk_prep(Frame& F, const Args& a) {
    unsigned char* ws = a.ws;
    const bf16* P = (const bf16*)(ws + WS_BIG); const bf16* QKV = (const bf16*)(ws + WS_EXT); const float* BG = (const float*)(ws + WS_BG);
    const int l = F.lane, c = l & 15, rq = l >> 4;
    const int gw = F.vcu * NWAVES + F.wave;
    LAS float* Al = (LAS float*)(F.lds + F.wave * WAVE_LDS);
    for (int jg = gw; jg < 4096; jg += 2048) {
        const int bh = jg >> 5, n = jg & 31, b = bh >> 3, h = bh & 7;
        const size_t m0 = (size_t)b * T + 64 * n;
        const float beta = BG[(m0 + l) * 16 + h], g = BG[(m0 + l) * 16 + 8 + h];
        float G = g;
#pragma unroll
        for (int o = 1; o < 64; o <<= 1) { const float t = __shfl_up(G, o); if (l >= o) G += t; }
        const float Glast = __shfl(G, 63);
        { float* vec = (float*)(ws + PW_GVEC) + (size_t)jg * 256;
          vec[l] = beta; vec[64 + l] = __expf(G); vec[128 + l] = __expf(Glast - G); vec[192 + l] = __expf(Glast); }
        f32x4 kk[4][4], qk[4][4];
#pragma unroll
        for (int ib = 0; ib < 4; ++ib)
#pragma unroll
            for (int jb = 0; jb < 4; ++jb) { kk[ib][jb] = (f32x4){0.f, 0.f, 0.f, 0.f}; qk[ib][jb] = (f32x4){0.f, 0.f, 0.f, 0.f}; }
#pragma unroll
        for (int s = 0; s < 4; ++s) {
            bf16x8 kf[4], qf[4];
#pragma unroll
            for (int ib = 0; ib < 4; ++ib) { const bf16* rp = QKV + (m0 + 16 * ib + c) * 3072 + 128 * h + 32 * s + 8 * rq;
                qf[ib] = *(const bf16x8*)rp; kf[ib] = *(const bf16x8*)(rp + 1024); }
#pragma unroll
            for (int ib = 0; ib < 4; ++ib)
#pragma unroll
                for (int jb = 0; jb <= ib; ++jb) { kk[ib][jb] = mfma16(kf[ib], kf[jb], kk[ib][jb]); qk[ib][jb] = mfma16(qf[ib], kf[jb], qk[ib][jb]); }
        }
        float Gj[4];
#pragma unroll
        for (int jb = 0; jb < 4; ++jb) Gj[jb] = __shfl(G, 16 * jb + c);
        bf16* qko = (bf16*)(ws + PW_GQK) + (size_t)jg * 4096;
        LAS float* Alq = Al + (4 * rq) * 68 + c;
#pragma unroll
        for (int ib = 0; ib < 4; ++ib)
#pragma unroll
            for (int e = 0; e < 4; ++e) { const int i = 16 * ib + 4 * rq + e; const float Gi = __shfl(G, i);
#pragma unroll
                for (int jb = 0; jb < 4; ++jb) { const int j = 16 * jb + c; float qv = 0.f;
                    if (jb <= ib) qv = (i >= j) ? qk[ib][jb][e] * __expf(Gi - Gj[jb]) : 0.f;
                    Alq[(16 * ib + e) * 68 + 16 * jb] = qv; } }
#pragma unroll 4
        for (int i = 0; i < 64; ++i) qko[i * 64 + l] = (bf16)(cvt_pk_bf16(Al[i * 68 + l], 0.f) & 0xffffu);
#pragma unroll
        for (int ib = 0; ib < 4; ++ib)
#pragma unroll
            for (int e = 0; e < 4; ++e) { const int i = 16 * ib + 4 * rq + e; const float Gi = __shfl(G, i), bi = __shfl(beta, i);
#pragma unroll
                for (int jb = 0; jb < 4; ++jb) { const int j = 16 * jb + c; float av = 0.f;
                    if (jb <= ib) av = (i > j) ? bi * kk[ib][jb][e] * __expf(Gi - Gj[jb]) : 0.f;
                    Alq[(16 * ib + e) * 68 + 16 * jb] = av; } }
        for (int i = 0; i < 64; ++i) {
            float acc0 = (l == i) ? 1.f : 0.f, acc1 = 0.f;
            const int nj = (i + 3) >> 2;
            for (int jj = 0; jj < nj; ++jj) { const f32x4 a4 = *(const LAS f32x4*)(Al + i * 68 + 4 * jj);
                const float t0 = Al[(4 * jj) * 68 + l], t1 = Al[(4 * jj + 1) * 68 + l], t2 = Al[(4 * jj + 2) * 68 + l], t3 = Al[(4 * jj + 3) * 68 + l];
                acc0 = fmaf(-a4[0], t0, acc0); acc1 = fmaf(-a4[1], t1, acc1); acc0 = fmaf(-a4[2], t2, acc0); acc1 = fmaf(-a4[3], t3, acc1); }
            Al[i * 68 + l] = acc0 + acc1;
        }
        bf16* to = (bf16*)(ws + PW_GT) + (size_t)jg * 4096;
#pragma unroll 4
        for (int i = 0; i < 64; ++i) to[i * 64 + l] = (bf16)(cvt_pk_bf16(Al[i * 68 + l], 0.f) & 0xffffu);
    }
    {
        const int jr = gw, bhr = jr >> 5, n = jr & 31, b = bhr >> 2, hr = bhr & 3;
        const size_t m0 = (size_t)b * T + 64 * n;
        const float lg = log2f(1.0f - exp2f(-5.0f - (float)hr));
        f32x4 qk[4][4];
#pragma unroll
        for (int ib = 0; ib < 4; ++ib)
#pragma unroll
            for (int jb = 0; jb < 4; ++jb) qk[ib][jb] = (f32x4){0.f, 0.f, 0.f, 0.f};
        for (int s = 0; s < 8; ++s) {
            bf16x8 kf[4], qf[4];
#pragma unroll
            for (int ib = 0; ib < 4; ++ib) { const bf16* rp = P + (m0 + 16 * ib + c) * 8192 + 4096 + 256 * hr + 32 * s + 8 * rq;
                qf[ib] = *(const bf16x8*)rp; kf[ib] = *(const bf16x8*)(rp + 1024); }
#pragma unroll
            for (int ib = 0; ib < 4; ++ib)
#pragma unroll
                for (int jb = 0; jb <= ib; ++jb) qk[ib][jb] = mfma16(qf[ib], kf[jb], qk[ib][jb]);
        }
        bf16* qko = (bf16*)(ws + PW_RQK) + (size_t)jr * 4096;
        LAS float* Alq = Al + (4 * rq) * 68 + c;
#pragma unroll
        for (int ib = 0; ib < 4; ++ib)
#pragma unroll
            for (int e = 0; e < 4; ++e) { const int i = 16 * ib + 4 * rq + e; const float rs = exp2f((float)(i - 63) * lg);
#pragma unroll
                for (int jb = 0; jb < 4; ++jb) { const int j = 16 * jb + c; float qv = 0.f;
                    if (jb <= ib) qv = (i >= j) ? qk[ib][jb][e] * rs : 0.f;
                    Alq[(16 * ib + e) * 68 + 16 * jb] = qv; } }
#pragma unroll 4
        for (int i = 0; i < 64; ++i) qko[i * 64 + l] = (bf16)(cvt_pk_bf16(Al[i * 68 + l], 0.f) & 0xffffu);
    }
}
__device__ __forceinline__ void ev_chunk_scan(Frame& F, const Args& a) {
    unsigned char* ws = a.ws;
    const bf16* P = (const bf16*)(ws + WS_BIG); const bf16* QKV = (const bf16*)(ws + WS_EXT);
    bf16* O = (bf16*)(ws + WS_Y);
    const int l = F.lane, c = l & 15, rq = l >> 4, tid = F.tid, vs = F.wave;
    LAS unsigned char* L = F.lds;
    const f32x4 z4 = (f32x4){0.f, 0.f, 0.f, 0.f};
    if (F.bid < 128) {
        const int bh = F.bid, b = bh >> 3, h = bh & 7;
        constexpr int KL = 0, QL = 17408, VL = 34816, TL = 52224, QKL = 61440, VECL = 70656;
        f32x4 Sb[8];
#pragma unroll
        for (int kb = 0; kb < 8; ++kb) Sb[kb] = z4;
        v4u pk[2], pq[2], pv[2], pt, pqk, pvec;
#define GS_ISSUE(n) do { const size_t m0_ = (size_t)b * T + 64 * (n); const size_t job_ = (size_t)bh * 32 + (n); \
        _Pragma("unroll") for (int i = 0; i < 2; ++i) { const int ci = tid + 512 * i, row = ci >> 4, c16 = ci & 15; const bf16* sp = QKV + (m0_ + row) * 3072 + 128 * h + 8 * c16; \
            pq[i] = *(const v4u*)sp; pk[i] = *(const v4u*)(sp + 1024); pv[i] = *(const v4u*)(sp + 2048); } \
        pt = *(const v4u*)((const bf16*)(ws + PW_GT) + job_ * 4096 + tid * 8); pqk = *(const v4u*)((const bf16*)(ws + PW_GQK) + job_ * 4096 + tid * 8); \
        pvec = *(const v4u*)((const float*)(ws + PW_GVEC) + job_ * 256 + 4 * (tid & 63)); } while (0)
        GS_ISSUE(0);
        for (int n = 0; n < 32; ++n) {
            __syncthreads();
#pragma unroll
            for (int i = 0; i < 2; ++i) { const int ci = tid + 512 * i, row = ci >> 4, c16 = ci & 15;
                *(LAS v4u*)(L + KL + row * 272 + c16 * 16) = pk[i]; *(LAS v4u*)(L + QL + row * 272 + c16 * 16) = pq[i]; *(LAS v4u*)(L + VL + row * 272 + c16 * 16) = pv[i]; }
            *(LAS v4u*)(L + TL + (tid >> 3) * 144 + (tid & 7) * 16) = pt; *(LAS v4u*)(L + QKL + (tid >> 3) * 144 + (tid & 7) * 16) = pqk;
            if (tid < 64) *(LAS v4u*)(L + VECL + tid * 16) = pvec;
            __syncthreads();
            if (n + 1 < 32) GS_ISSUE(n + 1);
            const size_t m0 = (size_t)b * T + 64 * n;
            bf16x8 Sf[4];
#pragma unroll
            for (int s = 0; s < 4; ++s) Sf[s] = mkfrag(Sb[2 * s], Sb[2 * s + 1]);
            f32x4 KS[4], QS[4];
#pragma unroll
            for (int tb = 0; tb < 4; ++tb) { KS[tb] = z4; QS[tb] = z4;
                const LAS unsigned char* kr = L + KL + (16 * tb + c) * 272; const LAS unsigned char* qr = L + QL + (16 * tb + c) * 272;
#pragma unroll
                for (int s = 0; s < 4; ++s) { KS[tb] = mfma16(frag_pi(kr, 32 * s, rq), Sf[s], KS[tb]); QS[tb] = mfma16(frag_pi(qr, 32 * s, rq), Sf[s], QS[tb]); }
                __builtin_amdgcn_sched_barrier(0); }
            f32x4 R[4], eG[4], c3[4];
#pragma unroll
            for (int tb = 0; tb < 4; ++tb) {
                const v2u vw = tr_read(L + VL + (16 * tb + 4 * rq + (c >> 2)) * 272 + 32 * vs + 8 * (c & 3));
                const f32x4 be = *(const LAS f32x4*)(L + VECL + (16 * tb + 4 * rq) * 4);
                eG[tb] = *(const LAS f32x4*)(L + VECL + 256 + (16 * tb + 4 * rq) * 4); c3[tb] = *(const LAS f32x4*)(L + VECL + 512 + (16 * tb + 4 * rq) * 4);
                const float v0 = bfl(vw.x), v1 = bfh(vw.x), v2 = bfl(vw.y), v3 = bfh(vw.y);
                R[tb] = (f32x4){be[0] * (v0 - eG[tb][0] * KS[tb][0]), be[1] * (v1 - eG[tb][1] * KS[tb][1]), be[2] * (v2 - eG[tb][2] * KS[tb][2]), be[3] * (v3 - eG[tb][3] * KS[tb][3])};
            }
            const float dd = *(const LAS float*)(L + VECL + 768);
            bf16x8 Rf[2]; Rf[0] = mkfrag(R[0], R[1]); Rf[1] = mkfrag(R[2], R[3]);
            f32x4 Vn[4];
#pragma unroll
            for (int tb = 0; tb < 4; ++tb) { Vn[tb] = z4; const LAS unsigned char* tr = L + TL + (16 * tb + c) * 144;
#pragma unroll
                for (int s2 = 0; s2 <= (tb >> 1); ++s2) Vn[tb] = mfma16(frag_pi(tr, 32 * s2, rq), Rf[s2], Vn[tb]); }
            bf16x8 Vf[2], Wf[2];
            Vf[0] = mkfrag(Vn[0], Vn[1]); Vf[1] = mkfrag(Vn[2], Vn[3]);
            Wf[0] = mkfrag(Vn[0] * c3[0], Vn[1] * c3[1]); Wf[1] = mkfrag(Vn[2] * c3[2], Vn[3] * c3[3]);
#pragma unroll
            for (int tb = 0; tb < 4; ++tb) { f32x4 o2 = z4; const LAS unsigned char* qkr = L + QKL + (16 * tb + c) * 144;
#pragma unroll
                for (int s2 = 0; s2 <= (tb >> 1); ++s2) o2 = mfma16(frag_pi(qkr, 32 * s2, rq), Vf[s2], o2);
#pragma unroll
                for (int e = 0; e < 4; ++e) O[(m0 + 16 * tb + 4 * rq + e) * D + 128 * h + 16 * vs + c] = (bf16)(cvt_pk_bf16(eG[tb][e] * QS[tb][e] + o2[e], 0.f) & 0xffffu); }
#pragma unroll
            for (int kb = 0; kb < 8; ++kb) { f32x4 acc = Sb[kb] * dd;
#pragma unroll
                for (int s2 = 0; s2 < 2; ++s2) {
                    const v2u p0 = tr_read(L + KL + (32 * s2 + 4 * rq + (c >> 2)) * 272 + 32 * kb + 8 * (c & 3));
                    const v2u p1 = tr_read(L + KL + (32 * s2 + 16 + 4 * rq + (c >> 2)) * 272 + 32 * kb + 8 * (c & 3));
                    acc = mfma16(join64(p0, p1), Wf[s2], acc); }
                Sb[kb] = acc; if (kb & 1) __builtin_amdgcn_sched_barrier(0); }
        }
#undef GS_ISSUE
    } else {
        const int u = F.bid - 128, bhr = u >> 1, half = u & 1, b = bhr >> 2, hr = bhr & 3;
        constexpr int QL = 0, KL = 33792, VL = 67584, QKL = 84992;
        const float lg = log2f(1.0f - exp2f(-5.0f - (float)hr)), dd = exp2f(64.0f * lg);
        f32x4 Sb[16];
#pragma unroll
        for (int kb = 0; kb < 16; ++kb) Sb[kb] = z4;
        v4u pq[4], pk[4], pv[2], pqk;
#define RS_ISSUE(n) do { const size_t m0_ = (size_t)b * T + 64 * (n); const size_t job_ = (size_t)bhr * 32 + (n); \
        _Pragma("unroll") for (int i = 0; i < 4; ++i) { const int ci = tid + 512 * i, row = ci >> 5, c16 = ci & 31; const bf16* sp = P + (m0_ + row) * 8192 + 4096 + 256 * hr + 8 * c16; \
            pq[i] = *(const v4u*)sp; pk[i] = *(const v4u*)(sp + 1024); } \
        _Pragma("unroll") for (int i = 0; i < 2; ++i) { const int ci = tid + 512 * i, row = ci >> 4, c16 = ci & 15; pv[i] = *(const v4u*)(P + (m0_ + row) * 8192 + 6144 + 256 * hr + 128 * half + 8 * c16); } \
        pqk = *(const v4u*)((const bf16*)(ws + PW_RQK) + job_ * 4096 + tid * 8); } while (0)
        RS_ISSUE(0);
        for (int n = 0; n < 32; ++n) {
            __syncthreads();
#pragma unroll
            for (int i = 0; i < 4; ++i) { const int ci = tid + 512 * i, row = ci >> 5, c16 = ci & 31;
                *(LAS v4u*)(L + QL + row * 528 + c16 * 16) = pq[i]; *(LAS v4u*)(L + KL + row * 528 + c16 * 16) = pk[i]; }
#pragma unroll
            for (int i = 0; i < 2; ++i) { const int ci = tid + 512 * i, row = ci >> 4, c16 = ci & 15; *(LAS v4u*)(L + VL + row * 272 + c16 * 16) = pv[i]; }
            *(LAS v4u*)(L + QKL + (tid >> 3) * 144 + (tid & 7) * 16) = pqk;
            __syncthreads();
            if (n + 1 < 32) RS_ISSUE(n + 1);
            const size_t m0 = (size_t)b * T + 64 * n;
            f32x4 QS[4];
#pragma unroll
            for (int tb = 0; tb < 4; ++tb) QS[tb] = z4;
#pragma unroll
            for (int s = 0; s < 8; ++s) { const bf16x8 sf = mkfrag(Sb[2 * s], Sb[2 * s + 1]);
#pragma unroll
                for (int tb = 0; tb < 4; ++tb) QS[tb] = mfma16(frag_pi(L + QL + (16 * tb + c) * 528, 32 * s, rq), sf, QS[tb]);
                __builtin_amdgcn_sched_barrier(0); }
            bf16x8 Vf[2];
#pragma unroll
            for (int s2 = 0; s2 < 2; ++s2) {
                const v2u p0 = tr_read(L + VL + (32 * s2 + 8 * rq + (c >> 2)) * 272 + 32 * vs + 8 * (c & 3));
                const v2u p1 = tr_read(L + VL + (32 * s2 + 8 * rq + 4 + (c >> 2)) * 272 + 32 * vs + 8 * (c & 3));
                Vf[s2] = join64(p0, p1); }
#pragma unroll
            for (int tb = 0; tb < 4; ++tb) { f32x4 o2 = z4;
#pragma unroll
                for (int s2 = 0; s2 <= (tb >> 1); ++s2) o2 = mfma16(*(const LAS bf16x8*)(L + QKL + (16 * tb + c) * 144 + (32 * s2 + 8 * rq) * 2), Vf[s2], o2);
#pragma unroll
                for (int e = 0; e < 4; ++e) { const int i = 16 * tb + 4 * rq + e;
                    O[(m0 + i) * D + 1024 + 256 * hr + 128 * half + 16 * vs + c] = (bf16)(cvt_pk_bf16(exp2f((float)(i + 1) * lg) * QS[tb][e] + o2[e], 0.f) & 0xffffu); } }
#pragma unroll
            for (int kb = 0; kb < 16; ++kb) { f32x4 acc = Sb[kb] * dd;
#pragma unroll
                for (int s2 = 0; s2 < 2; ++s2) {
                    const v2u p0 = tr_read(L + KL + (32 * s2 + 8 * rq + (c >> 2)) * 528 + 32 * kb + 8 * (c & 3));
                    const v2u p1 = tr_read(L + KL + (32 * s2 + 8 * rq + 4 + (c >> 2)) * 528 + 32 * kb + 8 * (c & 3));
                    acc = mfma16(join64(p0, p1), Vf[s2], acc); }
                Sb[kb] = acc; if (kb & 1) __builtin_amdgcn_sched_barrier(0); }
        }
#undef RS_ISSUE
    }
    __syncthreads();
}

__device__ __forceinline__ void ev_post(Frame& F, const Args& a) {
    unsigned char* ws = a.ws;
    const bf16* P = (const bf16*)(ws + WS_BIG); const bf16* O = (const bf16*)(ws + WS_Y); bf16* OM = (bf16*)(ws + WS_H);
    const int gw = F.vcu * NWAVES + F.wave, l = F.lane;
    for (int r = 0; r < 16; ++r) {
        const int m = gw * 16 + r;
#pragma unroll
        for (int j = 0; j < 4; ++j) {
            const int c0 = 512 * j + 8 * l;
            float o[8], z[8]; unpack8(*(const v4u*)(O + (size_t)m * D + c0), o);
            float ss = 0.f;
#pragma unroll
            for (int e = 0; e < 8; ++e) ss += o[e] * o[e];
            ss += __shfl_xor(ss, 1); ss += __shfl_xor(ss, 2); ss += __shfl_xor(ss, 4); ss += __shfl_xor(ss, 8);
            float rn; const float* gn;
            if (j < 2) { rn = 1.0f / sqrtf(ss * (1.0f / 128.0f) + EPS); gn = a.in[12] + (c0 & 127); unpack8(*(const v4u*)(P + (size_t)m * 8192 + 3072 + c0), z); }
            else { ss += __shfl_xor(ss, 16); rn = 1.0f / sqrtf(ss * (1.0f / 256.0f) + EPS); gn = a.in[13] + (c0 - 1024); unpack8(*(const v4u*)(P + (size_t)m * 8192 + 7168 + (c0 - 1024)), z); }
            const f32x4 g0 = *(const f32x4*)gn, g1 = *(const f32x4*)(gn + 4);
            const float gg[8] = {g0[0], g0[1], g0[2], g0[3], g1[0], g1[1], g1[2], g1[3]};
#pragma unroll
            for (int e = 0; e < 8; ++e) o[e] = o[e] * rn * gg[e] * silu_f(z[e]);
            *(v4u*)(OM + (size_t)m * D + c0) = pack8(o);
        }
    }
}

__device__ __forceinline__ void od_conv(Frame& F, const Args& a) {
    unsigned char* ws = a.ws;
    const bf16* P1 = (const bf16*)(ws + WS_BIG); bf16* XC = (bf16*)(ws + WS_H);
    const int gw = F.vcu * NWAVES + F.wave, l = F.lane;
    const int rb = gw >> 2, j = gw & 3; const size_t m0 = (size_t)rb * 64; const int t0 = (int)(m0 & (T - 1));
    conv_slab<3>(P1 + m0 * 4096 + 2048 + 512 * j, 4096, t0, a.in[16] + 512 * j, 2048, a.in[17] + 512 * j, XC + m0 * D + 512 * j, D, l);
}
__device__ __forceinline__ float gelu_tanh(float y) {
    const float u = 0.7978845608028654f * (y + 0.044715f * y * y * y);
    const float th = 1.0f - 2.0f * __builtin_amdgcn_rcpf(__expf(2.0f * u) + 1.0f);
    return 0.5f * y * (1.0f + th);
}
__device__ __forceinline__ void od_scan(Frame& F, const Args& a) {
    unsigned char* ws = a.ws;
    const bf16* P1 = (const bf16*)(ws + WS_BIG); const float* ADEC = (const float*)(ws + WS_ADEC); const bf16* INP = (const bf16*)(ws + WS_EXT); bf16* HSY = (bf16*)(ws + WS_H);
    typedef float f32x2 __attribute__((ext_vector_type(2)));
    LAS f32x4* seg = (LAS f32x4*)F.lds;
    const int b = F.bid >> 4, c = (F.bid & 15) * 128 + 2 * F.lane;
    const size_t m0 = (size_t)b * T + (size_t)F.wave * 256;
    float A0 = 1.f, A1 = 1.f, h0 = 0.f, h1 = 0.f;
    for (int t0 = 0; t0 < 256; t0 += 16) {
        f32x2 av[16]; unsigned iv[16];
#pragma unroll
        for (int i = 0; i < 16; ++i) { const size_t m = m0 + t0 + i; av[i] = *(const f32x2*)(ADEC + m * D + c); iv[i] = *(const unsigned*)(INP + m * D + c); }
#pragma unroll
        for (int i = 0; i < 16; ++i) { h0 = fmaf(av[i][0], h0, bfl(iv[i])); h1 = fmaf(av[i][1], h1, bfh(iv[i])); A0 *= av[i][0]; A1 *= av[i][1]; }
    }
    seg[F.wave * 64 + F.lane] = (f32x4){A0, h0, A1, h1};
    __syncthreads();
    h0 = 0.f; h1 = 0.f;
    for (int s = 0; s < F.wave; ++s) { const f32x4 g = seg[s * 64 + F.lane]; h0 = fmaf(g[0], h0, g[1]); h1 = fmaf(g[2], h1, g[3]); }
    for (int t0 = 0; t0 < 256; t0 += 16) {
        f32x2 av[16]; unsigned iv[16], yv[16];
#pragma unroll
        for (int i = 0; i < 16; ++i) { const size_t m = m0 + t0 + i; av[i] = *(const f32x2*)(ADEC + m * D + c); iv[i] = *(const unsigned*)(INP + m * D + c); yv[i] = *(const unsigned*)(P1 + m * 4096 + c); }
#pragma unroll
        for (int i = 0; i < 16; ++i) { const size_t m = m0 + t0 + i; h0 = fmaf(av[i][0], h0, bfl(iv[i])); h1 = fmaf(av[i][1], h1, bfh(iv[i]));
            *(unsigned*)(HSY + m * D + c) = cvt_pk_bf16(h0 * gelu_tanh(bfl(yv[i])), h1 * gelu_tanh(bfh(yv[i]))); }
    }
    __syncthreads();
}

__device__ __forceinline__ void poison_state(LAS unsigned char* lds) {
    const unsigned seed = ((((unsigned)__builtin_amdgcn_s_memrealtime() * 2654435761u) ^ ((unsigned)threadIdx.x * 40503u)) & 0x007fffffu) | 0x3f000000u;
    __syncthreads();
#if PROBE_POISON_LDS
    for (int u = threadIdx.x; u < LDSCTL_OFF / 4; u += NWAVES * 64) ((LAS unsigned*)lds)[u] = seed ^ (unsigned)u;
#else
    { const unsigned long long t0 = __builtin_amdgcn_s_memrealtime(); while (__builtin_amdgcn_s_memrealtime() - t0 < 300ull + (seed & 255u)) __builtin_amdgcn_s_sleep(2); }
#endif
    __syncthreads();
#if PROBE_POISON_VGPR
    asm volatile("v_mov_b32 v1, %0\n\tv_mov_b32 v2, %0\n\tv_mov_b32 v3, %0\n\tv_mov_b32 v4, %0\n\tv_mov_b32 v5, %0\n\tv_mov_b32 v6, %0\n\tv_mov_b32 v7, %0\n\tv_mov_b32 v8, %0\n\tv_mov_b32 v9, %0\n\tv_mov_b32 v10, %0\n\tv_mov_b32 v11, %0\n\tv_mov_b32 v12, %0\n\tv_mov_b32 v13, %0\n\tv_mov_b32 v14, %0\n\tv_mov_b32 v15, %0\n\tv_mov_b32 v16, %0\n\tv_mov_b32 v17, %0\n\tv_mov_b32 v18, %0\n\tv_mov_b32 v19, %0\n\tv_mov_b32 v20, %0\n\tv_mov_b32 v21, %0\n\tv_mov_b32 v22, %0\n\tv_mov_b32 v23, %0\n\tv_mov_b32 v24, %0\n\tv_mov_b32 v25, %0\n\tv_mov_b32 v26, %0\n\tv_mov_b32 v27, %0\n\tv_mov_b32 v28, %0\n\tv_mov_b32 v29, %0\n\tv_mov_b32 v30, %0\n\tv_mov_b32 v31, %0\n\tv_mov_b32 v32, %0\n\tv_mov_b32 v33, %0\n\tv_mov_b32 v34, %0\n\tv_mov_b32 v35, %0\n\tv_mov_b32 v36, %0\n\tv_mov_b32 v37, %0\n\tv_mov_b32 v38, %0\n\tv_mov_b32 v39, %0\n\tv_mov_b32 v40, %0\n\tv_mov_b32 v41, %0\n\tv_mov_b32 v42, %0\n\tv_mov_b32 v43, %0\n\tv_mov_b32 v44, %0\n\tv_mov_b32 v45, %0\n\tv_mov_b32 v46, %0\n\tv_mov_b32 v47, %0\n\tv_mov_b32 v48, %0\n\tv_mov_b32 v49, %0\n\tv_mov_b32 v50, %0\n\tv_mov_b32 v51, %0\n\tv_mov_b32 v52, %0\n\tv_mov_b32 v53, %0\n\tv_mov_b32 v54, %0\n\tv_mov_b32 v55, %0\n\tv_mov_b32 v56, %0\n\tv_mov_b32 v57, %0\n\tv_mov_b32 v58, %0\n\tv_mov_b32 v59, %0\n\tv_mov_b32 v60, %0\n\tv_mov_b32 v61, %0\n\tv_mov_b32 v62, %0\n\tv_mov_b32 v63, %0\n\tv_mov_b32 v64, %0\n\tv_mov_b32 v65, %0\n\tv_mov_b32 v66, %0\n\tv_mov_b32 v67, %0\n\tv_mov_b32 v68, %0\n\tv_mov_b32 v69, %0\n\tv_mov_b32 v70, %0\n\tv_mov_b32 v71, %0\n\tv_mov_b32 v72, %0\n\tv_mov_b32 v73, %0\n\tv_mov_b32 v74, %0\n\tv_mov_b32 v75, %0\n\tv_mov_b32 v76, %0\n\tv_mov_b32 v77, %0\n\tv_mov_b32 v78, %0\n\tv_mov_b32 v79, %0\n\tv_mov_b32 v80, %0\n\tv_mov_b32 v81, %0\n\tv_mov_b32 v82, %0\n\tv_mov_b32 v83, %0\n\tv_mov_b32 v84, %0\n\tv_mov_b32 v85, %0\n\tv_mov_b32 v86, %0\n\tv_mov_b32 v87, %0\n\tv_mov_b32 v88, %0\n\tv_mov_b32 v89, %0\n\tv_mov_b32 v90, %0\n\tv_mov_b32 v91, %0\n\tv_mov_b32 v92, %0\n\tv_mov_b32 v93, %0\n\tv_mov_b32 v94, %0\n\tv_mov_b32 v95, %0\n\tv_mov_b32 v96, %0\n\tv_mov_b32 v97, %0\n\tv_mov_b32 v98, %0\n\tv_mov_b32 v99, %0\n\tv_mov_b32 v100, %0\n\tv_mov_b32 v101, %0\n\tv_mov_b32 v102, %0\n\tv_mov_b32 v103, %0\n\tv_mov_b32 v104, %0\n\tv_mov_b32 v105, %0\n\tv_mov_b32 v106, %0\n\tv_mov_b32 v107, %0\n\tv_mov_b32 v108, %0\n\tv_mov_b32 v109, %0\n\tv_mov_b32 v110, %0\n\tv_mov_b32 v111, %0\n\tv_mov_b32 v112, %0\n\tv_mov_b32 v113, %0\n\tv_mov_b32 v114, %0\n\tv_mov_b32 v115, %0\n\tv_mov_b32 v116, %0\n\tv_mov_b32 v117, %0\n\tv_mov_b32 v118, %0\n\tv_mov_b32 v119, %0\n\tv_mov_b32 v120, %0\n\tv_mov_b32 v121, %0\n\tv_mov_b32 v122, %0\n\tv_mov_b32 v123, %0\n\tv_mov_b32 v124, %0\n\tv_mov_b32 v125, %0\n\tv_mov_b32 v126, %0\n\tv_mov_b32 v127, %0\n\tv_mov_b32 v128, %0\n\tv_mov_b32 v129, %0\n\tv_mov_b32 v130, %0\n\tv_mov_b32 v131, %0\n\tv_mov_b32 v132, %0\n\tv_mov_b32 v133, %0\n\tv_mov_b32 v134, %0\n\tv_mov_b32 v135, %0\n\tv_mov_b32 v136, %0\n\tv_mov_b32 v137, %0\n\tv_mov_b32 v138, %0\n\tv_mov_b32 v139, %0\n\tv_mov_b32 v140, %0\n\tv_mov_b32 v141, %0\n\tv_mov_b32 v142, %0\n\tv_mov_b32 v143, %0\n\tv_mov_b32 v144, %0\n\tv_mov_b32 v145, %0\n\tv_mov_b32 v146, %0\n\tv_mov_b32 v147, %0\n\tv_mov_b32 v148, %0\n\tv_mov_b32 v149, %0\n\tv_mov_b32 v150, %0\n\tv_mov_b32 v151, %0\n\tv_mov_b32 v152, %0\n\tv_mov_b32 v153, %0\n\tv_mov_b32 v154, %0\n\tv_mov_b32 v155, %0\n\tv_mov_b32 v156, %0\n\tv_mov_b32 v157, %0\n\tv_mov_b32 v158, %0\n\tv_mov_b32 v159, %0\n\tv_mov_b32 v160, %0\n\tv_mov_b32 v161, %0\n\tv_mov_b32 v162, %0\n\tv_mov_b32 v163, %0\n\tv_mov_b32 v164, %0\n\tv_mov_b32 v165, %0\n\tv_mov_b32 v166, %0\n\tv_mov_b32 v167, %0\n\tv_mov_b32 v168, %0\n\tv_mov_b32 v169, %0\n\tv_mov_b32 v170, %0\n\tv_mov_b32 v171, %0\n\tv_mov_b32 v172, %0\n\tv_mov_b32 v173, %0\n\tv_mov_b32 v174, %0\n\tv_mov_b32 v175, %0\n\tv_mov_b32 v176, %0\n\tv_mov_b32 v177, %0\n\tv_mov_b32 v178, %0\n\tv_mov_b32 v179, %0\n\tv_mov_b32 v180, %0\n\tv_mov_b32 v181, %0\n\tv_mov_b32 v182, %0\n\tv_mov_b32 v183, %0\n\tv_mov_b32 v184, %0\n\tv_mov_b32 v185, %0\n\tv_mov_b32 v186, %0\n\tv_mov_b32 v187, %0\n\tv_mov_b32 v188, %0\n\tv_mov_b32 v189, %0\n\tv_mov_b32 v190, %0\n\tv_mov_b32 v191, %0\n\tv_mov_b32 v192, %0\n\tv_mov_b32 v193, %0\n\tv_mov_b32 v194, %0\n\tv_mov_b32 v195, %0\n\tv_mov_b32 v196, %0\n\tv_mov_b32 v197, %0\n\tv_mov_b32 v198, %0\n\tv_mov_b32 v199, %0\n\tv_mov_b32 v200, %0\n\tv_mov_b32 v201, %0\n\tv_mov_b32 v202, %0\n\tv_mov_b32 v203, %0\n\tv_mov_b32 v204, %0\n\tv_mov_b32 v205, %0\n\tv_mov_b32 v206, %0\n\tv_mov_b32 v207, %0\n\tv_mov_b32 v208, %0\n\tv_mov_b32 v209, %0\n\tv_mov_b32 v210, %0\n\tv_mov_b32 v211, %0\n\tv_mov_b32 v212, %0\n\tv_mov_b32 v213, %0\n\tv_mov_b32 v214, %0\n\tv_mov_b32 v215, %0\n\tv_mov_b32 v216, %0\n\tv_mov_b32 v217, %0\n\tv_mov_b32 v218, %0\n\tv_mov_b32 v219, %0\n\tv_mov_b32 v220, %0\n\tv_mov_b32 v221, %0\n\tv_mov_b32 v222, %0\n\tv_mov_b32 v223, %0\n\tv_mov_b32 v224, %0\n\tv_mov_b32 v225, %0\n\tv_mov_b32 v226, %0\n\tv_mov_b32 v227, %0\n\tv_mov_b32 v228, %0\n\tv_mov_b32 v229, %0\n\tv_mov_b32 v230, %0\n\tv_mov_b32 v231, %0\n\tv_mov_b32 v232, %0\n\tv_mov_b32 v233, %0\n\tv_mov_b32 v234, %0\n\tv_mov_b32 v235, %0\n\tv_mov_b32 v236, %0\n\tv_mov_b32 v237, %0\n\tv_mov_b32 v238, %0\n\tv_mov_b32 v239, %0" :: "v"(seed) : "v1", "v2", "v3", "v4", "v5", "v6", "v7", "v8", "v9", "v10", "v11", "v12", "v13", "v14", "v15", "v16", "v17", "v18", "v19", "v20", "v21", "v22", "v23", "v24", "v25", "v26", "v27", "v28", "v29", "v30", "v31", "v32", "v33", "v34", "v35", "v36", "v37", "v38", "v39", "v40", "v41", "v42", "v43", "v44", "v45", "v46", "v47", "v48", "v49", "v50", "v51", "v52", "v53", "v54", "v55", "v56", "v57", "v58", "v59", "v60", "v61", "v62", "v63", "v64", "v65", "v66", "v67", "v68", "v69", "v70", "v71", "v72", "v73", "v74", "v75", "v76", "v77", "v78", "v79", "v80", "v81", "v82", "v83", "v84", "v85", "v86", "v87", "v88", "v89", "v90", "v91", "v92", "v93", "v94", "v95", "v96", "v97", "v98", "v99", "v100", "v101", "v102", "v103", "v104", "v105", "v106", "v107", "v108", "v109", "v110", "v111", "v112", "v113", "v114", "v115", "v116", "v117", "v118", "v119", "v120", "v121", "v122", "v123", "v124", "v125", "v126", "v127", "v128", "v129", "v130", "v131", "v132", "v133", "v134", "v135", "v136", "v137", "v138", "v139", "v140", "v141", "v142", "v143", "v144", "v145", "v146", "v147", "v148", "v149", "v150", "v151", "v152", "v153", "v154", "v155", "v156", "v157", "v158", "v159", "v160", "v161", "v162", "v163", "v164", "v165", "v166", "v167", "v168", "v169", "v170", "v171", "v172", "v173", "v174", "v175", "v176", "v177", "v178", "v179", "v180", "v181", "v182", "v183", "v184", "v185", "v186", "v187", "v188", "v189", "v190", "v191", "v192", "v193", "v194", "v195", "v196", "v197", "v198", "v199", "v200", "v201", "v202", "v203", "v204", "v205", "v206", "v207", "v208", "v209", "v210", "v211", "v212", "v213", "v214", "v215", "v216", "v217", "v218", "v219", "v220", "v221", "v222", "v223", "v224", "v225", "v226", "v227", "v228", "v229", "v230", "v231", "v232", "v233", "v234", "v235", "v236", "v237", "v238", "v239");
#endif
}
__device__ __forceinline__ bool maybe_poison(Frame& F, int k) { if (PROBE_POISON_PHASE >= 0 && k == PROBE_POISON_PHASE) poison_state(F.lds); return true; }
__device__ __forceinline__ void echo_busy(const unsigned long long tlast, float* sink) {
    typedef short ebf16x8 __attribute__((ext_vector_type(8)));
    const unsigned long long t1 = __builtin_amdgcn_s_memrealtime(), d = t1 - tlast;
    ebf16x8 efa, efb; pg8::f32x4 e0 = {0.f, 0.f, 0.f, 0.f}, e1 = e0, e2 = e0, e3 = e0;
    unsigned hsh = (unsigned)threadIdx.x * 2654435761u + 12345u;
#pragma unroll
    for (int i = 0; i < 8; ++i) { hsh = hsh * 1664525u + 1013904223u; efa[i] = (short)(0x3c00 | ((hsh >> 9) & 0x83ff)); hsh = hsh * 1664525u + 1013904223u; efb[i] = (short)(0x3c00 | ((hsh >> 9) & 0x83ff)); }
    while (__builtin_amdgcn_s_memrealtime() - t1 < d) {
        if (PROBE_ECHO_SLEEP == 1) { __builtin_amdgcn_s_sleep(8); continue; }
        if (PROBE_ECHO_SLEEP == 2) { _Pragma("unroll") for (int i = 0; i < 64; ++i) { e0 = e0 * 1.0001f + e1; e1 = e1 * 0.9999f + e2; e2 = e2 * 1.0001f - e3; e3 = e3 * 0.9999f + 1e-3f; } continue; }
#pragma unroll
        for (int i = 0; i < 16; ++i) { e0 = __builtin_amdgcn_mfma_f32_16x16x32_bf16(efa, efb, e0, 0, 0, 0); e1 = __builtin_amdgcn_mfma_f32_16x16x32_bf16(efb, efa, e1, 0, 0, 0);
            e2 = __builtin_amdgcn_mfma_f32_16x16x32_bf16(efa, efa, e2, 0, 0, 0); e3 = __builtin_amdgcn_mfma_f32_16x16x32_bf16(efb, efb, e3, 0, 0, 0); }
    }
    const float es = e0[0] + e1[1] + e2[2] + e3[3]; if (es == 1.2345678e-33f) sink[0] = es;
}
__device__ __forceinline__ bool fresh(Frame& F) { int t = threadIdx.x; asm volatile("" : "+v"(t)); F.tid = t; F.lane = t & 63; return true; }
__global__ void __launch_bounds__(NWAVES * 64, 2) mk_fwd(Args args) {
    extern __shared__ __attribute__((aligned(16))) unsigned char lds[];
    Frame F;
    F.lds = (LAS unsigned char*)lds;
    F.MISC = (volatile LAS unsigned*)(F.lds + MISC_OFF);
    F.tid = threadIdx.x; F.lane = F.tid & 63; F.wave = __builtin_amdgcn_readfirstlane(F.tid >> 6);
    F.G = gridDim.x; F.bid = blockIdx.x;
    if (PROBE_PERM_BLOCKS) { const unsigned sd = (unsigned)(__builtin_amdgcn_s_memrealtime() >> 22); F.bid = (int)((blockIdx.x * 37u + sd * 101u) & 255u); }
    { const int bx = F.bid; F.vcu = (F.G % 8 == 0) ? (bx % 8) * (F.G / 8) + bx / 8 : bx; }
    unsigned char* ws = args.ws;
    F.ctl = (gu32*)(ws + WS_CTL);
    for (int u = F.tid; u < (LDS_BYTES - LDSCTL_OFF) / 4; u += NWAVES * 64) ((LAS unsigned*)(F.lds + LDSCTL_OFF))[u] = 0u;
    __syncthreads();
    XcdBarrier bar; bar.bar = (unsigned*)(F.ctl + CW_BAR); bar.x = 0; bar.st = nullptr;
    if (!MK_PER_PHASE) bar = xcd_barrier_post((unsigned*)(F.ctl + CW_BAR), F.MISC + 8);
    const int lo = args.ph_lo, hi = args.ph_hi;
    if (PROBE_START_BUSY) { echo_busy(__builtin_amdgcn_s_memrealtime() - (unsigned long long)PROBE_START_BUSY, args.out); }
    unsigned long long tlast = PROBE_ECHO_MASK != 0u ? __builtin_amdgcn_s_memrealtime() : 0ull; (void)tlast;
#define IN(k) (lo <= (k) && (k) < hi && fresh(F) && maybe_poison(F, (k)))
#define GEMM_RUN(...) do { pg8::gemm_phase<__VA_ARGS__>(F.lds, g, S, E); if (PROBE_GEMM_X2) { __syncthreads(); pg8::gemm_phase<__VA_ARGS__>(F.lds, g, S, E); } } while (0)
#define SEAM(k) do { if (IN(k) && IN((k) + 1)) xcd_barrier(bar); \
    if (PROBE_ECHO_MASK != 0u) { if ((PROBE_ECHO_MASK >> (k)) & 1u) { echo_busy(tlast, args.out); } tlast = __builtin_amdgcn_s_memrealtime(); } } while (0)
    const pg8::bf16_t* Hb = (const pg8::bf16_t*)(ws + WS_H);
    pg8::bf16_t* Yb = (pg8::bf16_t*)(ws + WS_Y);
    pg8::bf16_t* BIGb = (pg8::bf16_t*)(ws + WS_BIG);
#define FFN_PHASES(k, q, wi) \
    if (IN(k)) { norm_pass<false>(F, args, (q)); if (PROBE_NORM_X2 && (q) == 0) { __syncthreads(); norm_pass<false>(F, args, (q)); } } SEAM(k); \
    if (IN((k) + 1)) { pg8::Gemm g{Hb, (const pg8::bf16_t*)(ws + WS_W13 + (size_t)(wi) * W13_BYTES), M, 2 * DFF, D, D, 0}; pg8::StaticOrder S; S.init(M, 2 * DFF, F.G, F.bid); \
        pg8::EpiSwiGLU E{BIGb, DFF}; GEMM_RUN(pg8::EpiSwiGLU, pg8::StaticOrder, true, true); } SEAM((k) + 1); \
    if (IN((k) + 2)) { pg8::Gemm g{BIGb, (const pg8::bf16_t*)(ws + WS_W2 + (size_t)(wi) * W2_BYTES), M, D, DFF, DFF, 0}; pg8::StaticOrder S; S.init(M, D, F.G, F.bid); \
        pg8::EpiBf16 E{Yb, D}; GEMM_RUN(pg8::EpiBf16, pg8::StaticOrder, true, true); } SEAM((k) + 2);

    enum { PH_P0 = 0, PH_F0 = 1, PH_N1 = 4, PH_EVIN = 5, PH_EVPREP = 6, PH_EVCP = 7, PH_EVSCAN = 8, PH_EVPOST = 9, PH_EVOUT = 10, PH_F2 = 11, PH_F3 = 14,
           PH_N4 = 17, PH_ODIN = 18, PH_ODCONV = 19, PH_ODGATE = 20, PH_ODSCAN = 21, PH_ODOUT = 22, PH_F5 = 23, PH_FINAL = 26 };
    static_assert(PH_FINAL + 1 == NPHASE, "phase count");
    if (IN(PH_P0)) { p0_prologue(F, args); if (PROBE_P0_X2) { __syncthreads(); p0_prologue(F, args); } } SEAM(PH_P0);
    FFN_PHASES(PH_F0, 0, 0)
    if (IN(PH_N1)) { norm_pass<true>(F, args, 1); if (PROBE_NORM_X2) { __syncthreads(); norm_pass<true>(F, args, 1); } } SEAM(PH_N1);
    if (IN(PH_EVIN)) { pg8::Gemm g{Hb, (const pg8::bf16_t*)(ws + WS_WEVIN), M, 8192, D, D, 0}; pg8::StaticOrder S; S.init(M, 8192, F.G, F.bid);
        pg8::EpiBf16 E{BIGb, 8192}; GEMM_RUN(pg8::EpiBf16, pg8::StaticOrder, true, true); } SEAM(PH_EVIN);
    if (IN(PH_EVPREP)) { ev_prep(F, args); } SEAM(PH_EVPREP);
    if (IN(PH_EVCP)) { ev_chunk_prep(F, args); if (PROBE_EW_X2 == 2) { __syncthreads(); ev_chunk_prep(F, args); } } SEAM(PH_EVCP);
    if (IN(PH_EVSCAN)) { ev_chunk_scan(F, args); if (PROBE_REC_X2) { __syncthreads(); ev_chunk_scan(F, args); } } SEAM(PH_EVSCAN);
    if (IN(PH_EVPOST)) { ev_post(F, args); if (PROBE_EW_X2 == 1) { __syncthreads(); ev_post(F, args); } } SEAM(PH_EVPOST);
    if (IN(PH_EVOUT)) { pg8::Gemm g{Hb, (const pg8::bf16_t*)(ws + WS_WEVOUT), M, D, D, D, 0}; pg8::StaticOrder S; S.init(M, D, F.G, F.bid);
        pg8::EpiBf16 E{Yb, D}; GEMM_RUN(pg8::EpiBf16, pg8::StaticOrder, true, true); } SEAM(PH_EVOUT);
    FFN_PHASES(PH_F2, 2, 1)
    FFN_PHASES(PH_F3, 3, 2)
    if (IN(PH_N4)) { norm_pass<false>(F, args, 4); } SEAM(PH_N4);
    if (IN(PH_ODIN)) { pg8::Gemm g{Hb, (const pg8::bf16_t*)(ws + WS_WODIN), M, 4096, D, D, 0}; pg8::StaticOrder S; S.init(M, 4096, F.G, F.bid);
        pg8::EpiBf16 E{BIGb, 4096}; GEMM_RUN(pg8::EpiBf16, pg8::StaticOrder, true, true); } SEAM(PH_ODIN);
    if (IN(PH_ODCONV)) { od_conv(F, args); if (PROBE_EW_X2 == 1) { __syncthreads(); od_conv(F, args); } } SEAM(PH_ODCONV);
    if (IN(PH_ODGATE)) { pg8::Gemm g{Hb, (const pg8::bf16_t*)(ws + WS_WGATE), M, 4096, 256, D, 2}; pg8::StaticOrder S; S.init(M, 4096, F.G, F.bid);
        pg8::EpiGates E{(float*)(ws + WS_ADEC), (pg8::bf16_t*)(ws + WS_EXT), Hb, args.in[19], args.in[21], (const float*)(ws + WS_SP8)};
        GEMM_RUN(pg8::EpiGates, pg8::StaticOrder, true, true); } SEAM(PH_ODGATE);
    if (IN(PH_ODSCAN)) { od_scan(F, args); } SEAM(PH_ODSCAN);
    if (IN(PH_ODOUT)) { pg8::Gemm g{Hb, (const pg8::bf16_t*)(ws + WS_WODOUT), M, D, D, D, 0}; pg8::StaticOrder S; S.init(M, D, F.G, F.bid);
        pg8::EpiBf16 E{Yb, D}; GEMM_RUN(pg8::EpiBf16, pg8::StaticOrder, true, true); } SEAM(PH_ODOUT);
    FFN_PHASES(PH_F5, 5, 3)
    if (IN(PH_FINAL)) { norm_pass<false>(F, args, 6); if (FINAL_BAR && !MK_PER_PHASE) xcd_barrier(bar); }
#undef IN
#undef SEAM
#undef FFN_PHASES
}

extern "C" void kernel_launch(void* const* d_in, const int* in_sizes, int n_in, void* d_out, int out_size, void* d_ws, size_t ws_size, hipStream_t stream) {
    static int grid = 0;
    if (grid == 0) {
        if (n_in != 24 || in_sizes[0] != M * D || out_size != M * D || ws_size < WS_END) {
            fprintf(stderr, "kernel_launch: unexpected problem (n_in %d, in0 %d, out %d, ws %zu < %zu); nothing launched\n", n_in, n_in > 0 ? in_sizes[0] : -1, out_size, ws_size, (size_t)WS_END); grid = -1; return; }
        int dev = 0, cus = 0, per_cu = 0;
        if (hipGetDevice(&dev) != hipSuccess || hipDeviceGetAttribute(&cus, hipDeviceAttributeMultiprocessorCount, dev) != hipSuccess) { grid = -1; return; }
        if (hipFuncSetAttribute((const void*)mk_fwd, hipFuncAttributeMaxDynamicSharedMemorySize, LDS_BYTES) != hipSuccess) { fprintf(stderr, "kernel_launch: hipFuncSetAttribute failed\n"); grid = -1; return; }
        if (hipOccupancyMaxActiveBlocksPerMultiprocessor(&per_cu, (const void*)mk_fwd, NWAVES * 64, LDS_BYTES) != hipSuccess || per_cu < 1)
            fprintf(stderr, "kernel_launch: note: occupancy query reports %d workgroups per CU\n", per_cu);
        (void)hipGetLastError();
        grid = cus;
        if (grid != 256) fprintf(stderr, "kernel_launch: note: %d CUs (built for 256)\n", grid);
    }
    if (grid < 0) return;
    if (hipMemsetAsync((char*)d_ws + WS_CTL, 0, CTL_ZERO_BYTES, stream) != hipSuccess) return;
    Args a{};
    for (int i = 0; i < 24; ++i) a.in[i] = (const float*)d_in[i];
    a.out = (float*)d_out; a.ws = (unsigned char*)d_ws;
#if MK_PER_PHASE
    for (int k = 0; k < NPHASE; ++k) { a.ph_lo = k; a.ph_hi = k + 1; hipLaunchKernelGGL(mk_fwd, dim3(grid), dim3(NWAVES * 64), LDS_BYTES, stream, a); }
#else
    a.ph_lo = 0; a.ph_hi = NPHASE; hipLaunchKernelGGL(mk_fwd, dim3(grid), dim3(NWAVES * 64), LDS_BYTES, stream, a);
#endif
}
```

```cpp
#include <hip/hip_runtime.h>
#include <cstdio>
#include <cstdint>
#include <cmath>
namespace pg8 {
#define PG8_LAS __attribute__((address_space(3)))
typedef unsigned short bf16_t;
typedef short bf16x8 __attribute__((ext_vector_type(8)));
typedef float f32x4 __attribute__((ext_vector_type(4)));
typedef unsigned u32x4 __attribute__((ext_vector_type(4)));
constexpr int BM = 256, BK = 64, HALF = 128, HTB = HALF * BK * 2  , STAGE_BYTES = 8 * HTB, NXCD = 8, WGM = 8;

__host__ __device__ __forceinline__ int lds_byte(int r, int c) { const int st = (r >> 4) * 2 + (c >> 5), rr = r & 15, cc = c & 31, ob = rr * 64 + cc * 2; return st * 1024 + (ob ^ (((ob >> 9) & 1) << 5)); }
__host__ __device__ __forceinline__ void stage_rc(int b, int& R, int& C) { const int st = b / 1024, sb = b % 1024, swz = sb ^ (((sb >> 9) & 1) << 5); R = (st >> 1) * 16 + swz / 64; C = (st & 1) * 32 + (swz % 64) / 2; }
__host__ __device__ __forceinline__ int perm32(int rho) { const int n = rho >> 4, i = rho & 15; return 8 * (i >> 2) + 4 * n + (i & 3); }

struct Unit { int pm, pn; };
struct Gemm { const bf16_t* A; const bf16_t* Bt; int M, N, K, lda, ablk; };

struct StaticOrder {
    int nM, nN, nwg, G, c;
    __host__ __device__ void init(int M, int N, int G_, int c_) { nM = M / BM; nN = N / BM; nwg = nM * nN; G = G_; c = c_; }
    __host__ __device__ bool next(int i, Unit& u) const {
        const long L = (long)i * G + c; if (L >= nwg) return false;
        int wgid = (int)L; { const int q = nwg / NXCD, r = nwg % NXCD, xcd = wgid % NXCD, off = wgid / NXCD; wgid = (xcd < r ? xcd * (q + 1) : r * (q + 1) + (xcd - r) * q) + off; }
        const int nig = WGM * nN, gid = wgid / nig, fm = gid * WGM, gsz = (nM - fm) < WGM ? (nM - fm) : WGM;
        u.pm = fm + ((wgid % nig) % gsz); u.pn = (wgid % nig) / gsz; return true;
    }
    __device__ __forceinline__ void a_ready(const Unit&) const {}
    __device__ __forceinline__ void done(const Unit&) const {}
};

__device__ __forceinline__ unsigned cvt_pk_bf16(float lo, float hi) { unsigned r; asm volatile("v_cvt_pk_bf16_f32 %0, %1, %2" : "=v"(r) : "v"(lo), "v"(hi)); return r; }
__device__ __forceinline__ float fast_sigmoid(float x) { return __builtin_amdgcn_rcpf(1.0f + __expf(-x)); }
__device__ __forceinline__ float bfl(unsigned w) { return __uint_as_float(w << 16); }
__device__ __forceinline__ float bfh(unsigned w) { return __uint_as_float(w & 0xffff0000u); }

struct EpiBf16 {
    static constexpr bool PERM = true, AFTER_DRAIN = false;
    bf16_t* O; int ldc;
    __device__ __forceinline__ void operator()(const f32x4 (&acc)[2][2][4][2], const Unit& u, int wr, int wc, int fr, int fq) const {
        const int row0 = u.pm * BM + wr * 64 + fr, col0 = u.pn * BM + wc * 32 + 8 * fq;
#pragma unroll
        for (int ai = 0; ai < 2; ++ai)
#pragma unroll
            for (int m = 0; m < 4; ++m) { bf16_t* rowp = O + (size_t)(row0 + ai * HALF + m * 16) * ldc + col0;
#pragma unroll
                for (int bj = 0; bj < 2; ++bj) { const f32x4 v0 = acc[ai][bj][m][0], v1 = acc[ai][bj][m][1];
                    u32x4 w; w.x = cvt_pk_bf16(v0[0], v0[1]); w.y = cvt_pk_bf16(v0[2], v0[3]); w.z = cvt_pk_bf16(v1[0], v1[1]); w.w = cvt_pk_bf16(v1[2], v1[3]);
                    *(u32x4*)(rowp + bj * HALF) = w; } }
    }
};
struct EpiSwiGLU {
    static constexpr bool PERM = true, AFTER_DRAIN = false;
    bf16_t* O; int ldc;
    __device__ __forceinline__ void operator()(const f32x4 (&acc)[2][2][4][2], const Unit& u, int wr, int wc, int fr, int fq) const {
        const int row0 = u.pm * BM + wr * 64 + fr, col0 = u.pn * HALF + wc * 32 + 8 * fq;
#pragma unroll
        for (int ai = 0; ai < 2; ++ai)
#pragma unroll
            for (int m = 0; m < 4; ++m) { bf16_t* rowp = O + (size_t)(row0 + ai * HALF + m * 16) * ldc + col0;
                float r[8];
#pragma unroll
                for (int n = 0; n < 2; ++n)
#pragma unroll
                    for (int e = 0; e < 4; ++e) { const float g = acc[ai][0][m][n][e], up = acc[ai][1][m][n][e]; r[n * 4 + e] = g * fast_sigmoid(g) * up; }
                u32x4 w; w.x = cvt_pk_bf16(r[0], r[1]); w.y = cvt_pk_bf16(r[2], r[3]); w.z = cvt_pk_bf16(r[4], r[5]); w.w = cvt_pk_bf16(r[6], r[7]);
                *(u32x4*)rowp = w; }
    }
};
struct EpiGates {
    static constexpr bool PERM = true, AFTER_DRAIN = false;
    bf16_t* RG; bf16_t* INP; const bf16_t* XC; const float* ba; const float* bx; const float* sp8;
    __device__ __forceinline__ void operator()(const f32x4 (&acc)[2][2][4][2], const Unit& u, int wr, int wc, int fr, int fq) const {
        const int row0 = u.pm * BM + wr * 64 + fr, c0 = (u.pn >> 1) * 256 + (u.pn & 1) * HALF + wc * 32 + 8 * fq;
#pragma unroll
        for (int ai = 0; ai < 2; ++ai)
#pragma unroll
            for (int m = 0; m < 4; ++m) { const size_t off = (size_t)(row0 + ai * HALF + m * 16) * 2048 + c0;
                const u32x4 xw = *(const u32x4*)(XC + off);
                f32x4 bav[2], bxv[2], spv[2];
#pragma unroll
                for (int n = 0; n < 2; ++n) { bav[n] = *(const f32x4*)(ba + c0 + 4 * n); bxv[n] = *(const f32x4*)(bx + c0 + 4 * n); spv[n] = *(const f32x4*)(sp8 + c0 + 4 * n); }
                const float xc[8] = {bfl(xw.x), bfh(xw.x), bfl(xw.y), bfh(xw.y), bfl(xw.z), bfh(xw.z), bfl(xw.w), bfh(xw.w)};
                float av[8], iv[8];
#pragma unroll
                for (int n = 0; n < 2; ++n)
#pragma unroll
                    for (int e = 0; e < 4; ++e) { const float r = fast_sigmoid(acc[ai][0][m][n][e] + bav[n][e]), ig = fast_sigmoid(acc[ai][1][m][n][e] + bxv[n][e]);
                        const float a = __expf(spv[n][e] * r); av[n * 4 + e] = r; iv[n * 4 + e] = sqrtf(fmaxf(1.0f - a * a, 0.0f)) * ig * xc[n * 4 + e]; }
                { u32x4 rw; rw.x = cvt_pk_bf16(av[0], av[1]); rw.y = cvt_pk_bf16(av[2], av[3]); rw.z = cvt_pk_bf16(av[4], av[5]); rw.w = cvt_pk_bf16(av[6], av[7]); *(u32x4*)(RG + off) = rw; }
                u32x4 w; w.x = cvt_pk_bf16(iv[0], iv[1]); w.y = cvt_pk_bf16(iv[2], iv[3]); w.z = cvt_pk_bf16(iv[4], iv[5]); w.w = cvt_pk_bf16(iv[6], iv[7]);
                *(u32x4*)(INP + off) = w;
                asm volatile("" ::: "memory"); }
    }
};

template <class Epi, class Sched, bool ALIGN_EPI = false, bool SP2 = false>
__device__ __forceinline__ void gemm_phase(PG8_LAS unsigned char* lds, const Gemm g, const Sched& S, const Epi& E) {
    int tid_ = threadIdx.x; asm volatile("" : "+v"(tid_));
    const int tid = tid_, wid = __builtin_amdgcn_readfirstlane(tid >> 6), lane = tid & 63, wr = wid >> 2, wc = wid & 3, fr = lane & 15, fq = lane >> 4;
    const int K = g.K, nt = K / BK;
    unsigned voffA[2], voffB[2];
#pragma unroll
    for (int i = 0; i < 2; ++i) { int R, C; stage_rc(tid * 16 + i * 8192, R, C); const int Rb = Epi::PERM ? ((R & ~31) + perm32(R & 31)) : R;
        voffA[i] = (unsigned)(R * g.lda + C) * 2u; voffB[i] = (unsigned)(Rb * K + C) * 2u; }
    const size_t kstep = (size_t)(BK * 2);
    const size_t hstep = (size_t)HALF * K * 2, hstepA = (size_t)HALF * g.lda * 2;
    const size_t tstep = 2 * hstep, tstepA = 2 * hstepA;
    const unsigned ldsw = (unsigned)wid * 1024u;
    const int aoff = lds_byte(wr * 64 + fr, fq * 8), boff = lds_byte(wc * 32 + fr, fq * 8);
#define PG8_SA(b, h) (((b) * 2 + (h)) * HTB)
#define PG8_SB(b, h) ((4 + (b) * 2 + (h)) * HTB)
#define PG8_STAGE(bufoff, gbase, voff) do { _Pragma("unroll") for (int _i = 0; _i < 2; ++_i) \
        __builtin_amdgcn_global_load_lds((const unsigned*)((const char*)(gbase) + (voff)[_i]), (PG8_LAS unsigned*)(lds + (bufoff) + ldsw + _i * 8192), 16, 0, 0); } while (0)
#define PG8_LDA(dst, b, h) do { _Pragma("unroll") for (int m = 0; m < 4; ++m) _Pragma("unroll") for (int k = 0; k < 2; ++k) dst[m][k] = *(const PG8_LAS bf16x8*)(lds + PG8_SA(b, h) + aoff + m * 2048 + k * 1024); } while (0)
#define PG8_LDB(dst, b, h) do { _Pragma("unroll") for (int n = 0; n < 2; ++n) _Pragma("unroll") for (int k = 0; k < 2; ++k) dst[n][k] = *(const PG8_LAS bf16x8*)(lds + PG8_SB(b, h) + boff + n * 2048 + k * 1024); } while (0)
#define PG8_MMA(ai, bj, At, Bt) do { __builtin_amdgcn_s_setprio(1); _Pragma("unroll") for (int m = 0; m < 4; ++m) _Pragma("unroll") for (int n = 0; n < 2; ++n) _Pragma("unroll") for (int k = 0; k < 2; ++k) \
        acc[ai][bj][m][n] = __builtin_amdgcn_mfma_f32_16x16x32_bf16(Bt[n][k], At[m][k], acc[ai][bj][m][n], 0, 0, 0); __builtin_amdgcn_s_setprio(0); } while (0)
#define PG8_WAIT_V(n) asm volatile("s_waitcnt vmcnt(" #n ")" ::: "memory")
#define PG8_WAIT_L(n) asm volatile("s_waitcnt lgkmcnt(" #n ")" ::: "memory")
#define PG8_BAR __builtin_amdgcn_s_barrier()
#define PG8_SCHED __builtin_amdgcn_sched_barrier(0)
    Unit cur, nxt; int ui = 0;
    if (!S.next(0, cur)) return;
    f32x4 acc[2][2][4][2];
#pragma unroll
    for (int a = 0; a < 2; ++a)
#pragma unroll
        for (int b = 0; b < 2; ++b)
#pragma unroll
            for (int m = 0; m < 4; ++m)
#pragma unroll
                for (int n = 0; n < 2; ++n) acc[a][b][m][n] = (f32x4){0.f, 0.f, 0.f, 0.f};
    bf16x8 At[4][2], B0[2][2], B1[2][2];
    const char* cA = (const char*)g.A + (size_t)cur.pm * tstepA + (g.ablk ? (size_t)(cur.pn / g.ablk) * K * 2 : (size_t)0); const char* cB = (const char*)g.Bt + (size_t)cur.pn * tstep;
    S.a_ready(cur);
    if constexpr (SP2) {
        PG8_STAGE(PG8_SB(0, 0), cB, voffB); PG8_STAGE(PG8_SB(0, 1), cB + hstep, voffB); PG8_STAGE(PG8_SA(0, 0), cA, voffA); PG8_STAGE(PG8_SA(0, 1), cA + hstepA, voffA);
        if (wr == 1) PG8_BAR;
        PG8_WAIT_V(2); PG8_BAR;
        PG8_STAGE(PG8_SB(1, 0), cB + kstep, voffB); PG8_STAGE(PG8_SA(1, 0), cA + kstep, voffA); PG8_STAGE(PG8_SB(1, 1), cB + hstep + kstep, voffB);
        PG8_WAIT_V(6); PG8_BAR;
    } else {
        PG8_STAGE(PG8_SB(0, 0), cB, voffB); PG8_STAGE(PG8_SA(0, 0), cA, voffA); PG8_STAGE(PG8_SB(0, 1), cB + hstep, voffB); PG8_STAGE(PG8_SA(0, 1), cA + hstepA, voffA);
        if (wr == 1) PG8_BAR;
        PG8_WAIT_V(4); PG8_BAR;
        PG8_STAGE(PG8_SB(1, 0), cB + kstep, voffB); PG8_STAGE(PG8_SA(1, 0), cA + kstep, voffA); PG8_STAGE(PG8_SB(1, 1), cB + hstep + kstep, voffB);
        PG8_WAIT_V(6); PG8_BAR;
    }
    for (;;) {
        const bool has_next = S.next(ui + 1, nxt);
        const char* nA = has_next ? (const char*)g.A + (size_t)nxt.pm * tstepA + (g.ablk ? (size_t)(nxt.pn / g.ablk) * K * 2 : (size_t)0) : cA; const char* nB = has_next ? (const char*)g.Bt + (size_t)nxt.pn * tstep : cB;
        for (int t = 0; t < nt; t += 2) {
            const bool last = (t == nt - 2);
            const char* a1 = cA + (size_t)(t + 1) * kstep;
            const char* a2 = last ? nA : cA + (size_t)(t + 2) * kstep; const char* b2 = last ? nB : cB + (size_t)(t + 2) * kstep;
            const char* a3 = a2 + kstep; const char* b3 = b2 + kstep;
            if (last && has_next) S.a_ready(nxt);
            if constexpr (SP2) {
            PG8_LDB(B0, 0, 0); PG8_LDB(B1, 0, 1); PG8_SCHED; PG8_LDA(At, 0, 0); PG8_STAGE(PG8_SA(1, 1), a1 + hstepA, voffA);
            PG8_WAIT_V(8); PG8_WAIT_L(0); PG8_BAR; PG8_MMA(0, 0, At, B0); PG8_MMA(0, 1, At, B1); PG8_BAR; PG8_SCHED;
            PG8_LDA(At, 0, 1); PG8_STAGE(PG8_SB(0, 0), b2, voffB); PG8_STAGE(PG8_SB(0, 1), b2 + hstep, voffB); PG8_STAGE(PG8_SA(0, 0), a2, voffA);
            PG8_WAIT_V(8); PG8_WAIT_L(0); PG8_BAR; PG8_MMA(1, 0, At, B0); PG8_MMA(1, 1, At, B1); PG8_BAR; PG8_SCHED;
            PG8_LDB(B0, 1, 0); PG8_LDB(B1, 1, 1); PG8_SCHED; PG8_LDA(At, 1, 0); PG8_STAGE(PG8_SA(0, 1), a2 + hstepA, voffA);
            PG8_WAIT_V(8); PG8_WAIT_L(0); PG8_BAR; PG8_MMA(0, 0, At, B0); PG8_MMA(0, 1, At, B1); PG8_BAR; PG8_SCHED;
            PG8_LDA(At, 1, 1); PG8_STAGE(PG8_SB(1, 0), b3, voffB); PG8_STAGE(PG8_SB(1, 1), b3 + hstep, voffB); PG8_STAGE(PG8_SA(1, 0), a3, voffA);
            PG8_WAIT_V(8); PG8_WAIT_L(0); PG8_BAR; PG8_MMA(1, 0, At, B0); PG8_MMA(1, 1, At, B1); PG8_BAR; PG8_SCHED;
            } else {
            PG8_LDB(B0, 0, 0); PG8_SCHED; PG8_LDA(At, 0, 0); PG8_STAGE(PG8_SA(1, 1), a1 + hstepA, voffA);
            PG8_WAIT_L(8); PG8_BAR; PG8_WAIT_L(0); PG8_MMA(0, 0, At, B0); PG8_BAR; PG8_SCHED;
            PG8_LDB(B1, 0, 1); PG8_STAGE(PG8_SB(0, 0), b2, voffB);
            PG8_BAR; PG8_WAIT_L(0); PG8_MMA(0, 1, At, B1); PG8_BAR;
            PG8_LDA(At, 0, 1); PG8_STAGE(PG8_SA(0, 0), a2, voffA);
            PG8_BAR; PG8_WAIT_L(0); PG8_MMA(1, 0, At, B0); PG8_BAR; PG8_SCHED;
            PG8_STAGE(PG8_SB(0, 1), b2 + hstep, voffB);
            PG8_WAIT_V(6); PG8_BAR; PG8_MMA(1, 1, At, B1); PG8_BAR;
            PG8_LDB(B0, 1, 0); PG8_SCHED; PG8_LDA(At, 1, 0); PG8_STAGE(PG8_SA(0, 1), a2 + hstepA, voffA);
            PG8_WAIT_L(8); PG8_BAR; PG8_WAIT_L(0); PG8_MMA(0, 0, At, B0); PG8_BAR; PG8_SCHED;
            PG8_LDB(B1, 1, 1); PG8_STAGE(PG8_SB(1, 0), b3, voffB);
            PG8_BAR; PG8_WAIT_L(0); PG8_MMA(0, 1, At, B1); PG8_BAR;
            PG8_LDA(At, 1, 1); PG8_STAGE(PG8_SA(1, 0), a3, voffA);
            PG8_BAR; PG8_WAIT_L(0); PG8_MMA(1, 0, At, B0); PG8_BAR; PG8_SCHED;
            PG8_STAGE(PG8_SB(1, 1), b3 + hstep, voffB);
            PG8_WAIT_V(6); PG8_BAR; PG8_MMA(1, 1, At, B1); PG8_BAR;
            }
        }
        if constexpr (ALIGN_EPI) { if (wr == 0) PG8_BAR; }
        if constexpr (!Epi::AFTER_DRAIN) { E(acc, cur, wr, wc, fr, fq); S.done(cur); }
        if (!has_next) break;
#pragma unroll
        for (int a = 0; a < 2; ++a)
#pragma unroll
            for (int b = 0; b < 2; ++b)
#pragma unroll
                for (int m = 0; m < 4; ++m)
#pragma unroll
                    for (int n = 0; n < 2; ++n) acc[a][b][m][n] = (f32x4){0.f, 0.f, 0.f, 0.f};
        cur = nxt; cA = nA; cB = nB; ++ui;
        if constexpr (ALIGN_EPI) { if (wr == 1) PG8_BAR; }
    }
    PG8_WAIT_V(0);
    if constexpr (!ALIGN_EPI) { if (wr == 0) PG8_BAR; }
    PG8_BAR;
    if constexpr (Epi::AFTER_DRAIN) { E.fused(acc, cur, wr, wc, fr, fq, lds, wid, lane); S.done(cur); }
#undef PG8_SA
#undef PG8_SB
#undef PG8_STAGE
#undef PG8_LDA
#undef PG8_LDB
#undef PG8_MMA
#undef PG8_WAIT_V
#undef PG8_WAIT_L
#undef PG8_BAR
#undef PG8_SCHED
}
}

constexpr int NWAVES = 8;
constexpr int NB = 16, T = 2048, D = 2048, M = NB * T, DFF = 5632, NADA = 18432, EVW = 8208;
constexpr float EPS = 1e-6f;
#ifndef MK_PER_PHASE
#define MK_PER_PHASE 0
#endif
constexpr int NPHASE = 27;
#ifndef PROBE_GEMM_X2
#define PROBE_GEMM_X2 0
#endif
#ifndef PROBE_P0_X2
#define PROBE_P0_X2 0
#endif
#ifndef PROBE_NORM_X2
#define PROBE_NORM_X2 0
#endif
#ifndef PROBE_EW_X2
#define PROBE_EW_X2 0
#endif
#ifndef PROBE_ECHO_MASK
#define PROBE_ECHO_MASK 0u
#endif
#ifndef PROBE_POISON_PHASE
#define PROBE_POISON_PHASE (-1)
#endif
#ifndef FINAL_BAR
#define FINAL_BAR 1
#endif
#ifndef PROBE_ECHO_SLEEP
#define PROBE_ECHO_SLEEP 0
#endif
#ifndef PROBE_START_BUSY
#define PROBE_START_BUSY 0
#endif
#ifndef PROBE_PERM_BLOCKS
#define PROBE_PERM_BLOCKS 0
#endif
#ifndef PROBE_POISON_LDS
#define PROBE_POISON_LDS 0
#endif
#ifndef PROBE_POISON_VGPR
#define PROBE_POISON_VGPR 0
#endif
#ifndef PROBE_REC_X2
#define PROBE_REC_X2 0
#endif

constexpr size_t MiB = 1u << 20;
constexpr size_t WS_CTL = 0, CTL_ZERO_BYTES = 1 * MiB;
constexpr size_t WS_MODV = 1 * MiB;
constexpr size_t WS_ROPE = 4 * MiB;
constexpr size_t WS_BG = 6 * MiB;
constexpr size_t WS_WBA = 8 * MiB;
constexpr size_t WS_SP8 = 8 * MiB + 256 * 1024;
constexpr size_t WS_W13 = 16 * MiB;
constexpr size_t W13_BYTES = (size_t)2 * DFF * D * 2;
constexpr size_t WS_W2 = WS_W13 + 4 * W13_BYTES;
constexpr size_t W2_BYTES = (size_t)D * DFF * 2;
constexpr size_t WS_WEVIN = WS_W2 + 4 * W2_BYTES;
constexpr size_t WS_WEVOUT = WS_WEVIN + (size_t)8192 * D * 2;
constexpr size_t WS_WODIN = WS_WEVOUT + (size_t)D * D * 2;
constexpr size_t WS_WGATE = WS_WODIN + (size_t)4096 * D * 2;
constexpr size_t WS_WODOUT = WS_WGATE + (size_t)4096 * 256 * 2;
constexpr size_t WS_X = WS_WODOUT + (size_t)D * D * 2;
constexpr size_t WS_Y = WS_X + (size_t)M * D * 2;
constexpr size_t WS_BIG = WS_Y + (size_t)M * D * 2;
constexpr size_t WS_RG = WS_BIG + 256 * MiB;
constexpr size_t WS_EXT = WS_BIG + 512 * MiB;
constexpr size_t WS_END = WS_EXT + 192 * MiB;
static_assert(WS_W13 % (1u << 20) == 0 && WS_X == 346 * MiB && WS_END == 1306 * MiB, "d_ws map");
constexpr int CW_BAR = 4096;

constexpr int RING_BYTES = 131072;
constexpr int WAVE_LDS = 19712;
constexpr int ADA_ACC_OFF = 131072;
constexpr int LDSCTL_OFF = 157696, MISC_OFF = LDSCTL_OFF + 320;
constexpr int LDS_BYTES = 158720;
static_assert(MISC_OFF + 128 <= LDS_BYTES && 8 * WAVE_LDS <= LDSCTL_OFF, "LDS map");

#define GAS __attribute__((address_space(1)))
#define LAS __attribute__((address_space(3)))
typedef unsigned short bf16;
typedef unsigned v4u __attribute__((ext_vector_type(4)));
typedef unsigned v2u __attribute__((ext_vector_type(2)));
typedef float f32x4 __attribute__((ext_vector_type(4)));
typedef GAS unsigned gu32;
#define RLX_AGENT __ATOMIC_RELAXED, __HIP_MEMORY_SCOPE_AGENT
#define LDS_WAIT() asm volatile("s_waitcnt lgkmcnt(0)" ::: "memory")
#define VM_WAIT() asm volatile("s_waitcnt vmcnt(0)" ::: "memory")
using pg8::cvt_pk_bf16; using pg8::bfl; using pg8::bfh; using pg8::fast_sigmoid;

#define XB_TMO      128
#define XB_XCNT(j)  (256  + 64 * (j))
#define XB_XSUB(j)  (1280 + 64 * (j))
#define XB_XGEN(j)  (2304 + 64 * (j))
#define XB_TOP      3328
#define XB_TOPGEN   3392
#define XCD_BAR_WORDS 3456
#define XB_SPIN_CAP (1u << 18)

__device__ __forceinline__ unsigned xb_ld(unsigned* p)              { return __hip_atomic_load(p, __ATOMIC_RELAXED, __HIP_MEMORY_SCOPE_AGENT); }
__device__ __forceinline__ unsigned xb_add(unsigned* p, unsigned v) { return __hip_atomic_fetch_add(p, v, __ATOMIC_RELAXED, __HIP_MEMORY_SCOPE_AGENT); }
__device__ __forceinline__ unsigned xb_xcc_id() { return (unsigned)__builtin_amdgcn_s_getreg((3 << 11) | 20) & 0xFu; }
#define XB_SPIN(cond, bar) do { unsigned _sp = 0; while (cond) { __builtin_amdgcn_s_sleep(1); \
    if ((++_sp & 255u) == 0u) { if (xb_ld(&(bar)[XB_TMO])) break; if (_sp > XB_SPIN_CAP) { atomicAdd(&(bar)[XB_TMO], 1u); break; } } } } while (0)

struct XcdBarrier {
    unsigned* bar; unsigned x;
    volatile LAS unsigned* st;
};

__device__ __forceinline__ XcdBarrier xcd_barrier_post(unsigned* bar, volatile LAS unsigned* st) {
    XcdBarrier b; b.bar = bar; b.x = xb_xcc_id(); b.st = st;
    if (threadIdx.x == 0) (void)xb_add(&bar[XB_XCNT(b.x)], 1u);
    return b;
}
__device__ __forceinline__ void xcd_barrier_complete(unsigned* bar, unsigned x, unsigned& nloc, unsigned& nx) {
    const unsigned G = gridDim.x * gridDim.y * gridDim.z;
    unsigned sum, cnt, mine, sp = 0u;
    for (;;) {
        sum = 0u; cnt = 0u; mine = 0u;
#pragma unroll
        for (unsigned j = 0; j < 16; ++j) { const unsigned c = xb_ld(&bar[XB_XCNT(j)]); sum += c; cnt += (c > 0u) ? 1u : 0u; mine = (j == x) ? c : mine; }
        if (sum == G) break;
        __builtin_amdgcn_s_sleep(1);
        if ((++sp & 255u) == 0u) { if (xb_ld(&bar[XB_TMO])) break; if (sp > XB_SPIN_CAP) { atomicAdd(&bar[XB_TMO], 1u); break; } }
    }
    nloc = mine > 0u ? mine : 1u; nx = cnt > 0u ? cnt : 1u;
}

__device__ __forceinline__ void xcd_barrier(const XcdBarrier& b) {
    asm volatile("s_waitcnt vmcnt(0)" ::: "memory");
    __syncthreads();
    if (threadIdx.x == 0) {
        unsigned* bar = b.bar;
        __builtin_amdgcn_s_waitcnt(0);
        unsigned nloc = b.st[0], nx = b.st[1];
        if (nloc == 0u) { xcd_barrier_complete(bar, b.x, nloc, nx); b.st[0] = nloc; b.st[1] = nx; }
        const unsigned old = xb_add(&bar[XB_XSUB(b.x)], 1u);
        const unsigned gen = old / nloc;
        if (old + 1u == (gen + 1u) * nloc) {
            __builtin_amdgcn_fence(__ATOMIC_RELEASE, "agent");
            asm volatile("s_waitcnt vmcnt(0)" ::: "memory");
            const unsigned og = xb_add(&bar[XB_TOP], 1u);
            const unsigned tg = og / nx;
            if (og + 1u == (tg + 1u) * nx) xb_add(&bar[XB_TOPGEN], 1u);
            else XB_SPIN(xb_ld(&bar[XB_TOPGEN]) == tg, bar);
            __builtin_amdgcn_fence(__ATOMIC_ACQUIRE, "agent");
            xb_add(&bar[XB_XGEN(b.x)], 1u);
            asm volatile("s_waitcnt vmcnt(0)" ::: "memory");
        } else {
            XB_SPIN(xb_ld(&bar[XB_XGEN(b.x)]) == gen, bar);
            __builtin_amdgcn_fence(__ATOMIC_ACQUIRE, "agent");
            asm volatile("s_waitcnt vmcnt(0)" ::: "memory");
        }
    }
    __syncthreads();
}

struct Args { const float* in[24]; float* out; unsigned char* ws; int ph_lo, ph_hi; };
struct Frame {
    LAS unsigned char* lds; volatile LAS unsigned* MISC; gu32* ctl;
    int tid, lane, wave, vcu, G, bid;
};
__device__ __forceinline__ float wave_sum(float v) {
#pragma unroll
    for (int o = 1; o < 64; o <<= 1) v += __shfl_xor(v, o);
    return v;
}
__device__ __forceinline__ float silu_f(float x) { return x * fast_sigmoid(x); }
__device__ __forceinline__ void unpack8(const v4u w, float (&f)[8]) { f[0] = bfl(w.x); f[1] = bfh(w.x); f[2] = bfl(w.y); f[3] = bfh(w.y); f[4] = bfl(w.z); f[5] = bfh(w.z); f[6] = bfl(w.w); f[7] = bfh(w.w); }
__device__ __forceinline__ v4u pack8(const float (&f)[8]) { v4u w; w.x = cvt_pk_bf16(f[0], f[1]); w.y = cvt_pk_bf16(f[2], f[3]); w.z = cvt_pk_bf16(f[4], f[5]); w.w = cvt_pk_bf16(f[6], f[7]); return w; }

__device__ __forceinline__ void transpose_item(const float* W, int ldw, int k0, int n0, bf16* WT, int ldt, int drow0, LAS float* scr, int lane) {
#pragma unroll 8
    for (int i = 0; i < 32; ++i) { const int kk = 2 * i + (lane >> 5); scr[kk * 33 + (lane & 31)] = W[(size_t)(k0 + kk) * ldw + n0 + (lane & 31)]; }
    LDS_WAIT(); asm volatile("" ::: "memory");
    const int c = lane & 7;
#pragma unroll
    for (int j = 0; j < 4; ++j) { const int n = (lane >> 3) + 8 * j; const LAS float* s = scr + (8 * c) * 33 + n;
        v4u o; o.x = cvt_pk_bf16(s[0 * 33], s[1 * 33]); o.y = cvt_pk_bf16(s[2 * 33], s[3 * 33]); o.z = cvt_pk_bf16(s[4 * 33], s[5 * 33]); o.w = cvt_pk_bf16(s[6 * 33], s[7 * 33]);
        *(GAS v4u*)(WT + (size_t)(drow0 + n) * ldt + k0 + 8 * c) = o; }
    LDS_WAIT(); asm volatile("" ::: "memory");
}
__device__ __forceinline__ void p0_prologue(Frame& F, const Args& a) {
    unsigned char* ws = a.ws;
    {
        LAS float* sc = (LAS float*)F.lds;
        LAS float* accl = (LAS float*)(F.lds + ADA_ACC_OFF);
        const float* c = a.in[1];
        for (int idx = F.tid; idx < NB * D; idx += NWAVES * 64) { const int b = idx >> 11, k = idx & 2047; const float v = c[idx]; sc[k * 16 + b] = v / (1.0f + __expf(-v)); }
        __syncthreads();
        float* modv = (float*)(ws + WS_MODV);
        for (int u = F.bid; u < 2 * (NADA / 64); u += F.G) {
            const int layer = u / (NADA / 64), n0 = (u % (NADA / 64)) * 64;
            for (int e = F.tid; e < 1024; e += NWAVES * 64) accl[e] = 0.f;
            __syncthreads();
            const float* W = a.in[2] + (size_t)layer * D * NADA + n0 + F.lane;
            float acc[16];
#pragma unroll
            for (int b = 0; b < 16; ++b) acc[b] = 0.f;
            const int kbeg = F.wave * 256;
#pragma unroll 4
            for (int kk = 0; kk < 256; ++kk) { const int k = kbeg + kk; const float w = W[(size_t)k * NADA];
#pragma unroll
                for (int i = 0; i < 4; ++i) { const f32x4 s4 = *(const LAS f32x4*)(sc + k * 16 + 4 * i);
                    acc[4 * i + 0] += w * s4[0]; acc[4 * i + 1] += w * s4[1]; acc[4 * i + 2] += w * s4[2]; acc[4 * i + 3] += w * s4[3]; } }
            for (int w = 0; w < NWAVES; ++w) {
                if (F.wave == w) {
#pragma unroll
                    for (int b = 0; b < 16; ++b) accl[b * 64 + F.lane] += acc[b];
                }
                __syncthreads();
            }
            for (int e = F.tid; e < 1024; e += NWAVES * 64) { const int b = e >> 6, col = e & 63, n = n0 + col;
                const float v = accl[e] + a.in[3][layer * NADA + n];
                const int s = n / (3 * D), j = (n / D) % 3, d = n % D, q = layer * 3 + s;
                float o = v;
                if (j == 1) o = a.in[4][(size_t)q * D + d] * (1.0f + v);
                if (j == 2) o = (s == 1 ? 1.0f : 0.5f) * a.in[5][(size_t)q * D + d] * (1.0f + v);
                modv[((size_t)(q * 3 + j) * 16 + b) * D + d] = o; }
            __syncthreads();
        }
    }
    const int gw = F.vcu * NWAVES + F.wave, NGW = F.G * NWAVES;
    {
        LAS float* scr = (LAS float*)(F.lds + F.wave * 16384);
        constexpr int I13 = 32 * 352, I2 = 88 * 64, IEV = 32 * 256, IEO = 32 * 64, IOI = 32 * 128, IG = 16 * 32, IOO = 32 * 64;
        constexpr int NITEMS = 4 * I13 + 4 * I2 + IEV + IEO + IOI + IG + IOO;
        for (int it = gw; it < NITEMS; it += NGW) {
            int r = it;
            if (r < 4 * I13) { const int mat = r / I13; r -= mat * I13; const int kb = r / 352, nb = r % 352, n0 = 32 * nb;
                const int dr = n0 < DFF ? (n0 >> 7) * 256 + (n0 & 127) : ((n0 - DFF) >> 7) * 256 + 128 + ((n0 - DFF) & 127);
                transpose_item(a.in[6] + (size_t)mat * D * 2 * DFF, 2 * DFF, 64 * kb, n0, (bf16*)(ws + WS_W13 + mat * W13_BYTES), D, dr, scr, F.lane); continue; }
            r -= 4 * I13;
            if (r < 4 * I2) { const int mat = r / I2; r -= mat * I2; const int kb = r / 64, nb = r % 64;
                transpose_item(a.in[7] + (size_t)mat * DFF * D, D, 64 * kb, 32 * nb, (bf16*)(ws + WS_W2 + mat * W2_BYTES), DFF, 32 * nb, scr, F.lane); continue; }
            r -= 4 * I2;
            if (r < IEV) { const int kb = r / 256, nb = r % 256, d0 = 32 * nb, n0 = d0 + (d0 >= 3072 ? 16 : 0);
                transpose_item(a.in[8], EVW, 64 * kb, n0, (bf16*)(ws + WS_WEVIN), D, d0, scr, F.lane); continue; }
            r -= IEV;
            if (r < IEO) { const int kb = r / 64, nb = r % 64;
                transpose_item(a.in[14], D, 64 * kb, 32 * nb, (bf16*)(ws + WS_WEVOUT), D, 32 * nb, scr, F.lane); continue; }
            r -= IEO;
            if (r < IOI) { const int kb = r / 128, nb = r % 128;
                transpose_item(a.in[15], 2 * D, 64 * kb, 32 * nb, (bf16*)(ws + WS_WODIN), D, 32 * nb, scr, F.lane); continue; }
            r -= IOI;
            if (r < IG) { const int mat = r / 32; r -= mat * 32; const int gsel = mat >> 3, blk = mat & 7, kb = r / 8, nb = r % 8, j0 = 32 * nb;
                const int dr = (blk * 2 + (j0 >> 7)) * 256 + gsel * 128 + (j0 & 127);
                transpose_item((gsel ? a.in[20] : a.in[18]) + (size_t)blk * 65536, 256, 64 * kb, j0, (bf16*)(ws + WS_WGATE), 256, dr, scr, F.lane); continue; }
            r -= IG;
            { const int kb = r / 64, nb = r % 64;
                transpose_item(a.in[23], D, 64 * kb, 32 * nb, (bf16*)(ws + WS_WODOUT), D, 32 * nb, scr, F.lane); }
        }
    }
    const int gt = (F.vcu * NWAVES + F.wave) * 64 + F.lane, NGT = F.G * NWAVES * 64;
    { float* wba = (float*)(ws + WS_WBA);
      for (int i = gt; i < 16 * D; i += NGT) { const int o = i >> 11, k = i & 2047; wba[i] = a.in[8][(size_t)k * EVW + 3072 + o]; } }
    { float* sp8 = (float*)(ws + WS_SP8);
      for (int i = gt; i < D; i += NGT) sp8[i] = -8.0f * log1pf(expf(-a.in[22][i])); }
    { float* rc = (float*)(ws + WS_ROPE); float* rs = rc + T * 128;
      for (int i = gt; i < T * 128; i += NGT) { const int t = i >> 7, f = i & 127;
          const double ang = (double)t * pow(10000.0, -(double)f / 128.0); rc[i] = (float)cos(ang); rs[i] = (float)sin(ang); } }
}

template <bool DO_BA>
__device__ __forceinline__ void norm_pass(Frame& F, const Args& a, const int q) {
    unsigned char* ws = a.ws;
    const bool has_prev = q > 0, has_next = q < 6;
    const float* xin = a.in[0];
    bf16* Xb = (bf16*)(ws + WS_X);
    float* xout = a.out;
    const bf16* Y = (const bf16*)(ws + WS_Y); bf16* H = (bf16*)a.out;
    const float* modv = (const float*)(ws + WS_MODV);
    LAS float* wl = (LAS float*)F.lds;
    if (DO_BA) {
        const float* wba = (const float*)(ws + WS_WBA);
        for (int i = F.tid; i < 16 * D; i += NWAVES * 64) { const int o = i >> 11, col = i & 2047, j = col >> 9, l = (col >> 3) & 63, hf = (col >> 2) & 1, e = col & 3;
            wl[o * 2048 + j * 512 + hf * 256 + l * 4 + e] = wba[i]; }
        __syncthreads();
    }
    const int gw = F.vcu * NWAVES + F.wave, l = F.lane;
    for (int r = 0; r < 16; ++r) {
        const int m = gw * 16 + r, b = m >> 11;
        const size_t ro = (size_t)m * D + 8 * l;
        float x[4][8];
        if (q <= 1) {
#pragma unroll
            for (int j = 0; j < 4; ++j) { const f32x4 x0 = *(const f32x4*)(xin + ro + 512 * j), x1 = *(const f32x4*)(xin + ro + 512 * j + 4);
                x[j][0] = x0[0]; x[j][1] = x0[1]; x[j][2] = x0[2]; x[j][3] = x0[3]; x[j][4] = x1[0]; x[j][5] = x1[1]; x[j][6] = x1[2]; x[j][7] = x1[3]; }
        } else {
#pragma unroll
            for (int j = 0; j < 4; ++j) unpack8(*(const v4u*)(Xb + ro + 512 * j), x[j]);
        }
        if (has_prev) {
            float y[4][8]; float ss = 0.f;
#pragma unroll
            for (int j = 0; j < 4; ++j) { const v4u yw = *(const v4u*)(Y + ro + 512 * j); unpack8(yw, y[j]);
#pragma unroll
                for (int e = 0; e < 8; ++e) ss += y[j][e] * y[j][e]; }
            const float ry = 1.0f / sqrtf(wave_sum(ss) * (1.0f / D) + EPS);
            const float* al = modv + ((size_t)((q - 1) * 3 + 2) * 16 + b) * D + 8 * l;
#pragma unroll
            for (int j = 0; j < 4; ++j) { const f32x4 a0 = *(const f32x4*)(al + 512 * j), a1 = *(const f32x4*)(al + 512 * j + 4);
#pragma unroll
                for (int e = 0; e < 4; ++e) { x[j][e] += a0[e] * (y[j][e] * ry); x[j][4 + e] += a1[e] * (y[j][4 + e] * ry); }
                if (q == 6) { *(f32x4*)(xout + ro + 512 * j) = (f32x4){x[j][0], x[j][1], x[j][2], x[j][3]}; *(f32x4*)(xout + ro + 512 * j + 4) = (f32x4){x[j][4], x[j][5], x[j][6], x[j][7]}; }
                else { const v4u xw = pack8(x[j]); *(v4u*)(Xb + ro + 512 * j) = xw; unpack8(xw, x[j]); } }
        }
        if (has_next) {
            float ss = 0.f;
#pragma unroll
            for (int j = 0; j < 4; ++j)
#pragma unroll
                for (int e = 0; e < 8; ++e) ss += x[j][e] * x[j][e];
            const float rx = 1.0f / sqrtf(wave_sum(ss) * (1.0f / D) + EPS);
            const float* Bv = modv + ((size_t)(q * 3 + 1) * 16 + b) * D + 8 * l;
            const float* Cv = modv + ((size_t)(q * 3 + 0) * 16 + b) * D + 8 * l;
#pragma unroll
            for (int j = 0; j < 4; ++j) { const f32x4 b0 = *(const f32x4*)(Bv + 512 * j), b1 = *(const f32x4*)(Bv + 512 * j + 4), c0 = *(const f32x4*)(Cv + 512 * j), c1 = *(const f32x4*)(Cv + 512 * j + 4);
#pragma unroll
                for (int e = 0; e < 4; ++e) { x[j][e] = x[j][e] * rx * b0[e] + c0[e]; x[j][4 + e] = x[j][4 + e] * rx * b1[e] + c1[e]; }
                *(v4u*)(H + ro + 512 * j) = pack8(x[j]); }
            if (DO_BA) {
                float mine = 0.f;
#pragma unroll
                for (int o = 0; o < 16; ++o) { float p = 0.f;
#pragma unroll
                    for (int j = 0; j < 4; ++j) { const f32x4 w0 = *(const LAS f32x4*)(wl + o * 2048 + j * 512 + l * 4), w1 = *(const LAS f32x4*)(wl + o * 2048 + j * 512 + 256 + l * 4);
                        p += x[j][0] * w0[0] + x[j][1] * w0[1] + x[j][2] * w0[2] + x[j][3] * w0[3] + x[j][4] * w1[0] + x[j][5] * w1[1] + x[j][6] * w1[2] + x[j][7] * w1[3]; }
                    p = wave_sum(p); mine = (l == o) ? p : mine; }
                if (l < 16) { float v;
                    if (l < 8) v = 1.0f / (1.0f + expf(-mine));
                    else { const float z = mine + a.in[11][l - 8]; const float sp = z > 20.f ? z : log1pf(expf(z)); v = -expf(a.in[10][l - 8]) * sp; }
                    ((float*)(ws + WS_BG))[(size_t)m * 16 + l] = v; }
            }
        }
    }
}

template <int MODE>
__device__ __forceinline__ void conv_slab(const bf16* src, const size_t spitch, const int t0, const float* w, const int wpitch, const float* bias, bf16* dst, const size_t dpitch, const int l) {
    float wt[4][8];
#pragma unroll
    for (int tap = 0; tap < 4; ++tap) { const f32x4 w0 = *(const f32x4*)(w + tap * wpitch + 8 * l), w1 = *(const f32x4*)(w + tap * wpitch + 8 * l + 4);
        wt[tap][0] = w0[0]; wt[tap][1] = w0[1]; wt[tap][2] = w0[2]; wt[tap][3] = w0[3]; wt[tap][4] = w1[0]; wt[tap][5] = w1[1]; wt[tap][6] = w1[2]; wt[tap][7] = w1[3]; }
    float bs[8];
#pragma unroll
    for (int e = 0; e < 8; ++e) bs[e] = 0.f;
    if (MODE == 3) { const f32x4 b0 = *(const f32x4*)(bias + 8 * l), b1 = *(const f32x4*)(bias + 8 * l + 4);
        bs[0] = b0[0]; bs[1] = b0[1]; bs[2] = b0[2]; bs[3] = b0[3]; bs[4] = b1[0]; bs[5] = b1[1]; bs[6] = b1[2]; bs[7] = b1[3]; }
    float xm3[8], xm2[8], xm1[8];
#pragma unroll
    for (int e = 0; e < 8; ++e) { xm3[e] = 0.f; xm2[e] = 0.f; xm1[e] = 0.f; }
    if (t0 > 0) { unpack8(*(const v4u*)(src - 3 * spitch + 8 * l), xm3); unpack8(*(const v4u*)(src - 2 * spitch + 8 * l), xm2); unpack8(*(const v4u*)(src - spitch + 8 * l), xm1); }
    for (int r0 = 0; r0 < 64; r0 += 4) {
        v4u xw[4];
#pragma unroll
        for (int i = 0; i < 4; ++i) xw[i] = *(const v4u*)(src + (size_t)(r0 + i) * spitch + 8 * l);
#pragma unroll
        for (int i = 0; i < 4; ++i) {
            float x0[8], o[8]; unpack8(xw[i], x0);
#pragma unroll
            for (int e = 0; e < 8; ++e) o[e] = bs[e] + wt[0][e] * xm3[e] + wt[1][e] * xm2[e] + wt[2][e] * xm1[e] + wt[3][e] * x0[e];
#pragma unroll
            for (int e = 0; e < 8; ++e) { xm3[e] = xm2[e]; xm2[e] = xm1[e]; xm1[e] = x0[e]; }
            if (MODE <= 2) {
#pragma unroll
                for (int e = 0; e < 8; ++e) o[e] = silu_f(o[e]);
            }
            if (MODE <= 1) {
                float ss = 0.f;
#pragma unroll
                for (int e = 0; e < 8; ++e) ss += o[e] * o[e];
                ss += __shfl_xor(ss, 1); ss += __shfl_xor(ss, 2); ss += __shfl_xor(ss, 4); ss += __shfl_xor(ss, 8);
                float rn = 1.0f / sqrtf(ss + EPS);
                if (MODE == 0) rn *= 0.08838834764831845f;
#pragma unroll
                for (int e = 0; e < 8; ++e) o[e] *= rn;
            }
            *(v4u*)(dst + (size_t)(r0 + i) * dpitch + 8 * l) = pack8(o);
        }
    }
}
__device__ __forceinline__ void ev_prep(Frame& F, const Args& a) {
    unsigned char* ws = a.ws;
    bf16* P = (bf16*)(ws + WS_BIG); bf16* QKV = (bf16*)(ws + WS_EXT);
    const float* rc = (const float*)(ws + WS_ROPE); const float* rs = rc + T * 128;
    const int gw = F.vcu * NWAVES + F.wave, l = F.lane;
    for (int u = gw; u < 4096; u += 2048) {
        if (u < 3072) {
            const int rb = u / 6, g = u - rb * 6; const size_t m0 = (size_t)rb * 64; const int t0 = (int)(m0 & (T - 1));
            const bf16* src = P + m0 * 8192 + 512 * g; bf16* dst = QKV + m0 * 3072 + 512 * g; const float* w = a.in[9] + 512 * g;
            if (g < 2) conv_slab<0>(src, 8192, t0, w, 3072, nullptr, dst, 3072, l);
            else if (g < 4) conv_slab<1>(src, 8192, t0, w, 3072, nullptr, dst, 3072, l);
            else conv_slab<2>(src, 8192, t0, w, 3072, nullptr, dst, 3072, l);
        } else {
            const int v = u - 3072, rb = v >> 1, w = v & 1; const size_t m0 = (size_t)rb * 64; const int t0 = (int)(m0 & (T - 1));
            const int hh = l >> 4, i0 = (l & 15) * 8;
            const float lgam = log2f(1.0f - exp2f(-5.0f - (float)hh));
            for (int r0 = 0; r0 < 64; r0 += 2) {
                v4u xa[2], xb[2]; f32x4 cs0[2], cs1[2], sn0[2], sn1[2];
#pragma unroll
                for (int i = 0; i < 2; ++i) { const int t = t0 + r0 + i; bf16* base = P + (m0 + r0 + i) * 8192 + 4096 + 1024 * w + 256 * hh + i0;
                    xa[i] = *(const v4u*)base; xb[i] = *(const v4u*)(base + 128);
                    cs0[i] = *(const f32x4*)(rc + t * 128 + i0); cs1[i] = *(const f32x4*)(rc + t * 128 + i0 + 4); sn0[i] = *(const f32x4*)(rs + t * 128 + i0); sn1[i] = *(const f32x4*)(rs + t * 128 + i0 + 4); }
#pragma unroll
                for (int i = 0; i < 2; ++i) { const int t = t0 + r0 + i; bf16* base = P + (m0 + r0 + i) * 8192 + 4096 + 1024 * w + 256 * hh + i0;
                    const float scl = w ? 0.0625f * exp2f((float)(63 - (t & 63)) * lgam) : 1.0f;
                    const float cs[8] = {cs0[i][0], cs0[i][1], cs0[i][2], cs0[i][3], cs1[i][0], cs1[i][1], cs1[i][2], cs1[i][3]};
                    const float sn[8] = {sn0[i][0], sn0[i][1], sn0[i][2], sn0[i][3], sn1[i][0], sn1[i][1], sn1[i][2], sn1[i][3]};
                    float x1[8], x2[8], o1[8], o2[8]; unpack8(xa[i], x1); unpack8(xb[i], x2);
#pragma unroll
                    for (int e = 0; e < 8; ++e) { o1[e] = (x1[e] * cs[e] - x2[e] * sn[e]) * scl; o2[e] = (x2[e] * cs[e] + x1[e] * sn[e]) * scl; }
                    *(v4u*)base = pack8(o1); *(v4u*)(base + 128) = pack8(o2); }
            }
        }
    }
}

typedef short bf16x8 __attribute__((ext_vector_type(8)));
typedef short s16x4 __attribute__((ext_vector_type(4)));
typedef short v4i16_t __attribute__((ext_vector_type(4)));
__device__ __forceinline__ f32x4 mfma16(bf16x8 a, bf16x8 b, f32x4 c) { return __builtin_amdgcn_mfma_f32_16x16x32_bf16(a, b, c, 0, 0, 0); }
__device__ __forceinline__ bf16x8 mkfrag(const f32x4 x0, const f32x4 x1) {
    v4u w; w.x = cvt_pk_bf16(x0[0], x0[1]); w.y = cvt_pk_bf16(x0[2], x0[3]); w.z = cvt_pk_bf16(x1[0], x1[1]); w.w = cvt_pk_bf16(x1[2], x1[3]);
    return __builtin_bit_cast(bf16x8, w);
}
__device__ __forceinline__ bf16x8 join64(const v2u lo, const v2u hi) { v4u w; w.x = lo.x; w.y = lo.y; w.z = hi.x; w.w = hi.y; return __builtin_bit_cast(bf16x8, w); }
__device__ __forceinline__ bf16x8 frag_pi(const LAS unsigned char* rowp, int k0, int kq) {
    return join64(*(const LAS v2u*)(rowp + (k0 + 4 * kq) * 2), *(const LAS v2u*)(rowp + (k0 + 16 + 4 * kq) * 2));
}
__device__ __forceinline__ v2u tr_read(const LAS unsigned char* p) {
    return __builtin_bit_cast(v2u, __builtin_amdgcn_ds_read_tr16_b64_v4i16((LAS v4i16_t*)p));
}
constexpr size_t PW_GT = 0, PW_GQK = 32 * MiB, PW_GVEC = 64 * MiB, PW_RQK = 72 * MiB;

__device__ __forceinline__ void ev_chunk_prep(Frame& F, const Args& a) {
    unsigned char* ws = a.ws;
    const bf16* P = (const bf16*)(ws + WS_BIG); const bf16* QKV = (const bf16*)(ws + WS_EXT); const float* BG = (const float*)(ws + WS_BG);
    const int l = F.lane, c = l & 15, rq = l >> 4;
    const int gw = F.vcu * NWAVES + F.wave;
    LAS float* Al = (LAS float*)(F.lds + F.wave * WAVE_LDS);
    for (int jg = gw; jg < 4096; jg += 2048) {
        const int bh = jg >> 5, n = jg & 31, b = bh >> 3, h = bh & 7;
        const size_t m0 = (size_t)b * T + 64 * n;
        const float beta = BG[(m0 + l) * 16 + h], g = BG[(m0 + l) * 16 + 8 + h];
        float G = g;
#pragma unroll
        for (int o = 1; o < 64; o <<= 1) { const float t = __shfl_up(G, o); if (l >= o) G += t; }
        const float Glast = __shfl(G, 63);
        { float* vec = (float*)((unsigned char*)a.out + PW_GVEC) + (size_t)jg * 256;
          vec[l] = beta; vec[64 + l] = __expf(G); vec[128 + l] = __expf(Glast - G); vec[192 + l] = __expf(Glast); }
        f32x4 kk[4][4], qk[4][4];
#pragma unroll
        for (int ib = 0; ib < 4; ++ib)
#pragma unroll
            for (int jb = 0; jb < 4; ++jb) { kk[ib][jb] = (f32x4){0.f, 0.f, 0.f, 0.f}; qk[ib][jb] = (f32x4){0.f, 0.f, 0.f, 0.f}; }
#pragma unroll
        for (int s = 0; s < 4; ++s) {
            bf16x8 kf[4], qf[4];
#pragma unroll
            for (int ib = 0; ib < 4; ++ib) { const bf16* rp = QKV + (m0 + 16 * ib + c) * 3072 + 128 * h + 32 * s + 8 * rq;
                qf[ib] = *(const bf16x8*)rp; kf[ib] = *(const bf16x8*)(rp + 1024); }
#pragma unroll
            for (int ib = 0; ib < 4; ++ib)
#pragma unroll
                for (int jb = 0; jb <= ib; ++jb) { kk[ib][jb] = mfma16(kf[ib], kf[jb], kk[ib][jb]); qk[ib][jb] = mfma16(qf[ib], kf[jb], qk[ib][jb]); }
        }
        float Gj[4];
#pragma unroll
        for (int jb = 0; jb < 4; ++jb) Gj[jb] = __shfl(G, 16 * jb + c);
        bf16* qko = (bf16*)((unsigned char*)a.out + PW_GQK) + (size_t)jg * 4096;
        LAS float* Alq = Al + (4 * rq) * 68 + c;
#pragma unroll
        for (int ib = 0; ib < 4; ++ib)
#pragma unroll
            for (int e = 0; e < 4; ++e) { const int i = 16 * ib + 4 * rq + e; const float Gi = __shfl(G, i);
#pragma unroll
                for (int jb = 0; jb < 4; ++jb) { const int j = 16 * jb + c; float qv = 0.f;
                    if (jb <= ib) qv = (i >= j) ? qk[ib][jb][e] * __expf(Gi - Gj[jb]) : 0.f;
                    Alq[(16 * ib + e) * 68 + 16 * jb] = qv; } }
#pragma unroll 4
        for (int i = 0; i < 64; ++i) qko[i * 64 + l] = (bf16)(cvt_pk_bf16(Al[i * 68 + l], 0.f) & 0xffffu);
#pragma unroll
        for (int ib = 0; ib < 4; ++ib)
#pragma unroll
            for (int e = 0; e < 4; ++e) { const int i = 16 * ib + 4 * rq + e; const float Gi = __shfl(G, i), bi = __shfl(beta, i);
#pragma unroll
                for (int jb = 0; jb < 4; ++jb) { const int j = 16 * jb + c; float av = 0.f;
                    if (jb <= ib) av = (i > j) ? bi * kk[ib][jb][e] * __expf(Gi - Gj[jb]) : 0.f;
                    Alq[(16 * ib + e) * 68 + 16 * jb] = av; } }
        for (int i = 0; i < 64; ++i) {
            float acc0 = (l == i) ? 1.f : 0.f, acc1 = 0.f;
            const int nj = (i + 3) >> 2;
            for (int jj = 0; jj < nj; ++jj) { const f32x4 a4 = *(const LAS f32x4*)(Al + i * 68 + 4 * jj);
                const float t0 = Al[(4 * jj) * 68 + l], t1 = Al[(4 * jj + 1) * 68 + l], t2 = Al[(4 * jj + 2) * 68 + l], t3 = Al[(4 * jj + 3) * 68 + l];
                acc0 = fmaf(-a4[0], t0, acc0); acc1 = fmaf(-a4[1], t1, acc1); acc0 = fmaf(-a4[2], t2, acc0); acc1 = fmaf(-a4[3], t3, acc1); }
            Al[i * 68 + l] = acc0 + acc1;
        }
        bf16* to = (bf16*)((unsigned char*)a.out + PW_GT) + (size_t)jg * 4096;
#pragma unroll 4
        for (int i = 0; i < 64; ++i) to[i * 64 + l] = (bf16)(cvt_pk_bf16(Al[i * 68 + l], 0.f) & 0xffffu);
    }
    {
        const int jr = gw, bhr = jr >> 5, n = jr & 31, b = bhr >> 2, hr = bhr & 3;
        const size_t m0 = (size_t)b * T + 64 * n;
        const float lg = log2f(1.0f - exp2f(-5.0f - (float)hr));
        f32x4 qk[4][4];
#pragma unroll
        for (int ib = 0; ib < 4; ++ib)
#pragma unroll
            for (int jb = 0; jb < 4; ++jb) qk[ib][jb] = (f32x4){0.f, 0.f, 0.f, 0.f};
        for (int s = 0; s < 8; ++s) {
            bf16x8 kf[4], qf[4];
#pragma unroll
            for (int ib = 0; ib < 4; ++ib) { const bf16* rp = P + (m0 + 16 * ib + c) * 8192 + 4096 + 256 * hr + 32 * s + 8 * rq;
                qf[ib] = *(const bf16x8*)rp; kf[ib] = *(const bf16x8*)(rp + 1024); }
#pragma unroll
            for (int ib = 0; ib < 4; ++ib)
#pragma unroll
                for (int jb = 0; jb <= ib; ++jb) qk[ib][jb] = mfma16(qf[ib], kf[jb], qk[ib][jb]);
        }
        bf16* qko = (bf16*)((unsigned char*)a.out + PW_RQK) + (size_t)jr * 4096;
        LAS float* Alq = Al + (4 * rq) * 68 + c;
#pragma unroll
        for (int ib = 0; ib < 4; ++ib)
#pragma unroll
            for (int e = 0; e < 4; ++e) { const int i = 16 * ib + 4 * rq + e; const float rs = exp2f((float)(i - 63) * lg);
#pragma unroll
                for (int jb = 0; jb < 4; ++jb) { const int j = 16 * jb + c; float qv = 0.f;
                    if (jb <= ib) qv = (i >= j) ? qk[ib][jb][e] * rs : 0.f;
                    Alq[(16 * ib + e) * 68 + 16 * jb] = qv; } }
#pragma unroll 4
        for (int i = 0; i < 64; ++i) qko[i * 64 + l] = (bf16)(cvt_pk_bf16(Al[i * 68 + l], 0.f) & 0xffffu);
    }
}
__device__ __forceinline__ void ev_chunk_scan(Frame& F, const Args& a) {
    unsigned char* ws = a.ws;
    const bf16* P = (const bf16*)(ws + WS_BIG); const bf16* QKV = (const bf16*)(ws + WS_EXT);
    bf16* O = (bf16*)(ws + WS_Y);
    const int l = F.lane, c = l & 15, rq = l >> 4, tid = F.tid, vs = F.wave;
    LAS unsigned char* L = F.lds;
    const f32x4 z4 = (f32x4){0.f, 0.f, 0.f, 0.f};
    if (F.bid < 128) {
        const int bh = F.bid, b = bh >> 3, h = bh & 7;
        constexpr int KL = 0, QL = 17408, VL = 34816, TL = 52224, QKL = 61440, VECL = 70656;
        f32x4 Sb[8];
#pragma unroll
        for (int kb = 0; kb < 8; ++kb) Sb[kb] = z4;
        v4u pk[2], pq[2], pv[2], pt, pqk, pvec;
#define GS_ISSUE(n) do { const size_t m0_ = (size_t)b * T + 64 * (n); const size_t job_ = (size_t)bh * 32 + (n); \
        _Pragma("unroll") for (int i = 0; i < 2; ++i) { const int ci = tid + 512 * i, row = ci >> 4, c16 = ci & 15; const bf16* sp = QKV + (m0_ + row) * 3072 + 128 * h + 8 * c16; \
            pq[i] = *(const v4u*)sp; pk[i] = *(const v4u*)(sp + 1024); pv[i] = *(const v4u*)(sp + 2048); } \
        pt = *(const v4u*)((const bf16*)((unsigned char*)a.out + PW_GT) + job_ * 4096 + tid * 8); pqk = *(const v4u*)((const bf16*)((unsigned char*)a.out + PW_GQK) + job_ * 4096 + tid * 8); \
        pvec = *(const v4u*)((const float*)((unsigned char*)a.out + PW_GVEC) + job_ * 256 + 4 * (tid & 63)); } while (0)
        GS_ISSUE(0);
        for (int n = 0; n < 32; ++n) {
            __syncthreads();
#pragma unroll
            for (int i = 0; i < 2; ++i) { const int ci = tid + 512 * i, row = ci >> 4, c16 = ci & 15;
                *(LAS v4u*)(L + KL + row * 272 + c16 * 16) = pk[i]; *(LAS v4u*)(L + QL + row * 272 + c16 * 16) = pq[i]; *(LAS v4u*)(L + VL + row * 272 + c16 * 16) = pv[i]; }
            *(LAS v4u*)(L + TL + (tid >> 3) * 144 + (tid & 7) * 16) = pt; *(LAS v4u*)(L + QKL + (tid >> 3) * 144 + (tid & 7) * 16) = pqk;
            if (tid < 64) *(LAS v4u*)(L + VECL + tid * 16) = pvec;
            __syncthreads();
            if (n + 1 < 32) GS_ISSUE(n + 1);
            const size_t m0 = (size_t)b * T + 64 * n;
            bf16x8 Sf[4];
#pragma unroll
            for (int s = 0; s < 4; ++s) Sf[s] = mkfrag(Sb[2 * s], Sb[2 * s + 1]);
            f32x4 KS[4], QS[4];
#pragma unroll
            for (int tb = 0; tb < 4; ++tb) { KS[tb] = z4; QS[tb] = z4;
                const LAS unsigned char* kr = L + KL + (16 * tb + c) * 272; const LAS unsigned char* qr = L + QL + (16 * tb + c) * 272;
#pragma unroll
                for (int s = 0; s < 4; ++s) { KS[tb] = mfma16(frag_pi(kr, 32 * s, rq), Sf[s], KS[tb]); QS[tb] = mfma16(frag_pi(qr, 32 * s, rq), Sf[s], QS[tb]); }
                __builtin_amdgcn_sched_barrier(0); }
            f32x4 R[4], eG[4], c3[4];
#pragma unroll
            for (int tb = 0; tb < 4; ++tb) {
                const v2u vw = tr_read(L + VL + (16 * tb + 4 * rq + (c >> 2)) * 272 + 32 * vs + 8 * (c & 3));
                const f32x4 be = *(const LAS f32x4*)(L + VECL + (16 * tb + 4 * rq) * 4);
                eG[tb] = *(const LAS f32x4*)(L + VECL + 256 + (16 * tb + 4 * rq) * 4); c3[tb] = *(const LAS f32x4*)(L + VECL + 512 + (16 * tb + 4 * rq) * 4);
                const float v0 = bfl(vw.x), v1 = bfh(vw.x), v2 = bfl(vw.y), v3 = bfh(vw.y);
                R[tb] = (f32x4){be[0] * (v0 - eG[tb][0] * KS[tb][0]), be[1] * (v1 - eG[tb][1] * KS[tb][1]), be[2] * (v2 - eG[tb][2] * KS[tb][2]), be[3] * (v3 - eG[tb][3] * KS[tb][3])};
            }
            const float dd = *(const LAS float*)(L + VECL + 768);
            bf16x8 Rf[2]; Rf[0] = mkfrag(R[0], R[1]); Rf[1] = mkfrag(R[2], R[3]);
            f32x4 Vn[4];
#pragma unroll
            for (int tb = 0; tb < 4; ++tb) { Vn[tb] = z4; const LAS unsigned char* tr = L + TL + (16 * tb + c) * 144;
#pragma unroll
                for (int s2 = 0; s2 <= (tb >> 1); ++s2) Vn[tb] = mfma16(frag_pi(tr, 32 * s2, rq), Rf[s2], Vn[tb]); }
            bf16x8 Vf[2], Wf[2];
            Vf[0] = mkfrag(Vn[0], Vn[1]); Vf[1] = mkfrag(Vn[2], Vn[3]);
            Wf[0] = mkfrag(Vn[0] * c3[0], Vn[1] * c3[1]); Wf[1] = mkfrag(Vn[2] * c3[2], Vn[3] * c3[3]);
#pragma unroll
            for (int tb = 0; tb < 4; ++tb) { f32x4 o2 = z4; const LAS unsigned char* qkr = L + QKL + (16 * tb + c) * 144;
#pragma unroll
                for (int s2 = 0; s2 <= (tb >> 1); ++s2) o2 = mfma16(frag_pi(qkr, 32 * s2, rq), Vf[s2], o2);
#pragma unroll
                for (int e = 0; e < 4; ++e) O[(m0 + 16 * tb + 4 * rq + e) * D + 128 * h + 16 * vs + c] = (bf16)(cvt_pk_bf16(eG[tb][e] * QS[tb][e] + o2[e], 0.f) & 0xffffu); }
#pragma unroll
            for (int kb = 0; kb < 8; ++kb) { f32x4 acc = Sb[kb] * dd;
#pragma unroll
                for (int s2 = 0; s2 < 2; ++s2) {
                    const v2u p0 = tr_read(L + KL + (32 * s2 + 4 * rq + (c >> 2)) * 272 + 32 * kb + 8 * (c & 3));
                    const v2u p1 = tr_read(L + KL + (32 * s2 + 16 + 4 * rq + (c >> 2)) * 272 + 32 * kb + 8 * (c & 3));
                    acc = mfma16(join64(p0, p1), Wf[s2], acc); }
                Sb[kb] = acc; if (kb & 1) __builtin_amdgcn_sched_barrier(0); }
        }
#undef GS_ISSUE
    } else {
        const int u = F.bid - 128, bhr = u >> 1, half = u & 1, b = bhr >> 2, hr = bhr & 3;
        constexpr int QL = 0, KL = 33792, VL = 67584, QKL = 84992;
        const float lg = log2f(1.0f - exp2f(-5.0f - (float)hr)), dd = exp2f(64.0f * lg);
        f32x4 Sb[16];
#pragma unroll
        for (int kb = 0; kb < 16; ++kb) Sb[kb] = z4;
        v4u pq[4], pk[4], pv[2], pqk;
#define RS_ISSUE(n) do { const size_t m0_ = (size_t)b * T + 64 * (n); const size_t job_ = (size_t)bhr * 32 + (n); \
        _Pragma("unroll") for (int i = 0; i < 4; ++i) { const int ci = tid + 512 * i, row = ci >> 5, c16 = ci & 31; const bf16* sp = P + (m0_ + row) * 8192 + 4096 + 256 * hr + 8 * c16; \
            pq[i] = *(const v4u*)sp; pk[i] = *(const v4u*)(sp + 1024); } \
        _Pragma("unroll") for (int i = 0; i < 2; ++i) { const int ci = tid + 512 * i, row = ci >> 4, c16 = ci & 15; pv[i] = *(const v4u*)(P + (m0_ + row) * 8192 + 6144 + 256 * hr + 128 * half + 8 * c16); } \
        pqk = *(const v4u*)((const bf16*)((unsigned char*)a.out + PW_RQK) + job_ * 4096 + tid * 8); } while (0)
        RS_ISSUE(0);
        for (int n = 0; n < 32; ++n) {
            __syncthreads();
#pragma unroll
            for (int i = 0; i < 4; ++i) { const int ci = tid + 512 * i, row = ci >> 5, c16 = ci & 31;
                *(LAS v4u*)(L + QL + row * 528 + c16 * 16) = pq[i]; *(LAS v4u*)(L + KL + row * 528 + c16 * 16) = pk[i]; }
#pragma unroll
            for (int i = 0; i < 2; ++i) { const int ci = tid + 512 * i, row = ci >> 4, c16 = ci & 15; *(LAS v4u*)(L + VL + row * 272 + c16 * 16) = pv[i]; }
            *(LAS v4u*)(L + QKL + (tid >> 3) * 144 + (tid & 7) * 16) = pqk;
            __syncthreads();
            if (n + 1 < 32) RS_ISSUE(n + 1);
            const size_t m0 = (size_t)b * T + 64 * n;
            f32x4 QS[4];
#pragma unroll
            for (int tb = 0; tb < 4; ++tb) QS[tb] = z4;
#pragma unroll
            for (int s = 0; s < 8; ++s) { const bf16x8 sf = mkfrag(Sb[2 * s], Sb[2 * s + 1]);
#pragma unroll
                for (int tb = 0; tb < 4; ++tb) QS[tb] = mfma16(frag_pi(L + QL + (16 * tb + c) * 528, 32 * s, rq), sf, QS[tb]);
                __builtin_amdgcn_sched_barrier(0); }
            bf16x8 Vf[2];
#pragma unroll
            for (int s2 = 0; s2 < 2; ++s2) {
                const v2u p0 = tr_read(L + VL + (32 * s2 + 8 * rq + (c >> 2)) * 272 + 32 * vs + 8 * (c & 3));
                const v2u p1 = tr_read(L + VL + (32 * s2 + 8 * rq + 4 + (c >> 2)) * 272 + 32 * vs + 8 * (c & 3));
                Vf[s2] = join64(p0, p1); }
#pragma unroll
            for (int tb = 0; tb < 4; ++tb) { f32x4 o2 = z4;
#pragma unroll
                for (int s2 = 0; s2 <= (tb >> 1); ++s2) o2 = mfma16(*(const LAS bf16x8*)(L + QKL + (16 * tb + c) * 144 + (32 * s2 + 8 * rq) * 2), Vf[s2], o2);
#pragma unroll
                for (int e = 0; e < 4; ++e) { const int i = 16 * tb + 4 * rq + e;
                    O[(m0 + i) * D + 1024 + 256 * hr + 128 * half + 16 * vs + c] = (bf16)(cvt_pk_bf16(exp2f((float)(i + 1) * lg) * QS[tb][e] + o2[e], 0.f) & 0xffffu); } }
#pragma unroll
            for (int kb = 0; kb < 16; ++kb) { f32x4 acc = Sb[kb] * dd;
#pragma unroll
                for (int s2 = 0; s2 < 2; ++s2) {
                    const v2u p0 = tr_read(L + KL + (32 * s2 + 8 * rq + (c >> 2)) * 528 + 32 * kb + 8 * (c & 3));
                    const v2u p1 = tr_read(L + KL + (32 * s2 + 8 * rq + 4 + (c >> 2)) * 528 + 32 * kb + 8 * (c & 3));
                    acc = mfma16(join64(p0, p1), Vf[s2], acc); }
                Sb[kb] = acc; if (kb & 1) __builtin_amdgcn_sched_barrier(0); }
        }
#undef RS_ISSUE
    }
    __syncthreads();
}

__device__ __forceinline__ void ev_post(Frame& F, const Args& a) {
    unsigned char* ws = a.ws;
    const bf16* P = (const bf16*)(ws + WS_BIG); const bf16* O = (const bf16*)(ws + WS_Y); bf16* OM = (bf16*)a.out;
    const int gw = F.vcu * NWAVES + F.wave, l = F.lane;
    for (int r = 0; r < 16; ++r) {
        const int m = gw * 16 + r;
#pragma unroll
        for (int j = 0; j < 4; ++j) {
            const int c0 = 512 * j + 8 * l;
            float o[8], z[8]; unpack8(*(const v4u*)(O + (size_t)m * D + c0), o);
            float ss = 0.f;
#pragma unroll
            for (int e = 0; e < 8; ++e) ss += o[e] * o[e];
            ss += __shfl_xor(ss, 1); ss += __shfl_xor(ss, 2); ss += __shfl_xor(ss, 4); ss += __shfl_xor(ss, 8);
            float rn; const float* gn;
            if (j < 2) { rn = 1.0f / sqrtf(ss * (1.0f / 128.0f) + EPS); gn = a.in[12] + (c0 & 127); unpack8(*(const v4u*)(P + (size_t)m * 8192 + 3072 + c0), z); }
            else { ss += __shfl_xor(ss, 16); rn = 1.0f / sqrtf(ss * (1.0f / 256.0f) + EPS); gn = a.in[13] + (c0 - 1024); unpack8(*(const v4u*)(P + (size_t)m * 8192 + 7168 + (c0 - 1024)), z); }
            const f32x4 g0 = *(const f32x4*)gn, g1 = *(const f32x4*)(gn + 4);
            const float gg[8] = {g0[0], g0[1], g0[2], g0[3], g1[0], g1[1], g1[2], g1[3]};
#pragma unroll
            for (int e = 0; e < 8; ++e) o[e] = o[e] * rn * gg[e] * silu_f(z[e]);
            *(v4u*)(OM + (size_t)m * D + c0) = pack8(o);
        }
    }
}

__device__ __forceinline__ void od_conv(Frame& F, const Args& a) {
    unsigned char* ws = a.ws;
    const bf16* P1 = (const bf16*)(ws + WS_BIG); bf16* XC = (bf16*)a.out;
    const int gw = F.vcu * NWAVES + F.wave, l = F.lane;
    const int rb = gw >> 2, j = gw & 3; const size_t m0 = (size_t)rb * 64; const int t0 = (int)(m0 & (T - 1));
    conv_slab<3>(P1 + m0 * 4096 + 2048 + 512 * j, 4096, t0, a.in[16] + 512 * j, 2048, a.in[17] + 512 * j, XC + m0 * D + 512 * j, D, l);
}
__device__ __forceinline__ float gelu_tanh(float y) {
    const float u = 0.7978845608028654f * (y + 0.044715f * y * y * y);
    const float th = 1.0f - 2.0f * __builtin_amdgcn_rcpf(__expf(2.0f * u) + 1.0f);
    return 0.5f * y * (1.0f + th);
}
__device__ __forceinline__ void od_scan(Frame& F, const Args& a) {
    unsigned char* ws = a.ws;
    const bf16* P1 = (const bf16*)(ws + WS_BIG); const bf16* RG = (const bf16*)(ws + WS_RG); const bf16* INP = (const bf16*)(ws + WS_EXT); bf16* HSY = (bf16*)a.out; const float* sp8 = (const float*)(ws + WS_SP8);
    typedef float f32x2 __attribute__((ext_vector_type(2)));
    LAS f32x4* seg = (LAS f32x4*)F.lds;
    const int b = F.bid >> 4, c = (F.bid & 15) * 128 + 2 * F.lane;
    const size_t m0 = (size_t)b * T + (size_t)F.wave * 256;
    const f32x2 spc = *(const f32x2*)(sp8 + c);
    float A0 = 1.f, A1 = 1.f, h0 = 0.f, h1 = 0.f;
    for (int t0 = 0; t0 < 256; t0 += 16) {
        unsigned rv[16], iv[16];
#pragma unroll
        for (int i = 0; i < 16; ++i) { const size_t m = m0 + t0 + i; rv[i] = *(const unsigned*)(RG + m * D + c); iv[i] = *(const unsigned*)(INP + m * D + c); }
#pragma unroll
        for (int i = 0; i < 16; ++i) { const float a0 = __expf(spc[0] * bfl(rv[i])), a1 = __expf(spc[1] * bfh(rv[i]));
            h0 = fmaf(a0, h0, bfl(iv[i])); h1 = fmaf(a1, h1, bfh(iv[i])); A0 *= a0; A1 *= a1; }
    }
    seg[F.wave * 64 + F.lane] = (f32x4){A0, h0, A1, h1};
    __syncthreads();
    h0 = 0.f; h1 = 0.f;
    for (int s = 0; s < F.wave; ++s) { const f32x4 g = seg[s * 64 + F.lane]; h0 = fmaf(g[0], h0, g[1]); h1 = fmaf(g[2], h1, g[3]); }
    for (int t0 = 0; t0 < 256; t0 += 16) {
        unsigned rv[16], iv[16], yv[16];
#pragma unroll
        for (int i = 0; i < 16; ++i) { const size_t m = m0 + t0 + i; rv[i] = *(const unsigned*)(RG + m * D + c); iv[i] = *(const unsigned*)(INP + m * D + c); yv[i] = *(const unsigned*)(P1 + m * 4096 + c); }
#pragma unroll
        for (int i = 0; i < 16; ++i) { const size_t m = m0 + t0 + i; h0 = fmaf(__expf(spc[0] * bfl(rv[i])), h0, bfl(iv[i])); h1 = fmaf(__expf(spc[1] * bfh(rv[i])), h1, bfh(iv[i]));
            *(unsigned*)(HSY + m * D + c) = cvt_pk_bf16(h0 * gelu_tanh(bfl(yv[i])), h1 * gelu_tanh(bfh(yv[i]))); }
    }
    __syncthreads();
}

__device__ __forceinline__ void poison_state(LAS unsigned char* lds) {
    const unsigned seed = ((((unsigned)__builtin_amdgcn_s_memrealtime() * 2654435761u) ^ ((unsigned)threadIdx.x * 40503u)) & 0x007fffffu) | 0x3f000000u;
    __syncthreads();
#if PROBE_POISON_LDS
    for (int u = threadIdx.x; u < LDSCTL_OFF / 4; u += NWAVES * 64) ((LAS unsigned*)lds)[u] = seed ^ (unsigned)u;
#else
    { const unsigned long long t0 = __builtin_amdgcn_s_memrealtime(); while (__builtin_amdgcn_s_memrealtime() - t0 < 300ull + (seed & 255u)) __builtin_amdgcn_s_sleep(2); }
#endif
    __syncthreads();
#if PROBE_POISON_VGPR
    asm volatile("v_mov_b32 v1, %0\n\tv_mov_b32 v2, %0\n\tv_mov_b32 v3, %0\n\tv_mov_b32 v4, %0\n\tv_mov_b32 v5, %0\n\tv_mov_b32 v6, %0\n\tv_mov_b32 v7, %0\n\tv_mov_b32 v8, %0\n\tv_mov_b32 v9, %0\n\tv_mov_b32 v10, %0\n\tv_mov_b32 v11, %0\n\tv_mov_b32 v12, %0\n\tv_mov_b32 v13, %0\n\tv_mov_b32 v14, %0\n\tv_mov_b32 v15, %0\n\tv_mov_b32 v16, %0\n\tv_mov_b32 v17, %0\n\tv_mov_b32 v18, %0\n\tv_mov_b32 v19, %0\n\tv_mov_b32 v20, %0\n\tv_mov_b32 v21, %0\n\tv_mov_b32 v22, %0\n\tv_mov_b32 v23, %0\n\tv_mov_b32 v24, %0\n\tv_mov_b32 v25, %0\n\tv_mov_b32 v26, %0\n\tv_mov_b32 v27, %0\n\tv_mov_b32 v28, %0\n\tv_mov_b32 v29, %0\n\tv_mov_b32 v30, %0\n\tv_mov_b32 v31, %0\n\tv_mov_b32 v32, %0\n\tv_mov_b32 v33, %0\n\tv_mov_b32 v34, %0\n\tv_mov_b32 v35, %0\n\tv_mov_b32 v36, %0\n\tv_mov_b32 v37, %0\n\tv_mov_b32 v38, %0\n\tv_mov_b32 v39, %0\n\tv_mov_b32 v40, %0\n\tv_mov_b32 v41, %0\n\tv_mov_b32 v42, %0\n\tv_mov_b32 v43, %0\n\tv_mov_b32 v44, %0\n\tv_mov_b32 v45, %0\n\tv_mov_b32 v46, %0\n\tv_mov_b32 v47, %0\n\tv_mov_b32 v48, %0\n\tv_mov_b32 v49, %0\n\tv_mov_b32 v50, %0\n\tv_mov_b32 v51, %0\n\tv_mov_b32 v52, %0\n\tv_mov_b32 v53, %0\n\tv_mov_b32 v54, %0\n\tv_mov_b32 v55, %0\n\tv_mov_b32 v56, %0\n\tv_mov_b32 v57, %0\n\tv_mov_b32 v58, %0\n\tv_mov_b32 v59, %0\n\tv_mov_b32 v60, %0\n\tv_mov_b32 v61, %0\n\tv_mov_b32 v62, %0\n\tv_mov_b32 v63, %0\n\tv_mov_b32 v64, %0\n\tv_mov_b32 v65, %0\n\tv_mov_b32 v66, %0\n\tv_mov_b32 v67, %0\n\tv_mov_b32 v68, %0\n\tv_mov_b32 v69, %0\n\tv_mov_b32 v70, %0\n\tv_mov_b32 v71, %0\n\tv_mov_b32 v72, %0\n\tv_mov_b32 v73, %0\n\tv_mov_b32 v74, %0\n\tv_mov_b32 v75, %0\n\tv_mov_b32 v76, %0\n\tv_mov_b32 v77, %0\n\tv_mov_b32 v78, %0\n\tv_mov_b32 v79, %0\n\tv_mov_b32 v80, %0\n\tv_mov_b32 v81, %0\n\tv_mov_b32 v82, %0\n\tv_mov_b32 v83, %0\n\tv_mov_b32 v84, %0\n\tv_mov_b32 v85, %0\n\tv_mov_b32 v86, %0\n\tv_mov_b32 v87, %0\n\tv_mov_b32 v88, %0\n\tv_mov_b32 v89, %0\n\tv_mov_b32 v90, %0\n\tv_mov_b32 v91, %0\n\tv_mov_b32 v92, %0\n\tv_mov_b32 v93, %0\n\tv_mov_b32 v94, %0\n\tv_mov_b32 v95, %0\n\tv_mov_b32 v96, %0\n\tv_mov_b32 v97, %0\n\tv_mov_b32 v98, %0\n\tv_mov_b32 v99, %0\n\tv_mov_b32 v100, %0\n\tv_mov_b32 v101, %0\n\tv_mov_b32 v102, %0\n\tv_mov_b32 v103, %0\n\tv_mov_b32 v104, %0\n\tv_mov_b32 v105, %0\n\tv_mov_b32 v106, %0\n\tv_mov_b32 v107, %0\n\tv_mov_b32 v108, %0\n\tv_mov_b32 v109, %0\n\tv_mov_b32 v110, %0\n\tv_mov_b32 v111, %0\n\tv_mov_b32 v112, %0\n\tv_mov_b32 v113, %0\n\tv_mov_b32 v114, %0\n\tv_mov_b32 v115, %0\n\tv_mov_b32 v116, %0\n\tv_mov_b32 v117, %0\n\tv_mov_b32 v118, %0\n\tv_mov_b32 v119, %0\n\tv_mov_b32 v120, %0\n\tv_mov_b32 v121, %0\n\tv_mov_b32 v122, %0\n\tv_mov_b32 v123, %0\n\tv_mov_b32 v124, %0\n\tv_mov_b32 v125, %0\n\tv_mov_b32 v126, %0\n\tv_mov_b32 v127, %0\n\tv_mov_b32 v128, %0\n\tv_mov_b32 v129, %0\n\tv_mov_b32 v130, %0\n\tv_mov_b32 v131, %0\n\tv_mov_b32 v132, %0\n\tv_mov_b32 v133, %0\n\tv_mov_b32 v134, %0\n\tv_mov_b32 v135, %0\n\tv_mov_b32 v136, %0\n\tv_mov_b32 v137, %0\n\tv_mov_b32 v138, %0\n\tv_mov_b32 v139, %0\n\tv_mov_b32 v140, %0\n\tv_mov_b32 v141, %0\n\tv_mov_b32 v142, %0\n\tv_mov_b32 v143, %0\n\tv_mov_b32 v144, %0\n\tv_mov_b32 v145, %0\n\tv_mov_b32 v146, %0\n\tv_mov_b32 v147, %0\n\tv_mov_b32 v148, %0\n\tv_mov_b32 v149, %0\n\tv_mov_b32 v150, %0\n\tv_mov_b32 v151, %0\n\tv_mov_b32 v152, %0\n\tv_mov_b32 v153, %0\n\tv_mov_b32 v154, %0\n\tv_mov_b32 v155, %0\n\tv_mov_b32 v156, %0\n\tv_mov_b32 v157, %0\n\tv_mov_b32 v158, %0\n\tv_mov_b32 v159, %0\n\tv_mov_b32 v160, %0\n\tv_mov_b32 v161, %0\n\tv_mov_b32 v162, %0\n\tv_mov_b32 v163, %0\n\tv_mov_b32 v164, %0\n\tv_mov_b32 v165, %0\n\tv_mov_b32 v166, %0\n\tv_mov_b32 v167, %0\n\tv_mov_b32 v168, %0\n\tv_mov_b32 v169, %0\n\tv_mov_b32 v170, %0\n\tv_mov_b32 v171, %0\n\tv_mov_b32 v172, %0\n\tv_mov_b32 v173, %0\n\tv_mov_b32 v174, %0\n\tv_mov_b32 v175, %0\n\tv_mov_b32 v176, %0\n\tv_mov_b32 v177, %0\n\tv_mov_b32 v178, %0\n\tv_mov_b32 v179, %0\n\tv_mov_b32 v180, %0\n\tv_mov_b32 v181, %0\n\tv_mov_b32 v182, %0\n\tv_mov_b32 v183, %0\n\tv_mov_b32 v184, %0\n\tv_mov_b32 v185, %0\n\tv_mov_b32 v186, %0\n\tv_mov_b32 v187, %0\n\tv_mov_b32 v188, %0\n\tv_mov_b32 v189, %0\n\tv_mov_b32 v190, %0\n\tv_mov_b32 v191, %0\n\tv_mov_b32 v192, %0\n\tv_mov_b32 v193, %0\n\tv_mov_b32 v194, %0\n\tv_mov_b32 v195, %0\n\tv_mov_b32 v196, %0\n\tv_mov_b32 v197, %0\n\tv_mov_b32 v198, %0\n\tv_mov_b32 v199, %0\n\tv_mov_b32 v200, %0\n\tv_mov_b32 v201, %0\n\tv_mov_b32 v202, %0\n\tv_mov_b32 v203, %0\n\tv_mov_b32 v204, %0\n\tv_mov_b32 v205, %0\n\tv_mov_b32 v206, %0\n\tv_mov_b32 v207, %0\n\tv_mov_b32 v208, %0\n\tv_mov_b32 v209, %0\n\tv_mov_b32 v210, %0\n\tv_mov_b32 v211, %0\n\tv_mov_b32 v212, %0\n\tv_mov_b32 v213, %0\n\tv_mov_b32 v214, %0\n\tv_mov_b32 v215, %0\n\tv_mov_b32 v216, %0\n\tv_mov_b32 v217, %0\n\tv_mov_b32 v218, %0\n\tv_mov_b32 v219, %0\n\tv_mov_b32 v220, %0\n\tv_mov_b32 v221, %0\n\tv_mov_b32 v222, %0\n\tv_mov_b32 v223, %0\n\tv_mov_b32 v224, %0\n\tv_mov_b32 v225, %0\n\tv_mov_b32 v226, %0\n\tv_mov_b32 v227, %0\n\tv_mov_b32 v228, %0\n\tv_mov_b32 v229, %0\n\tv_mov_b32 v230, %0\n\tv_mov_b32 v231, %0\n\tv_mov_b32 v232, %0\n\tv_mov_b32 v233, %0\n\tv_mov_b32 v234, %0\n\tv_mov_b32 v235, %0\n\tv_mov_b32 v236, %0\n\tv_mov_b32 v237, %0\n\tv_mov_b32 v238, %0\n\tv_mov_b32 v239, %0" :: "v"(seed) : "v1", "v2", "v3", "v4", "v5", "v6", "v7", "v8", "v9", "v10", "v11", "v12", "v13", "v14", "v15", "v16", "v17", "v18", "v19", "v20", "v21", "v22", "v23", "v24", "v25", "v26", "v27", "v28", "v29", "v30", "v31", "v32", "v33", "v34", "v35", "v36", "v37", "v38", "v39", "v40", "v41", "v42", "v43", "v44", "v45", "v46", "v47", "v48", "v49", "v50", "v51", "v52", "v53", "v54", "v55", "v56", "v57", "v58", "v59", "v60", "v61", "v62", "v63", "v64", "v65", "v66", "v67", "v68", "v69", "v70", "v71", "v72", "v73", "v74", "v75", "v76", "v77", "v78", "v79", "v80", "v81", "v82", "v83", "v84", "v85", "v86", "v87", "v88", "v89", "v90", "v91", "v92", "v93", "v94", "v95", "v96", "v97", "v98", "v99", "v100", "v101", "v102", "v103", "v104", "v105", "v106", "v107", "v108", "v109", "v110", "v111", "v112", "v113", "v114", "v115", "v116", "v117", "v118", "v119", "v120", "v121", "v122", "v123", "v124", "v125", "v126", "v127", "v128", "v129", "v130", "v131", "v132", "v133", "v134", "v135", "v136", "v137", "v138", "v139", "v140", "v141", "v142", "v143", "v144", "v145", "v146", "v147", "v148", "v149", "v150", "v151", "v152", "v153", "v154", "v155", "v156", "v157", "v158", "v159", "v160", "v161", "v162", "v163", "v164", "v165", "v166", "v167", "v168", "v169", "v170", "v171", "v172", "v173", "v174", "v175", "v176", "v177", "v178", "v179", "v180", "v181", "v182", "v183", "v184", "v185", "v186", "v187", "v188", "v189", "v190", "v191", "v192", "v193", "v194", "v195", "v196", "v197", "v198", "v199", "v200", "v201", "v202", "v203", "v204", "v205", "v206", "v207", "v208", "v209", "v210", "v211", "v212", "v213", "v214", "v215", "v216", "v217", "v218", "v219", "v220", "v221", "v222", "v223", "v224", "v225", "v226", "v227", "v228", "v229", "v230", "v231", "v232", "v233", "v234", "v235", "v236", "v237", "v238", "v239");
#endif
}
__device__ __forceinline__ bool maybe_poison(Frame& F, int k) { if (PROBE_POISON_PHASE >= 0 && k == PROBE_POISON_PHASE) poison_state(F.lds); return true; }
__device__ __forceinline__ void echo_busy(const unsigned long long tlast, float* sink) {
    typedef short ebf16x8 __attribute__((ext_vector_type(8)));
    const unsigned long long t1 = __builtin_amdgcn_s_memrealtime(), d = t1 - tlast;
    ebf16x8 efa, efb; pg8::f32x4 e0 = {0.f, 0.f, 0.f, 0.f}, e1 = e0, e2 = e0, e3 = e0;
    unsigned hsh = (unsigned)threadIdx.x * 2654435761u + 12345u;
#pragma unroll
    for (int i = 0; i < 8; ++i) { hsh = hsh * 1664525u + 1013904223u; efa[i] = (short)(0x3c00 | ((hsh >> 9) & 0x83ff)); hsh = hsh * 1664525u + 1013904223u; efb[i] = (short)(0x3c00 | ((hsh >> 9) & 0x83ff)); }
    while (__builtin_amdgcn_s_memrealtime() - t1 < d) {
        if (PROBE_ECHO_SLEEP == 1) { __builtin_amdgcn_s_sleep(8); continue; }
        if (PROBE_ECHO_SLEEP == 2) { _Pragma("unroll") for (int i = 0; i < 64; ++i) { e0 = e0 * 1.0001f + e1; e1 = e1 * 0.9999f + e2; e2 = e2 * 1.0001f - e3; e3 = e3 * 0.9999f + 1e-3f; } continue; }
#pragma unroll
        for (int i = 0; i < 16; ++i) { e0 = __builtin_amdgcn_mfma_f32_16x16x32_bf16(efa, efb, e0, 0, 0, 0); e1 = __builtin_amdgcn_mfma_f32_16x16x32_bf16(efb, efa, e1, 0, 0, 0);
            e2 = __builtin_amdgcn_mfma_f32_16x16x32_bf16(efa, efa, e2, 0, 0, 0); e3 = __builtin_amdgcn_mfma_f32_16x16x32_bf16(efb, efb, e3, 0, 0, 0); }
    }
    const float es = e0[0] + e1[1] + e2[2] + e3[3]; if (es == 1.2345678e-33f) sink[0] = es;
}
__device__ __forceinline__ bool fresh(Frame& F) { int t = threadIdx.x; asm volatile("" : "+v"(t)); F.tid = t; F.lane = t & 63; return true; }
__global__ void __launch_bounds__(NWAVES * 64, 2) mk_fwd(Args args) {
    extern __shared__ __attribute__((aligned(16))) unsigned char lds[];
    Frame F;
    F.lds = (LAS unsigned char*)lds;
    F.MISC = (volatile LAS unsigned*)(F.lds + MISC_OFF);
    F.tid = threadIdx.x; F.lane = F.tid & 63; F.wave = __builtin_amdgcn_readfirstlane(F.tid >> 6);
    F.G = gridDim.x; F.bid = blockIdx.x;
    if (PROBE_PERM_BLOCKS) { const unsigned sd = (unsigned)(__builtin_amdgcn_s_memrealtime() >> 22); F.bid = (int)((blockIdx.x * 37u + sd * 101u) & 255u); }
    { const int bx = F.bid; F.vcu = (F.G % 8 == 0) ? (bx % 8) * (F.G / 8) + bx / 8 : bx; }
    unsigned char* ws = args.ws;
    F.ctl = (gu32*)(ws + WS_CTL);
    for (int u = F.tid; u < (LDS_BYTES - LDSCTL_OFF) / 4; u += NWAVES * 64) ((LAS unsigned*)(F.lds + LDSCTL_OFF))[u] = 0u;
    __syncthreads();
    XcdBarrier bar; bar.bar = (unsigned*)(F.ctl + CW_BAR); bar.x = 0; bar.st = nullptr;
    if (!MK_PER_PHASE) bar = xcd_barrier_post((unsigned*)(F.ctl + CW_BAR), F.MISC + 8);
    const int lo = args.ph_lo, hi = args.ph_hi;
    if (PROBE_START_BUSY) { echo_busy(__builtin_amdgcn_s_memrealtime() - (unsigned long long)PROBE_START_BUSY, args.out); }
    unsigned long long tlast = PROBE_ECHO_MASK != 0u ? __builtin_amdgcn_s_memrealtime() : 0ull; (void)tlast;
#define IN(k) (lo <= (k) && (k) < hi && fresh(F) && maybe_poison(F, (k)))
#define GEMM_RUN(...) do { pg8::gemm_phase<__VA_ARGS__>(F.lds, g, S, E); if (PROBE_GEMM_X2) { __syncthreads(); pg8::gemm_phase<__VA_ARGS__>(F.lds, g, S, E); } } while (0)
#define SEAM(k) do { if (IN(k) && IN((k) + 1)) xcd_barrier(bar); \
    if (PROBE_ECHO_MASK != 0u) { if ((PROBE_ECHO_MASK >> (k)) & 1u) { echo_busy(tlast, args.out); } tlast = __builtin_amdgcn_s_memrealtime(); } } while (0)
    const pg8::bf16_t* Hb = (const pg8::bf16_t*)args.out;
    pg8::bf16_t* Yb = (pg8::bf16_t*)(ws + WS_Y);
    pg8::bf16_t* BIGb = (pg8::bf16_t*)(ws + WS_BIG);
#define FFN_PHASES(k, q, wi) \
    if (IN(k)) { norm_pass<false>(F, args, (q)); if (PROBE_NORM_X2 && (q) == 0) { __syncthreads(); norm_pass<false>(F, args, (q)); } } SEAM(k); \
    if (IN((k) + 1)) { pg8::Gemm g{Hb, (const pg8::bf16_t*)(ws + WS_W13 + (size_t)(wi) * W13_BYTES), M, 2 * DFF, D, D, 0}; pg8::StaticOrder S; S.init(M, 2 * DFF, F.G, F.bid); \
        pg8::EpiSwiGLU E{BIGb, DFF}; GEMM_RUN(pg8::EpiSwiGLU, pg8::StaticOrder, true, true); } SEAM((k) + 1); \
    if (IN((k) + 2)) { pg8::Gemm g{BIGb, (const pg8::bf16_t*)(ws + WS_W2 + (size_t)(wi) * W2_BYTES), M, D, DFF, DFF, 0}; pg8::StaticOrder S; S.init(M, D, F.G, F.bid); \
        pg8::EpiBf16 E{Yb, D}; GEMM_RUN(pg8::EpiBf16, pg8::StaticOrder, true, true); } SEAM((k) + 2);

    enum { PH_P0 = 0, PH_F0 = 1, PH_N1 = 4, PH_EVIN = 5, PH_EVPREP = 6, PH_EVCP = 7, PH_EVSCAN = 8, PH_EVPOST = 9, PH_EVOUT = 10, PH_F2 = 11, PH_F3 = 14,
           PH_N4 = 17, PH_ODIN = 18, PH_ODCONV = 19, PH_ODGATE = 20, PH_ODSCAN = 21, PH_ODOUT = 22, PH_F5 = 23, PH_FINAL = 26 };
    static_assert(PH_FINAL + 1 == NPHASE, "phase count");
    if (IN(PH_P0)) { p0_prologue(F, args); if (PROBE_P0_X2) { __syncthreads(); p0_prologue(F, args); } } SEAM(PH_P0);
    FFN_PHASES(PH_F0, 0, 0)
    if (IN(PH_N1)) { norm_pass<true>(F, args, 1); if (PROBE_NORM_X2) { __syncthreads(); norm_pass<true>(F, args, 1); } } SEAM(PH_N1);
    if (IN(PH_EVIN)) { pg8::Gemm g{Hb, (const pg8::bf16_t*)(ws + WS_WEVIN), M, 8192, D, D, 0}; pg8::StaticOrder S; S.init(M, 8192, F.G, F.bid);
        pg8::EpiBf16 E{BIGb, 8192}; GEMM_RUN(pg8::EpiBf16, pg8::StaticOrder, true, true); } SEAM(PH_EVIN);
    if (IN(PH_EVPREP)) { ev_prep(F, args); } SEAM(PH_EVPREP);
    if (IN(PH_EVCP)) { ev_chunk_prep(F, args); if (PROBE_EW_X2 == 2) { __syncthreads(); ev_chunk_prep(F, args); } } SEAM(PH_EVCP);
    if (IN(PH_EVSCAN)) { ev_chunk_scan(F, args); if (PROBE_REC_X2) { __syncthreads(); ev_chunk_scan(F, args); } } SEAM(PH_EVSCAN);
    if (IN(PH_EVPOST)) { ev_post(F, args); if (PROBE_EW_X2 == 1) { __syncthreads(); ev_post(F, args); } } SEAM(PH_EVPOST);
    if (IN(PH_EVOUT)) { pg8::Gemm g{Hb, (const pg8::bf16_t*)(ws + WS_WEVOUT), M, D, D, D, 0}; pg8::StaticOrder S; S.init(M, D, F.G, F.bid);
        pg8::EpiBf16 E{Yb, D}; GEMM_RUN(pg8::EpiBf16, pg8::StaticOrder, true, true); } SEAM(PH_EVOUT);
    FFN_PHASES(PH_F2, 2, 1)
    FFN_PHASES(PH_F3, 3, 2)
    if (IN(PH_N4)) { norm_pass<false>(F, args, 4); } SEAM(PH_N4);
    if (IN(PH_ODIN)) { pg8::Gemm g{Hb, (const pg8::bf16_t*)(ws + WS_WODIN), M, 4096, D, D, 0}; pg8::StaticOrder S; S.init(M, 4096, F.G, F.bid);
        pg8::EpiBf16 E{BIGb, 4096}; GEMM_RUN(pg8::EpiBf16, pg8::StaticOrder, true, true); } SEAM(PH_ODIN);
    if (IN(PH_ODCONV)) { od_conv(F, args); if (PROBE_EW_X2 == 1) { __syncthreads(); od_conv(F, args); } } SEAM(PH_ODCONV);
    if (IN(PH_ODGATE)) { pg8::Gemm g{Hb, (const pg8::bf16_t*)(ws + WS_WGATE), M, 4096, 256, D, 2}; pg8::StaticOrder S; S.init(M, 4096, F.G, F.bid);
        pg8::EpiGates E{(pg8::bf16_t*)(ws + WS_RG), (pg8::bf16_t*)(ws + WS_EXT), Hb, args.in[19], args.in[21], (const float*)(ws + WS_SP8)};
        GEMM_RUN(pg8::EpiGates, pg8::StaticOrder, true, true); } SEAM(PH_ODGATE);
    if (IN(PH_ODSCAN)) { od_scan(F, args); } SEAM(PH_ODSCAN);
    if (IN(PH_ODOUT)) { pg8::Gemm g{Hb, (const pg8::bf16_t*)(ws + WS_WODOUT), M, D, D, D, 0}; pg8::StaticOrder S; S.init(M, D, F.G, F.bid);
        pg8::EpiBf16 E{Yb, D}; GEMM_RUN(pg8::EpiBf16, pg8::StaticOrder, true, true); } SEAM(PH_ODOUT);
    FFN_PHASES(PH_F5, 5, 3)
    if (IN(PH_FINAL)) { norm_pass<false>(F, args, 6); if (FINAL_BAR && !MK_PER_PHASE) xcd_barrier(bar); }
#undef IN
#undef SEAM
#undef FFN_PHASES
}

extern "C" void kernel_launch(void* const* d_in, const int* in_sizes, int n_in, void* d_out, int out_size, void* d_ws, size_t ws_size, hipStream_t stream) {
    static int grid = 0;
    if (grid == 0) {
        if (n_in != 24 || in_sizes[0] != M * D || out_size != M * D || ws_size < WS_END) {
            fprintf(stderr, "kernel_launch: unexpected problem (n_in %d, in0 %d, out %d, ws %zu < %zu); nothing launched\n", n_in, n_in > 0 ? in_sizes[0] : -1, out_size, ws_size, (size_t)WS_END); grid = -1; return; }
        int dev = 0, cus = 0, per_cu = 0;
        if (hipGetDevice(&dev) != hipSuccess || hipDeviceGetAttribute(&cus, hipDeviceAttributeMultiprocessorCount, dev) != hipSuccess) { grid = -1; return; }
        if (hipFuncSetAttribute((const void*)mk_fwd, hipFuncAttributeMaxDynamicSharedMemorySize, LDS_BYTES) != hipSuccess) { fprintf(stderr, "kernel_launch: hipFuncSetAttribute failed\n"); grid = -1; return; }
        if (hipOccupancyMaxActiveBlocksPerMultiprocessor(&per_cu, (const void*)mk_fwd, NWAVES * 64, LDS_BYTES) != hipSuccess || per_cu < 1)
            fprintf(stderr, "kernel_launch: note: occupancy query reports %d workgroups per CU\n", per_cu);
        (void)hipGetLastError();
        grid = cus;
        if (grid != 256) fprintf(stderr, "kernel_launch: note: %d CUs (built for 256)\n", grid);
    }
    if (grid < 0) return;
    if (hipMemsetAsync((char*)d_ws + WS_CTL, 0, CTL_ZERO_BYTES, stream) != hipSuccess) return;
    Args a{};
    for (int i = 0; i < 24; ++i) a.in[i] = (const float*)d_in[i];
    a.out = (float*)d_out; a.ws = (unsigned char*)d_ws;
#if MK_PER_PHASE
    for (int k = 0; k < NPHASE; ++k) { a.ph_lo = k; a.ph_hi = k + 1; hipLaunchKernelGGL(mk_fwd, dim3(grid), dim3(NWAVES * 64), LDS_BYTES, stream, a); }
#else
    a.ph_lo = 0; a.ph_hi = NPHASE; hipLaunchKernelGGL(mk_fwd, dim3(grid), dim3(NWAVES * 64), LDS_BYTES, stream, a);
#endif
}
```
